# Optimizing an MI355X kernel written in HIP

```python
import math
import jax, jax.numpy as jnp
from jax import lax
import numpy as np

D_MODEL = 2048
BATCH = 4
SEQ = 8192
DEPTH = 2

N_A = DEPTH // 2
N_B = DEPTH - N_A

POOL_WINDOWS = (2, 4, 8, 16)
N_POOL_GROUPS = len(POOL_WINDOWS)
POOL_GROUP = D_MODEL // N_POOL_GROUPS

N_HEADS = 16
QK_NOPE_DIM = 128
QK_ROPE_DIM = 64
QK_DIM = QK_NOPE_DIM + QK_ROPE_DIM
V_DIM = 128
Q_LORA_RANK = 512
KV_LORA_RANK = 512
ROPE_BASE = 10000.0
ATTN_SCALE = 1.0 / math.sqrt(QK_DIM)
Q_BLOCK = 128

FFN_MULT = 256
D_FF = ((8 * D_MODEL + 3 * FFN_MULT - 1) // (3 * FFN_MULT)) * FFN_MULT

NORM_EPS = 1e-6
POS_OFFSET_MAX = 4096

kernel_name = "yoco_pool_mla_hybrid"


def rms_norm(x, g):
    xf = x.astype(jnp.float32)
    y = xf * lax.rsqrt(jnp.mean(xf * xf, axis=-1, keepdims=True) + NORM_EPS)
    return (y * g.astype(jnp.float32)).astype(x.dtype)


def swiglu(h, w_gate, w_up, w_down):
    return (jax.nn.silu(h @ w_gate) * (h @ w_up)) @ w_down


def rope_tables(positions):
    half = QK_ROPE_DIM // 2
    inv_freq = ROPE_BASE ** (-jnp.arange(half, dtype=jnp.float32) / half)
    ang = positions.astype(jnp.float32)[..., None] * inv_freq
    return jnp.cos(ang), jnp.sin(ang)


def apply_rope(x, cos, sin):
    half = QK_ROPE_DIM // 2
    xf = x.astype(jnp.float32)
    x1, x2 = xf[..., :half], xf[..., half:]
    out = jnp.concatenate([x1 * cos - x2 * sin, x2 * cos + x1 * sin], axis=-1)
    return out.astype(x.dtype)


def multiscale_pool_mixer(h, pool_w, pool_scale):
    S = h.shape[1]
    hf = h.astype(jnp.float32)
    cs = jnp.cumsum(hf, axis=1)
    t = jnp.arange(S)
    outs = []
    for g, w in enumerate(POOL_WINDOWS):
        sl = slice(g * POOL_GROUP, (g + 1) * POOL_GROUP)
        c = cs[..., sl]
        c_prev = jnp.pad(c, ((0, 0), (w, 0), (0, 0)))[:, :S]
        count = jnp.minimum(t + 1, w).astype(jnp.float32)[None, :, None]
        diff = (c - c_prev) / count - hf[..., sl]
        outs.append(jnp.einsum('bsc,cd->bsd', diff.astype(h.dtype), pool_w[g]))
    return jnp.concatenate(outs, axis=-1) * pool_scale


def shared_mla_kv(h, w_kv_a, kv_latent_norm, w_kv_b, cos, sin):
    B, S, _ = h.shape
    kv = h @ w_kv_a
    c_kv = rms_norm(kv[..., :KV_LORA_RANK], kv_latent_norm)
    k_pe = apply_rope(kv[..., KV_LORA_RANK:], cos, sin)
    kv_up = (c_kv @ w_kv_b).reshape(B, S, N_HEADS, QK_NOPE_DIM + V_DIM)
    return kv_up[..., :QK_NOPE_DIM], k_pe, kv_up[..., QK_NOPE_DIM:]


def causal_mla_attention(q_nope, q_pe, k_nope, k_pe, v):
    S = q_nope.shape[1]
    outs = []
    for i in range(S // Q_BLOCK):
        s0, e = i * Q_BLOCK, (i + 1) * Q_BLOCK
        sc = (jnp.einsum('bqhd,bkhd->bhqk', q_nope[:, s0:e], k_nope[:, :e])
              + jnp.einsum('bqhr,bkr->bhqk', q_pe[:, s0:e], k_pe[:, :e]))
        sc = sc.astype(jnp.float32) * ATTN_SCALE
        mask = jnp.arange(e)[None, :] <= (s0 + jnp.arange(Q_BLOCK))[:, None]
        sc = jnp.where(mask, sc, -jnp.inf)
        p = jax.nn.softmax(sc, axis=-1).astype(v.dtype)
        outs.append(jnp.einsum('bhqk,bkhd->bqhd', p, v[:, :e]))
    return jnp.concatenate(outs, axis=1)


def mla_layer_mixer(h, w_q_a, q_latent_norm, w_q_b, w_o, k_nope, k_pe, v, cos, sin):
    B, S, _ = h.shape
    q = (rms_norm(h @ w_q_a, q_latent_norm) @ w_q_b).reshape(B, S, N_HEADS, QK_DIM)
    q_nope = q[..., :QK_NOPE_DIM]
    q_pe = apply_rope(q[..., QK_NOPE_DIM:], cos[:, :, None, :], sin[:, :, None, :])
    o = causal_mla_attention(q_nope, q_pe, k_nope, k_pe, v)
    return o.reshape(B, S, N_HEADS * V_DIM) @ w_o


def setup_inputs(seed: int = 0) -> dict:
    key = jax.random.key(seed)
    ks = jax.random.split(key, 24)
    f32 = jnp.float32

    def dense(k, shape, fan_in):
        return jax.random.normal(k, shape, f32) * (fan_in ** -0.5)

    def gain(k, shape):
        return 1.0 + 0.05 * jax.random.normal(k, shape, f32)

    x = jax.random.normal(ks[0], (BATCH, SEQ, D_MODEL), f32)
    positions = (jax.random.randint(ks[1], (BATCH, 1), 0, POS_OFFSET_MAX, dtype=jnp.int32)
                 + jnp.arange(SEQ, dtype=jnp.int32)[None, :])
    return {
        "x": x,
        "positions": positions,
        "pool_norm": gain(ks[2], (N_A, D_MODEL)),
        "pool_w": dense(ks[3], (N_A, N_POOL_GROUPS, POOL_GROUP, POOL_GROUP), POOL_GROUP),
        "pool_scale": gain(ks[4], (N_A, D_MODEL)),
        "kv_in_norm": gain(ks[5], (D_MODEL,)),
        "w_kv_a": dense(ks[6], (D_MODEL, KV_LORA_RANK + QK_ROPE_DIM), D_MODEL),
        "kv_latent_norm": gain(ks[7], (KV_LORA_RANK,)),
        "w_kv_b": dense(ks[8], (KV_LORA_RANK, N_HEADS * (QK_NOPE_DIM + V_DIM)), KV_LORA_RANK),
        "attn_norm": gain(ks[9], (N_B, D_MODEL)),
        "w_q_a": dense(ks[10], (N_B, D_MODEL, Q_LORA_RANK), D_MODEL),
        "q_latent_norm": gain(ks[11], (N_B, Q_LORA_RANK)),
        "w_q_b": dense(ks[12], (N_B, Q_LORA_RANK, N_HEADS * QK_DIM), Q_LORA_RANK),
        "w_o": dense(ks[13], (N_B, N_HEADS * V_DIM, D_MODEL), N_HEADS * V_DIM),
        "ffn_norm": gain(ks[14], (DEPTH, D_MODEL)),
        "w_gate": dense(ks[15], (DEPTH, D_MODEL, D_FF), D_MODEL),
        "w_up": dense(ks[16], (DEPTH, D_MODEL, D_FF), D_MODEL),
        "w_down": dense(ks[17], (DEPTH, D_FF, D_MODEL), D_FF),
        "final_norm": gain(ks[18], (D_MODEL,)),
    }


def reference(x, positions, pool_norm, pool_w, pool_scale, kv_in_norm, w_kv_a,
              kv_latent_norm, w_kv_b, attn_norm, w_q_a, q_latent_norm, w_q_b, w_o,
              ffn_norm, w_gate, w_up, w_down, final_norm):
    cos, sin = rope_tables(positions)
    k_nope = k_pe = v = None
    for l in range(DEPTH):
        if l == N_A:
            k_nope, k_pe, v = shared_mla_kv(rms_norm(x, kv_in_norm), w_kv_a,
                                            kv_latent_norm, w_kv_b, cos, sin)
        if l < N_A:
            x = x + multiscale_pool_mixer(rms_norm(x, pool_norm[l]), pool_w[l], pool_scale[l])
        else:
            b = l - N_A
            x = x + mla_layer_mixer(rms_norm(x, attn_norm[b]), w_q_a[b], q_latent_norm[b],
                                    w_q_b[b], w_o[b], k_nope, k_pe, v, cos, sin)
        x = x + swiglu(rms_norm(x, ffn_norm[l]), w_gate[l], w_up[l], w_down[l])
    return rms_norm(x, final_norm)
```

```cpp
#include <hip/hip_runtime.h>
#include <hip/hip_cooperative_groups.h>
#include <cstdio>
#include <cstdint>
namespace cg = cooperative_groups;

#define LAS __attribute__((address_space(3)))
typedef unsigned short bf16_t;
typedef short bf16x8 __attribute__((ext_vector_type(8)));
typedef short s16x4 __attribute__((ext_vector_type(4)));
typedef float f32x2 __attribute__((ext_vector_type(2)));
typedef float f32x4 __attribute__((ext_vector_type(4)));
typedef float f32x16 __attribute__((ext_vector_type(16)));
typedef unsigned u32x2 __attribute__((ext_vector_type(2)));
typedef unsigned u32x4 __attribute__((ext_vector_type(4)));

constexpr int DM = 2048, NB = 4, SEQ = 8192, T = NB * SEQ, DFF = 5632, NH = 16;
constexpr float EPS = 1e-6f;
constexpr float C2Q = 0.07216878364870322f * 1.4426950408889634f;

__device__ __forceinline__ unsigned cvt_pk_bf16(float lo, float hi) { unsigned r; asm volatile("v_cvt_pk_bf16_f32 %0, %1, %2" : "=v"(r) : "v"(lo), "v"(hi)); return r; }
__device__ __forceinline__ u32x4 pack8(f32x4 a, f32x4 b) { u32x4 w; w.x = cvt_pk_bf16(a[0], a[1]); w.y = cvt_pk_bf16(a[2], a[3]); w.z = cvt_pk_bf16(b[0], b[1]); w.w = cvt_pk_bf16(b[2], b[3]); return w; }
__device__ __forceinline__ float sq4(f32x4 v) { return (v[0] * v[0] + v[1] * v[1]) + (v[2] * v[2] + v[3] * v[3]); }

namespace pg8 {
constexpr int BM = 256, BK = 64, HALF = 128, HTB = HALF * BK * 2, STAGE_BYTES = 8 * HTB, NXCD = 8, WGM = 8;
__host__ __device__ __forceinline__ int lds_byte(int r, int c) { const int st = (r >> 4) * 2 + (c >> 5), rr = r & 15, cc = c & 31, ob = rr * 64 + cc * 2; return st * 1024 + (ob ^ (((ob >> 9) & 1) << 5)); }
__host__ __device__ __forceinline__ void stage_rc(int b, int& R, int& C) { const int st = b / 1024, sb = b % 1024, swz = sb ^ (((sb >> 9) & 1) << 5); R = (st >> 1) * 16 + swz / 64; C = (st & 1) * 32 + (swz % 64) / 2; }
__host__ __device__ __forceinline__ int perm32(int rho) { const int n = rho >> 4, i = rho & 15; return 8 * (i >> 2) + 4 * n + (i & 3); }

struct Unit { int pm, pn, grp; };
struct Gemm { const bf16_t* A; const bf16_t* Bt; int lda, ldb, K; long grpA, grpB; };

struct Order {
    int nM, nN, nwg, nG, G, c;
    __device__ void init(int M, int N, int nG_, int G_, int c_) { nM = M / BM; nN = N / BM; nwg = nM * nN; nG = nG_; G = G_; c = c_; }
    __device__ bool next(int i, Unit& u) const {
        const long L = (long)i * G + c; if (L >= (long)nwg * nG) return false;
        u.grp = (int)(L / nwg); int wgid = (int)(L % nwg);
        { const int q = nwg / NXCD, r = nwg % NXCD, xcd = wgid % NXCD, off = wgid / NXCD; wgid = (xcd < r ? xcd * (q + 1) : r * (q + 1) + (xcd - r) * q) + off; }
        const int nig = WGM * nN, gid = wgid / nig, fm = gid * WGM, gsz = (nM - fm) < WGM ? (nM - fm) : WGM;
        u.pm = fm + ((wgid % nig) % gsz); u.pn = (wgid % nig) / gsz; return true;
    }
};

template <class Epi>
__device__ __forceinline__ void gemm_phase(LAS unsigned char* lds, const Gemm g, const Order& S, const Epi& E) {
    const int tid = threadIdx.x, wid = __builtin_amdgcn_readfirstlane(tid >> 6), lane = tid & 63, wr = wid >> 2, wc = wid & 3, fr = lane & 15, fq = lane >> 4;
    const int K = g.K, nt = K / BK;
    unsigned voffA[2], voffB[2];
#pragma unroll
    for (int i = 0; i < 2; ++i) { int R, C; stage_rc(tid * 16 + i * 8192, R, C); const int Rb = (R & ~31) + perm32(R & 31);
        voffA[i] = (unsigned)(R * g.lda + C) * 2u; voffB[i] = (unsigned)(Rb * g.ldb + C) * 2u; }
    const size_t kstep = (size_t)(BK * 2);
    const size_t hstepA = (size_t)HALF * g.lda * 2, hstepB = (size_t)HALF * g.ldb * 2;
    const size_t tstepA = 2 * hstepA, tstepB = 2 * hstepB;
    const unsigned ldsw = (unsigned)wid * 1024u;
    const int aoff = lds_byte(wr * 64 + fr, fq * 8), boff = lds_byte(wc * 32 + fr, fq * 8);
#define PG8_SA(b, h) (((b) * 2 + (h)) * HTB)
#define PG8_SB(b, h) ((4 + (b) * 2 + (h)) * HTB)
#define PG8_STAGE(bufoff, gbase, voff) do { _Pragma("unroll") for (int _i = 0; _i < 2; ++_i) \
        __builtin_amdgcn_global_load_lds((const unsigned*)((const char*)(gbase) + (voff)[_i]), (LAS unsigned*)(lds + (bufoff) + ldsw + _i * 8192), 16, 0, 0); } while (0)
#define PG8_LDA(dst, b, h) do { _Pragma("unroll") for (int m = 0; m < 4; ++m) _Pragma("unroll") for (int k = 0; k < 2; ++k) dst[m][k] = *(const LAS bf16x8*)(lds + PG8_SA(b, h) + aoff + m * 2048 + k * 1024); } while (0)
#define PG8_LDB(dst, b, h) do { _Pragma("unroll") for (int n = 0; n < 2; ++n) _Pragma("unroll") for (int k = 0; k < 2; ++k) dst[n][k] = *(const LAS bf16x8*)(lds + PG8_SB(b, h) + boff + n * 2048 + k * 1024); } while (0)
#define PG8_MMA(ai, bj, At, Bt) do { __builtin_amdgcn_s_setprio(1); _Pragma("unroll") for (int m = 0; m < 4; ++m) _Pragma("unroll") for (int n = 0; n < 2; ++n) _Pragma("unroll") for (int k = 0; k < 2; ++k) \
        acc[ai][bj][m][n] = __builtin_amdgcn_mfma_f32_16x16x32_bf16(Bt[n][k], At[m][k], acc[ai][bj][m][n], 0, 0, 0); __builtin_amdgcn_s_setprio(0); } while (0)
#define PG8_WAIT_V(n) asm volatile("s_waitcnt vmcnt(" #n ")" ::: "memory")
#define PG8_WAIT_L(n) asm volatile("s_waitcnt lgkmcnt(" #n ")" ::: "memory")
#define PG8_BAR __builtin_amdgcn_s_barrier()
#define PG8_SCHED __builtin_amdgcn_sched_barrier(0)
    Unit cur, nxt; int ui = 0;
    if (!S.next(0, cur)) return;
    f32x4 acc[2][2][4][2];
#pragma unroll
    for (int a = 0; a < 2; ++a)
#pragma unroll
        for (int b = 0; b < 2; ++b)
#pragma unroll
            for (int m = 0; m < 4; ++m)
#pragma unroll
                for (int n = 0; n < 2; ++n) acc[a][b][m][n] = (f32x4){0.f, 0.f, 0.f, 0.f};
    bf16x8 At[4][2], B0[2][2], B1[2][2];
    const char* cA = (const char*)(g.A + (size_t)cur.grp * g.grpA) + (size_t)cur.pm * tstepA;
    const char* cB = (const char*)(g.Bt + (size_t)cur.grp * g.grpB) + (size_t)cur.pn * tstepB;
    PG8_STAGE(PG8_SB(0, 0), cB, voffB); PG8_STAGE(PG8_SB(0, 1), cB + hstepB, voffB); PG8_STAGE(PG8_SA(0, 0), cA, voffA); PG8_STAGE(PG8_SA(0, 1), cA + hstepA, voffA);
    if (wr == 1) PG8_BAR;
    PG8_WAIT_V(2); PG8_BAR;
    PG8_STAGE(PG8_SB(1, 0), cB + kstep, voffB); PG8_STAGE(PG8_SA(1, 0), cA + kstep, voffA); PG8_STAGE(PG8_SB(1, 1), cB + hstepB + kstep, voffB);
    PG8_WAIT_V(6); PG8_BAR;
    for (;;) {
        const bool has_next = S.next(ui + 1, nxt);
        const char* nA = has_next ? (const char*)(g.A + (size_t)nxt.grp * g.grpA) + (size_t)nxt.pm * tstepA : cA;
        const char* nB = has_next ? (const char*)(g.Bt + (size_t)nxt.grp * g.grpB) + (size_t)nxt.pn * tstepB : cB;
        for (int t = 0; t < nt; t += 2) {
            const bool last = (t == nt - 2);
            const char* a1 = cA + (size_t)(t + 1) * kstep;
            const char* a2 = last ? nA : cA + (size_t)(t + 2) * kstep; const char* b2 = last ? nB : cB + (size_t)(t + 2) * kstep;
            const char* a3 = a2 + kstep; const char* b3 = b2 + kstep;
            PG8_LDB(B0, 0, 0); PG8_LDB(B1, 0, 1); PG8_SCHED; PG8_LDA(At, 0, 0); PG8_STAGE(PG8_SA(1, 1), a1 + hstepA, voffA);
            PG8_WAIT_V(8); PG8_WAIT_L(0); PG8_BAR; PG8_MMA(0, 0, At, B0); PG8_MMA(0, 1, At, B1); PG8_BAR; PG8_SCHED;
            PG8_LDA(At, 0, 1); PG8_STAGE(PG8_SB(0, 0), b2, voffB); PG8_STAGE(PG8_SB(0, 1), b2 + hstepB, voffB); PG8_STAGE(PG8_SA(0, 0), a2, voffA);
            PG8_WAIT_V(8); PG8_WAIT_L(0); PG8_BAR; PG8_MMA(1, 0, At, B0); PG8_MMA(1, 1, At, B1); PG8_BAR; PG8_SCHED;
            PG8_LDB(B0, 1, 0); PG8_LDB(B1, 1, 1); PG8_SCHED; PG8_LDA(At, 1, 0); PG8_STAGE(PG8_SA(0, 1), a2 + hstepA, voffA);
            PG8_WAIT_V(8); PG8_WAIT_L(0); PG8_BAR; PG8_MMA(0, 0, At, B0); PG8_MMA(0, 1, At, B1); PG8_BAR; PG8_SCHED;
            PG8_LDA(At, 1, 1); PG8_STAGE(PG8_SB(1, 0), b3, voffB); PG8_STAGE(PG8_SB(1, 1), b3 + hstepB, voffB); PG8_STAGE(PG8_SA(1, 0), a3, voffA);
            PG8_WAIT_V(8); PG8_WAIT_L(0); PG8_BAR; PG8_MMA(1, 0, At, B0); PG8_MMA(1, 1, At, B1); PG8_BAR; PG8_SCHED;
        }
        if (wr == 0) PG8_BAR;
        E(acc, cur, wr, wc, fr, fq);
        if (!has_next) break;
#pragma unroll
        for (int a = 0; a < 2; ++a)
#pragma unroll
            for (int b = 0; b < 2; ++b)
#pragma unroll
                for (int m = 0; m < 4; ++m)
#pragma unroll
                    for (int n = 0; n < 2; ++n) acc[a][b][m][n] = (f32x4){0.f, 0.f, 0.f, 0.f};
        cur = nxt; cA = nA; cB = nB; ++ui;
        if (wr == 1) PG8_BAR;
    }
    PG8_WAIT_V(0);
    PG8_BAR;
#undef PG8_SA
#undef PG8_SB
#undef PG8_STAGE
#undef PG8_LDA
#undef PG8_LDB
#undef PG8_MMA
#undef PG8_WAIT_V
#undef PG8_WAIT_L
#undef PG8_BAR
#undef PG8_SCHED
}

template <int NP> __device__ __forceinline__ float row_rstd(const float* ss, int row, int fq, float invn) {
    const float* p = ss + (size_t)row * NP + fq * (NP / 4); float s;
    if constexpr (NP == 32) { const f32x4 a = *(const f32x4*)p, b = *(const f32x4*)(p + 4); s = ((a[0] + a[1]) + (a[2] + a[3])) + ((b[0] + b[1]) + (b[2] + b[3])); }
    else { const f32x2 a = *(const f32x2*)p; s = a[0] + a[1]; }
    s += __shfl_xor(s, 16); s += __shfl_xor(s, 32);
    return __builtin_amdgcn_rsqf(s * invn + EPS);
}
__device__ __forceinline__ float rowsum4(float q) { q += __shfl_xor(q, 16); q += __shfl_xor(q, 32); return q; }

struct EpiResid {
    const float* base; float* out; bf16_t* xb; float* ss; int colgrp;
    __device__ __forceinline__ void operator()(const f32x4 (&acc)[2][2][4][2], const Unit& u, int wr, int wc, int fr, int fq) const {
        const int row0 = u.pm * BM + wr * 64 + fr, colb = u.grp * colgrp + u.pn * BM, col0 = colb + wc * 32 + 8 * fq, pidx = (colb >> 6) + wc;
#pragma unroll
        for (int ai = 0; ai < 2; ++ai)
#pragma unroll
            for (int m = 0; m < 4; ++m) { const int row = row0 + ai * HALF + m * 16; const size_t off = (size_t)row * DM + col0; float q = 0.f;
#pragma unroll
                for (int bj = 0; bj < 2; ++bj) {
                    const f32x4 b0 = *(const f32x4*)(base + off + bj * HALF), b1 = *(const f32x4*)(base + off + bj * HALF + 4);
                    const f32x4 v0 = acc[ai][bj][m][0] + b0, v1 = acc[ai][bj][m][1] + b1;
                    *(f32x4*)(out + off + bj * HALF) = v0; *(f32x4*)(out + off + bj * HALF + 4) = v1;
                    if (xb) *(u32x4*)(xb + off + bj * HALF) = pack8(v0, v1);
                    q += sq4(v0) + sq4(v1); }
                q = rowsum4(q); if (fq == 0) ss[(size_t)row * 32 + pidx] = q;
                asm volatile("" ::: "memory"); }
    }
};
struct EpiSwiGLU {
    bf16_t* mid; const float* ss;
    __device__ __forceinline__ void operator()(const f32x4 (&acc)[2][2][4][2], const Unit& u, int wr, int wc, int fr, int fq) const {
        const int row0 = u.pm * BM + wr * 64 + fr, col0 = u.pn * HALF + wc * 32 + 8 * fq;
#pragma unroll
        for (int ai = 0; ai < 2; ++ai)
#pragma unroll
            for (int m = 0; m < 4; ++m) { const int row = row0 + ai * HALF + m * 16; const float s = row_rstd<32>(ss, row, fq, 1.f / DM);
                f32x4 h[2];
#pragma unroll
                for (int n = 0; n < 2; ++n) { const f32x4 gg = acc[ai][0][m][n] * s, uu = acc[ai][1][m][n] * s;
#pragma unroll
                    for (int e = 0; e < 4; ++e) h[n][e] = gg[e] * __builtin_amdgcn_rcpf(1.f + __builtin_amdgcn_exp2f(-1.4426950408889634f * gg[e])) * uu[e]; }
                *(u32x4*)(mid + (size_t)row * DFF + col0) = pack8(h[0], h[1]); }
    }
};
__device__ __forceinline__ void rope8(f32x4& v0, f32x4& v1, const float* cs  ) {
    const f32x4 c0 = *(const f32x4*)cs, c1 = *(const f32x4*)(cs + 4);
    const f32x4 a = v0, b = v1;
    v0 = (f32x4){a[0] * c0[0] - a[1] * c0[1], a[1] * c0[0] + a[0] * c0[1], a[2] * c0[2] - a[3] * c0[3], a[3] * c0[2] + a[2] * c0[3]};
    v1 = (f32x4){b[0] * c1[0] - b[1] * c1[1], b[1] * c1[0] + b[0] * c1[1], b[2] * c1[2] - b[3] * c1[3], b[3] * c1[2] + b[2] * c1[3]};
}
struct EpiA {
    const float* ss; bf16_t* qa; bf16_t* kva; float* ssq; float* sskv; bf16_t* Kb; const float* cs;
    __device__ __forceinline__ void operator()(const f32x4 (&acc)[2][2][4][2], const Unit& u, int wr, int wc, int fr, int fq) const {
        const int row0 = u.pm * BM + wr * 64 + fr;
        if (u.pn < 4) {
            bf16_t* dst = u.pn < 2 ? qa : kva; float* sso = u.pn < 2 ? ssq : sskv; const int colb = (u.pn & 1) * BM, col0 = colb + wc * 32 + 8 * fq, pidx = (u.pn & 1) * 4 + wc;
#pragma unroll
            for (int ai = 0; ai < 2; ++ai)
#pragma unroll
                for (int m = 0; m < 4; ++m) { const int row = row0 + ai * HALF + m * 16; const float s = row_rstd<32>(ss, row, fq, 1.f / DM); float q = 0.f;
#pragma unroll
                    for (int bj = 0; bj < 2; ++bj) { const f32x4 v0 = acc[ai][bj][m][0] * s, v1 = acc[ai][bj][m][1] * s;
                        *(u32x4*)(dst + (size_t)row * 512 + col0 + bj * HALF) = pack8(v0, v1); q += sq4(v0) + sq4(v1); }
                    q = rowsum4(q); if (fq == 0) sso[(size_t)row * 8 + pidx] = q; }
        } else {
            const int p0 = wc * 32 + 8 * fq;
#pragma unroll
            for (int ai = 0; ai < 2; ++ai)
#pragma unroll
                for (int m = 0; m < 4; ++m) { const int row = row0 + ai * HALF + m * 16; const float s = row_rstd<32>(ss, row, fq, 1.f / DM);
                    if (wc < 2) { f32x4 v0 = acc[ai][0][m][0] * s, v1 = acc[ai][0][m][1] * s; rope8(v0, v1, cs + ((size_t)row * 32 + (p0 >> 1)) * 2);
                        const u32x4 w = pack8(v0, v1); bf16_t* kp = Kb + (size_t)row * 3072 + 128 + p0;
#pragma unroll
                        for (int h = 0; h < NH; ++h) *(u32x4*)(kp + h * 192) = w; } }
        }
    }
};
struct EpiQ {
    const float* ssq; bf16_t* Q; const float* cs;
    __device__ __forceinline__ void operator()(const f32x4 (&acc)[2][2][4][2], const Unit& u, int wr, int wc, int fr, int fq) const {
        const int row0 = u.pm * BM + wr * 64 + fr;
#pragma unroll
        for (int ai = 0; ai < 2; ++ai)
#pragma unroll
            for (int m = 0; m < 4; ++m) { const int row = row0 + ai * HALF + m * 16; const float s = row_rstd<8>(ssq, row, fq, 1.f / 512.f) * C2Q;
#pragma unroll
                for (int bj = 0; bj < 2; ++bj) { f32x4 v0 = acc[ai][bj][m][0] * s, v1 = acc[ai][bj][m][1] * s;
                    if (u.pn < 8) { *(u32x4*)(Q + (size_t)row * 3072 + (2 * u.pn + bj) * 192 + wc * 32 + 8 * fq) = pack8(v0, v1); }
                    else { const int head = 4 * (u.pn - 8) + 2 * bj + (wc >> 1), p0 = 32 * (wc & 1) + 8 * fq; rope8(v0, v1, cs + ((size_t)row * 32 + (p0 >> 1)) * 2);
                        *(u32x4*)(Q + (size_t)row * 3072 + head * 192 + 128 + p0) = pack8(v0, v1); } } }
    }
};
struct EpiKV {
    const float* sskv; bf16_t* Kb; bf16_t* Vb;
    __device__ __forceinline__ void operator()(const f32x4 (&acc)[2][2][4][2], const Unit& u, int wr, int wc, int fr, int fq) const {
        const int row0 = u.pm * BM + wr * 64 + fr;
#pragma unroll
        for (int ai = 0; ai < 2; ++ai)
#pragma unroll
            for (int m = 0; m < 4; ++m) { const int row = row0 + ai * HALF + m * 16; const float s = row_rstd<8>(sskv, row, fq, 1.f / 512.f);
#pragma unroll
                for (int bj = 0; bj < 2; ++bj) { const f32x4 v0 = acc[ai][bj][m][0] * s, v1 = acc[ai][bj][m][1] * s;
                    bf16_t* d = u.pn < 8 ? Kb + (size_t)row * 3072 + (2 * u.pn + bj) * 192 + wc * 32 + 8 * fq : Vb + (size_t)row * 2048 + (2 * (u.pn - 8) + bj) * 128 + wc * 32 + 8 * fq;
                    *(u32x4*)d = pack8(v0, v1); } }
    }
};
}

namespace att {
constexpr int NW = 8, QBLK = 32, KVBLK = 64, QB = 256;
constexpr int LDQ = 3072, LDK = 3072, LDV = 2048, LDO = 2048;
constexpr int KROWB = 400;
constexpr int SHM_K = KVBLK * KROWB, SHM_V = KVBLK * 128 * 2;
constexpr int LDS_BYTES = 2 * SHM_V + 2 * SHM_K + NW * 64 * 4;
constexpr float THR = 8.f;
#define SBAR() __builtin_amdgcn_sched_barrier(0)
__device__ __forceinline__ int v_st(int k, int c) { const int kk = (k & ~0xC) | ((k & 4) << 1) | ((k & 8) >> 1); return ((kk >> 3) * 4 + (c >> 5)) * 512 + ((kk & 7) * 32 + (c & 31)) * 2; }
__device__ __forceinline__ int v_rd_base(int lane) { return ((lane & 3) << 3) | (((lane >> 2) & 3) << 6) | (((lane >> 4) & 1) << 5) | (((lane >> 5) & 1) << 8); }
constexpr int v_rd_off(int d0, int ks, int half) { return d0 * 512 + ks * 4096 + half * 2048; }
__device__ __forceinline__ int crow(int r, int hi) { return (r & 3) + 8 * (r >> 2) + 4 * hi; }
__device__ __forceinline__ bf16x8 ld8(const bf16_t* p) { return *reinterpret_cast<const bf16x8*>(p); }
__device__ __forceinline__ void mask_tile(f32x16& p0, f32x16& p1, int dq) {
    const float NEG = -__builtin_inff();
#pragma unroll
    for (int r = 0; r < 16; ++r) { const int c = (r & 3) + 8 * (r >> 2); if (dq - c < 0) p0[r] = NEG; if (dq - c - 32 < 0) p1[r] = NEG; }
}
template <int VB>
__device__ __forceinline__ void pv_tile(f32x16* o, int vb0, bf16x8 pa0, bf16x8 pa1, bf16x8 pa2, bf16x8 pa3) {
#define TRRD(dst, off) asm volatile("ds_read_b64_tr_b16 %0, %1 offset:%2" : "=&v"(dst) : "v"(vb0), "i"(off) : "memory")
#define PV_D0(d0) do { s16x4 l0, l1, l2, l3, h0, h1, h2, h3; constexpr int b_ = VB * SHM_V + v_rd_off(d0, 0, 0); \
        TRRD(l0, b_); TRRD(h0, b_ + 2048); TRRD(l1, b_ + 4096); TRRD(h1, b_ + 6144); TRRD(l2, b_ + 8192); TRRD(h2, b_ + 10240); TRRD(l3, b_ + 12288); TRRD(h3, b_ + 14336); \
        asm volatile("s_waitcnt lgkmcnt(0)" ::: "memory"); SBAR(); \
        o[d0] = __builtin_amdgcn_mfma_f32_32x32x16_bf16(pa0, (bf16x8){l0[0], l0[1], l0[2], l0[3], h0[0], h0[1], h0[2], h0[3]}, o[d0], 0, 0, 0); \
        o[d0] = __builtin_amdgcn_mfma_f32_32x32x16_bf16(pa1, (bf16x8){l1[0], l1[1], l1[2], l1[3], h1[0], h1[1], h1[2], h1[3]}, o[d0], 0, 0, 0); \
        o[d0] = __builtin_amdgcn_mfma_f32_32x32x16_bf16(pa2, (bf16x8){l2[0], l2[1], l2[2], l2[3], h2[0], h2[1], h2[2], h2[3]}, o[d0], 0, 0, 0); \
        o[d0] = __builtin_amdgcn_mfma_f32_32x32x16_bf16(pa3, (bf16x8){l3[0], l3[1], l3[2], l3[3], h3[0], h3[1], h3[2], h3[3]}, o[d0], 0, 0, 0); } while (0)
    PV_D0(0); PV_D0(1); PV_D0(2); PV_D0(3);
#undef PV_D0
#undef TRRD
}
struct BlockRef { const bf16_t* Q; const bf16_t* K; const bf16_t* V; bf16_t* O; int P0; };
constexpr int NQR = 6;
constexpr int LDS_QS = 2 * SHM_V + 2 * SHM_K + NW * 64 * 4, LDS_TOTAL = LDS_QS + NW * (12 - NQR) * 1024;
struct Seam { bf16x8 qr[NQR]; };
__device__ __forceinline__ bf16x8 ldg8(const bf16_t* base, unsigned off) { return *reinterpret_cast<const bf16x8*>(base + off); }
#define VMW() asm volatile("s_waitcnt vmcnt(0)" ::: "memory")
#define SLOAD(Kp, Vp) do { const bf16_t* vp_ = (Vp); st_v0 = ldg8(vp_, voff); st_v1 = ldg8(vp_ + 32 * LDV, voff); \
        const bf16_t* kp_ = (Kp); st_k0 = ldg8(kp_, koff); st_k1 = ldg8(kp_ + 64, koff); st_k2 = ldg8(kp_ + 128, koff); } while (0)
#define SWRITE_K(bf) do { char* d_ = K_lds + (bf) * SHM_K + kws; *(bf16x8*)d_ = st_k0; *(bf16x8*)(d_ + 128) = st_k1; *(bf16x8*)(d_ + 256) = st_k2; } while (0)
#define SWRITE_V(bf) do { *(bf16x8*)(V_lds + (bf) * SHM_V + vst0) = st_v0; *(bf16x8*)(V_lds + (bf) * SHM_V + vst1) = st_v1; } while (0)
#define ATT_IDS() const int tid = threadIdx.x, wid = __builtin_amdgcn_readfirstlane(tid >> 6), lane = tid & 63, r32 = lane & 31, hi = lane >> 5; \
    const int sr = tid >> 4, sc = (tid & 15) * 8, kr = tid >> 3; const unsigned voff = (unsigned)(sr * LDV + sc), koff = (unsigned)(kr * LDK + (tid & 7) * 8), qoff = (unsigned)((wid * QBLK + r32) * LDQ + hi * 8); \
    const int kws = kr * KROWB + (tid & 7) * 16, vst0 = v_st(sr, sc), vst1 = v_st(32 + sr, sc); char* V_lds = lds; char* K_lds = lds + 2 * SHM_V; char* qs = lds + LDS_QS + wid * ((12 - NQR) * 1024) + lane * 16; \
    bf16x8 st_v0, st_v1, st_k0, st_k1, st_k2
__device__ __forceinline__ void attn_prime(const BlockRef& cur, char* lds, Seam& S) {
    ATT_IDS();
#pragma unroll
    for (int d0 = 0; d0 < NQR; ++d0) S.qr[d0] = ldg8(cur.Q + d0 * 16, qoff);
#pragma unroll
    for (int d0 = NQR; d0 < 12; ++d0) *(bf16x8*)(qs + (d0 - NQR) * 1024) = ldg8(cur.Q + d0 * 16, qoff);
    SLOAD(cur.K, cur.V); VMW(); SWRITE_K(0); SWRITE_V(0);
    __syncthreads();
}
template <int KB>
__device__ __forceinline__ void qkt(f32x16& p0, f32x16& p1, const char* K_lds, const char* qs, int r32, int hi, const bf16x8* qr) {
    p0 = f32x16{}; p1 = f32x16{};
    const char* a = K_lds + KB * SHM_K + r32 * KROWB + hi * 16;
    bf16x8 kA[3], kB[3], qv[3];
#define KL(d) do { kA[(d) % 3] = *reinterpret_cast<const bf16x8*>(a + (d) * 32); kB[(d) % 3] = *reinterpret_cast<const bf16x8*>(a + (d) * 32 + 32 * KROWB); \
        if ((d) >= NQR) qv[(d) % 3] = *reinterpret_cast<const bf16x8*>(qs + ((d) - NQR) * 1024); } while (0)
    KL(0); KL(1);
#pragma unroll
    for (int d0 = 0; d0 < 12; ++d0) {
        if (d0 + 2 < 12) KL(d0 + 2);
        SBAR();
        const bf16x8 q = d0 < NQR ? qr[d0 < NQR ? d0 : 0] : qv[d0 % 3];
        p0 = __builtin_amdgcn_mfma_f32_32x32x16_bf16(kA[d0 % 3], q, p0, 0, 0, 0);
        p1 = __builtin_amdgcn_mfma_f32_32x32x16_bf16(kB[d0 % 3], q, p1, 0, 0, 0);
        SBAR(); }
#undef KL
}
__device__ __forceinline__ void softmax_tile(f32x16& p0, f32x16& p1, float& m_reg, float& l_reg, float& alpha, bf16x8& pa0, bf16x8& pa1, bf16x8& pa2, bf16x8& pa3) {
    float pmax = p0[0];
#pragma unroll
    for (int r = 1; r < 16; ++r) pmax = fmaxf(pmax, p0[r]);
#pragma unroll
    for (int r = 0; r < 16; ++r) pmax = fmaxf(pmax, p1[r]);
    { auto rr = __builtin_amdgcn_permlane32_swap(__float_as_uint(pmax), __float_as_uint(pmax), false, false); pmax = fmaxf(__uint_as_float(rr[0]), __uint_as_float(rr[1])); }
    float mn;
    if (__builtin_expect(__all(pmax - m_reg <= THR), 1)) { mn = m_reg; alpha = 1.f; }
    else { mn = fmaxf(m_reg, pmax); alpha = __builtin_amdgcn_exp2f(m_reg - mn); m_reg = mn; }
#pragma unroll
    for (int r = 0; r < 16; ++r) { p0[r] = __builtin_amdgcn_exp2f(p0[r] - mn); p1[r] = __builtin_amdgcn_exp2f(p1[r] - mn); }
    float ps = 0.f;
#pragma unroll
    for (int r = 0; r < 16; ++r) ps += p0[r] + p1[r];
    { auto rr = __builtin_amdgcn_permlane32_swap(__float_as_uint(ps), __float_as_uint(ps), false, false); ps = __uint_as_float(rr[0]) + __uint_as_float(rr[1]); }
    l_reg = l_reg * alpha + ps;
#define PK4(P, B_, OUT) do { unsigned a0 = cvt_pk_bf16(P[B_+0], P[B_+1]), a1 = cvt_pk_bf16(P[B_+2], P[B_+3]); \
        unsigned b0 = cvt_pk_bf16(P[B_+4], P[B_+5]), b1 = cvt_pk_bf16(P[B_+6], P[B_+7]); \
        auto r0 = __builtin_amdgcn_permlane32_swap(a0, b0, false, false); auto r1 = __builtin_amdgcn_permlane32_swap(a1, b1, false, false); \
        u32x4 w = {r0[0], r1[0], r0[1], r1[1]}; OUT = *reinterpret_cast<bf16x8*>(&w); } while (0)
    PK4(p0, 0, pa0); PK4(p0, 8, pa1); PK4(p1, 0, pa2); PK4(p1, 8, pa3);
#undef PK4
}
__device__ __forceinline__ void attn_block(const BlockRef& cur, const BlockRef& nxt, char* lds, Seam& S) {
    ATT_IDS();
    const int NT = cur.P0 / KVBLK + 4;
    const int qlo = cur.P0 + wid * QBLK, qm = qlo + r32 - 4 * hi;
    float* ws = (float*)(lds + 2 * SHM_V + 2 * SHM_K) + wid * 64; float* li_l = ws, * al_l = ws + 32;
    float m_reg = -1e30f, l_reg = 0; f32x16 o[4] = {};
    const int vb0 = (int)(uintptr_t)V_lds + v_rd_base(lane);
    const bf16_t* Kh = cur.K; const bf16_t* Vh = cur.V;
    f32x16 p0, p1; float al; bf16x8 pa0, pa1, pa2, pa3;
    bf16x8 qx[12 - NQR];
#define RESC(a) do { if (__any((a) < 1.f)) { if (hi == 0) al_l[r32] = (a); asm volatile("s_waitcnt lgkmcnt(0)" ::: "memory"); \
                     _Pragma("unroll") for (int d_ = 0; d_ < 4; ++d_) _Pragma("unroll") for (int r = 0; r < 16; ++r) o[d_][r] *= al_l[crow(r, hi)]; } } while (0)
#define STEP(t, BF) do { const bool last_ = (t) + 1 >= NT; \
        SBAR(); qkt<BF>(p0, p1, K_lds, qs, r32, hi, S.qr); SBAR(); \
        { const bf16_t* kn_ = last_ ? nxt.K : Kh + (size_t)((t) + 1) * KVBLK * LDK; const bf16_t* vn_ = last_ ? nxt.V : Vh + (size_t)((t) + 1) * KVBLK * LDV; SLOAD(kn_, vn_); } \
        if (last_) { _Pragma("unroll") for (int d0 = 0; d0 < NQR; ++d0) S.qr[d0] = ldg8(nxt.Q + d0 * 16, qoff); \
                     _Pragma("unroll") for (int d0 = NQR; d0 < 12; ++d0) qx[d0 - NQR] = ldg8(nxt.Q + d0 * 16, qoff); } \
        SBAR(); \
        { const int kb_ = (t) * KVBLK; if (kb_ + KVBLK - 1 > qlo) mask_tile(p0, p1, qm - kb_); } \
        softmax_tile(p0, p1, m_reg, l_reg, al, pa0, pa1, pa2, pa3); RESC(al); SBAR(); \
        pv_tile<BF>(o, vb0, pa0, pa1, pa2, pa3); SBAR(); \
        VMW(); SWRITE_K((BF) ^ 1); SWRITE_V((BF) ^ 1); \
        if (last_) { _Pragma("unroll") for (int d0 = NQR; d0 < 12; ++d0) *(bf16x8*)(qs + (d0 - NQR) * 1024) = qx[d0 - NQR]; } \
        __syncthreads(); } while (0)
    for (int t = 0; t < NT; t += 2) { STEP(t, 0); STEP(t + 1, 1); }
    if (hi == 0) li_l[r32] = l_reg; asm volatile("s_waitcnt lgkmcnt(0)" ::: "memory");
    float rli[16];
#pragma unroll
    for (int r = 0; r < 16; ++r) rli[r] = __builtin_amdgcn_rcpf(li_l[crow(r, hi)]);
    bf16_t* Ow = cur.O; const unsigned ooff = (unsigned)((wid * QBLK + 4 * hi) * LDO + r32);
#pragma unroll
    for (int r = 0; r < 16; ++r) { const int orow = (r & 3) + 8 * (r >> 2);
#pragma unroll
        for (int d0 = 0; d0 < 4; ++d0) { const float v = o[d0][r] * rli[r]; const float vn = __shfl_xor(v, 1);
            if ((r32 & 1) == 0) *(unsigned*)(Ow + orow * LDO + d0 * 32 + ooff) = cvt_pk_bf16(v, vn); } }
#undef RESC
#undef STEP
}
#undef VMW
#undef SLOAD
#undef SWRITE_K
#undef SWRITE_V
#undef ATT_IDS
#undef SBAR
}

constexpr size_t MiB = 1u << 20;
constexpr size_t WS_RSTD0 = 0, WS_SSQ = 1 * MiB, WS_SSKV = 2 * MiB, WS_SS = 3 * MiB, WS_CS = 8 * MiB;
constexpr size_t WS_WPOOL = 16 * MiB, WS_WA = 18 * MiB, WS_WQB = 23 * MiB, WS_WKVB = 26 * MiB, WS_WO = 30 * MiB;
constexpr size_t WS_WGU0 = 38 * MiB, WS_WDN0 = 82 * MiB, WS_WGU1 = 104 * MiB, WS_WDN1 = 148 * MiB;
constexpr size_t WS_B0 = 170 * MiB, WS_B1 = 298 * MiB, WS_QA = 426 * MiB, WS_KVA = 458 * MiB;
constexpr size_t WS_Q = 490 * MiB, WS_K = 682 * MiB, WS_V = 874 * MiB, WS_MID = 490 * MiB, WS_END = 1002 * MiB;
constexpr int LDS_BYTES = 147456;
static_assert(att::LDS_TOTAL <= LDS_BYTES && att::LDS_BYTES <= pg8::STAGE_BYTES && pg8::STAGE_BYTES <= LDS_BYTES, "LDS map");

#ifndef PH_MASK
#define PH_MASK 0xFFF
#endif
#define PH_ON(k) (((PH_MASK) >> (k)) & 1)
struct Args { const float* in[19]; float* out; unsigned char* ws; int ph_lo, ph_hi; };

__device__ __forceinline__ float wave_sum(float v) {
#pragma unroll
    for (int o = 1; o < 64; o <<= 1) v += __shfl_xor(v, o);
    return v;
}
__device__ __forceinline__ int map_row(int mode, int n) {
    switch (mode) {
        case 1: return (n >> 7) * 256 + (n & 127);
        case 2: return (n >> 7) * 256 + 128 + (n & 127);
        case 3: { if (n < 512) return 512 + n; const int j = n - 512; return 1024 + 2 * (j & 31) + (j >> 5); }
        case 4: { const int h = n / 192, d = n % 192; if (d < 128) return h * 128 + d; const int j = d - 128; return 2048 + h * 64 + 2 * (j & 31) + (j >> 5); }
        case 5: { const int h = n >> 8, d = n & 255; return d < 128 ? h * 128 + d : 2048 + h * 128 + (d - 128); }
        default: return n;
    }
}
__device__ __forceinline__ void transpose_item(const float* W, int K, int N, bf16_t* WT, int mode, const float* ks, const float* cs, LAS float* scr, int item, int lane) {
    const int nblk = N / 32, kb = item / nblk, nb = item % nblk, k0 = 64 * kb, n0 = 32 * nb;
#pragma unroll 8
    for (int i = 0; i < 32; ++i) { const int kk = 2 * i + (lane >> 5); float v = W[(size_t)(k0 + kk) * N + n0 + (lane & 31)]; if (ks) v *= ks[k0 + kk]; scr[kk * 33 + (lane & 31)] = v; }
    asm volatile("s_waitcnt lgkmcnt(0)" ::: "memory");
    const int c = lane & 7;
#pragma unroll
    for (int j = 0; j < 4; ++j) { const int n = (lane >> 3) + 8 * j; const LAS float* s = scr + (8 * c) * 33 + n; const float csn = cs ? cs[n0 + n] : 1.f;
        u32x4 o; o.x = cvt_pk_bf16(s[0 * 33] * csn, s[1 * 33] * csn); o.y = cvt_pk_bf16(s[2 * 33] * csn, s[3 * 33] * csn); o.z = cvt_pk_bf16(s[4 * 33] * csn, s[5 * 33] * csn); o.w = cvt_pk_bf16(s[6 * 33] * csn, s[7 * 33] * csn);
        *(u32x4*)(WT + (size_t)map_row(mode, n0 + n) * K + k0 + 8 * c) = o; }
    asm volatile("s_waitcnt lgkmcnt(0)" ::: "memory");
}

__global__ void __launch_bounds__(512, 2) yoco_fwd(Args a) {
    extern __shared__ __attribute__((aligned(16))) unsigned char lds[];
    cg::grid_group grid = cg::this_grid();
    const int tid = threadIdx.x, lane = tid & 63, wave = __builtin_amdgcn_readfirstlane(tid >> 6);
    const int G = gridDim.x, bx = blockIdx.x, vcu = (G % 8 == 0) ? (bx % 8) * (G / 8) + bx / 8 : bx;
    const int gw = vcu * 8 + wave, NGW = G * 8;
    unsigned char* ws = a.ws;
    const float* x = a.in[0]; const int* positions = (const int*)a.in[1];
    float* out = a.out;
    float* rstd0 = (float*)(ws + WS_RSTD0); float* ssq = (float*)(ws + WS_SSQ); float* sskv = (float*)(ws + WS_SSKV); float* ss = (float*)(ws + WS_SS); float* cs = (float*)(ws + WS_CS);
    bf16_t* Wpool = (bf16_t*)(ws + WS_WPOOL); bf16_t* Wa = (bf16_t*)(ws + WS_WA); bf16_t* Wqb = (bf16_t*)(ws + WS_WQB); bf16_t* Wkvb = (bf16_t*)(ws + WS_WKVB); bf16_t* Wo = (bf16_t*)(ws + WS_WO);
    bf16_t* B0 = (bf16_t*)(ws + WS_B0); bf16_t* B1 = (bf16_t*)(ws + WS_B1); bf16_t* QA = (bf16_t*)(ws + WS_QA); bf16_t* KVA = (bf16_t*)(ws + WS_KVA);
    bf16_t* Qb = (bf16_t*)(ws + WS_Q); bf16_t* Kb = (bf16_t*)(ws + WS_K); bf16_t* Vb = (bf16_t*)(ws + WS_V); bf16_t* MID = (bf16_t*)(ws + WS_MID);
    LAS unsigned char* ldsl = (LAS unsigned char*)lds;
    const int lo = a.ph_lo, hi = a.ph_hi;
#define IN(k) (lo <= (k) && (k) < hi)
#define SEAM(k) do { if (IN(k) && IN((k) + 1)) grid.sync(); } while (0)

    if (PH_ON(0) && IN(0)) {
        LAS float* scr = (LAS float*)(ldsl + wave * 16384);
        constexpr int I_POOL = 8 * 16, I_GU = 32 * 176, I_DN = 88 * 64, I_QA = 32 * 16, I_KVA = 32 * 18, I_QB = 8 * 96, I_KVB = 8 * 128, I_WO = 32 * 64;
        constexpr int NITEMS = 4 * I_POOL + 2 * (2 * I_GU + I_DN) + I_QA + I_KVA + I_QB + I_KVB + I_WO;
        for (int it = gw; it < NITEMS; it += NGW) {
            int r = it;
#define JOB(cnt, W_, K_, N_, dst_, mode_, ks_, cs_) if (r < (cnt)) { transpose_item(W_, K_, N_, dst_, mode_, ks_, cs_, scr, r, lane); continue; } r -= (cnt);
            JOB(I_POOL, a.in[3] + 0 * 262144, 512, 512, Wpool + 0 * 262144, 0, a.in[2] + 0, a.in[4] + 0)
            JOB(I_POOL, a.in[3] + 1 * 262144, 512, 512, Wpool + 1 * 262144, 0, a.in[2] + 512, a.in[4] + 512)
            JOB(I_POOL, a.in[3] + 2 * 262144, 512, 512, Wpool + 2 * 262144, 0, a.in[2] + 1024, a.in[4] + 1024)
            JOB(I_POOL, a.in[3] + 3 * 262144, 512, 512, Wpool + 3 * 262144, 0, a.in[2] + 1536, a.in[4] + 1536)
            JOB(I_GU, a.in[15], DM, DFF, (bf16_t*)(ws + WS_WGU0), 1, a.in[14], nullptr)
            JOB(I_GU, a.in[16], DM, DFF, (bf16_t*)(ws + WS_WGU0), 2, a.in[14], nullptr)
            JOB(I_DN, a.in[17], DFF, DM, (bf16_t*)(ws + WS_WDN0), 0, nullptr, nullptr)
            JOB(I_GU, a.in[15] + (size_t)DM * DFF, DM, DFF, (bf16_t*)(ws + WS_WGU1), 1, a.in[14] + DM, nullptr)
            JOB(I_GU, a.in[16] + (size_t)DM * DFF, DM, DFF, (bf16_t*)(ws + WS_WGU1), 2, a.in[14] + DM, nullptr)
            JOB(I_DN, a.in[17] + (size_t)DM * DFF, DFF, DM, (bf16_t*)(ws + WS_WDN1), 0, nullptr, nullptr)
            JOB(I_QA, a.in[10], DM, 512, Wa, 0, a.in[9], nullptr)
            JOB(I_KVA, a.in[6], DM, 576, Wa, 3, a.in[5], nullptr)
            JOB(I_QB, a.in[12], 512, 3072, Wqb, 4, a.in[11], nullptr)
            JOB(I_KVB, a.in[8], 512, 4096, Wkvb, 5, a.in[7], nullptr)
            JOB(I_WO, a.in[13], DM, DM, Wo, 0, nullptr, nullptr)
#undef JOB
        }
        for (int m = gw; m < T; m += NGW) {
            const f32x4* xr = (const f32x4*)(x + (size_t)m * DM) + lane; float s = 0.f;
#pragma unroll
            for (int j = 0; j < 8; ++j) s += sq4(xr[64 * j]);
            s = wave_sum(s);
            if (lane == 0) rstd0[m] = __builtin_amdgcn_rsqf(s * (1.f / DM) + EPS);
            if (lane < 32) {
                const float invf = (float)exp2(-(double)lane * (13.287712379549449 / 32.0));
                const float ang = (float)positions[m] * invf;
                double rev = (double)ang * 0.15915494309189535; rev -= rint(rev);
                const float rf = (float)rev;
                *(f32x2*)(cs + ((size_t)m * 32 + lane) * 2) = (f32x2){__builtin_amdgcn_cosf(rf), __builtin_amdgcn_sinf(rf)};
            }
        }
    }
    SEAM(0);
    if (PH_ON(1) && IN(1)) {
        for (int item = gw; item < (T / 64) * 8; item += NGW) {
            const int slab = item & 7, chunk = item >> 3, t0 = chunk * 64, c0 = slab * 256 + lane * 4, w = 2 << (slab >> 1), tin0 = t0 & (SEQ - 1);
            const float* xc = x + c0; f32x4 s = {0.f, 0.f, 0.f, 0.f};
            for (int j = 1; j < w; ++j) if (tin0 - j >= 0) s += *(const f32x4*)(xc + (size_t)(t0 - j) * DM) * rstd0[t0 - j];
#pragma unroll 4
            for (int i = 0; i < 64; ++i) { const int t = t0 + i, tin = tin0 + i;
                const f32x4 h = *(const f32x4*)(xc + (size_t)t * DM) * rstd0[t]; s += h;
                const int cnt = tin + 1 < w ? tin + 1 : w; const f32x4 d = s * (1.f / (float)cnt) - h;
                u32x2 o; o.x = cvt_pk_bf16(d[0], d[1]); o.y = cvt_pk_bf16(d[2], d[3]); *(u32x2*)(B0 + (size_t)t * DM + c0) = o;
                if (tin - w + 1 >= 0) s -= *(const f32x4*)(xc + (size_t)(t - w + 1) * DM) * rstd0[t - w + 1]; }
        }
    }
    SEAM(1);
    if (PH_ON(2) && IN(2)) {
        pg8::Gemm g{B0, Wpool, DM, 512, 512, 512, 262144}; pg8::Order S; S.init(T, 512, 4, G, bx);
        pg8::EpiResid E{x, out, B1, ss, 512};
        pg8::gemm_phase(ldsl, g, S, E);
    }
    SEAM(2);
    if (PH_ON(3) && IN(3)) {
        pg8::Gemm g{B1, (const bf16_t*)(ws + WS_WGU0), DM, DM, DM, 0, 0}; pg8::Order S; S.init(T, 2 * DFF, 1, G, bx);
        pg8::EpiSwiGLU E{MID, ss};
        pg8::gemm_phase(ldsl, g, S, E);
    }
    SEAM(3);
    if (PH_ON(4) && IN(4)) {
        pg8::Gemm g{MID, (const bf16_t*)(ws + WS_WDN0), DFF, DFF, DFF, 0, 0}; pg8::Order S; S.init(T, DM, 1, G, bx);
        pg8::EpiResid E{out, out, B0, ss, 0};
        pg8::gemm_phase(ldsl, g, S, E);
    }
    SEAM(4);
    if (PH_ON(5) && IN(5)) {
        pg8::Gemm g{B0, Wa, DM, DM, DM, 0, 0}; pg8::Order S; S.init(T, 1280, 1, G, bx);
        pg8::EpiA E{ss, QA, KVA, ssq, sskv, Kb, cs};
        pg8::gemm_phase(ldsl, g, S, E);
    }
    SEAM(5);
    if (PH_ON(6) && IN(6)) {
        { pg8::Gemm g{QA, Wqb, 512, 512, 512, 0, 0}; pg8::Order S; S.init(T, 3072, 1, G, bx);
          pg8::EpiQ E{ssq, Qb, cs}; pg8::gemm_phase(ldsl, g, S, E); }
        { pg8::Gemm g{KVA, Wkvb, 512, 512, 512, 0, 0}; pg8::Order S; S.init(T, 4096, 1, G, bx);
          pg8::EpiKV E{sskv, Kb, Vb}; pg8::gemm_phase(ldsl, g, S, E); }
    }
    SEAM(6);
    if (PH_ON(7) && IN(7)) {
        for (int sid = vcu; sid < 256; sid += G) {
            const int bh = sid >> 2, s4 = sid & 3, b = bh >> 4, h = bh & 15;
            const bf16_t* Qh = Qb + (size_t)b * SEQ * 3072 + h * 192; const bf16_t* Kh = Kb + (size_t)b * SEQ * 3072 + h * 192;
            const bf16_t* Vh = Vb + (size_t)b * SEQ * 2048 + h * 128; bf16_t* Oh = B1 + (size_t)b * SEQ * 2048 + h * 128;
#define QBI(i) ((((i) >> 1) * 8) + (((i) & 1) ? 7 - s4 : s4))
#define MKREF(r, i) do { const int qb_ = QBI(i); r.Q = Qh + (size_t)qb_ * 256 * 3072; r.K = Kh; r.V = Vh; r.O = Oh + (size_t)qb_ * 256 * 2048; r.P0 = qb_ * 256; } while (0)
            att::BlockRef cur, nxt; MKREF(cur, 0);
            att::Seam S;
            att::attn_prime(cur, (char*)lds, S);
            for (int i = 0; i < 8; ++i) {
                if (i < 7) MKREF(nxt, i + 1); else nxt = cur;
                att::attn_block(cur, nxt, (char*)lds, S);
                cur = nxt;
            }
            asm volatile("s_waitcnt vmcnt(0)" ::: "memory"); __syncthreads();
#undef QBI
#undef MKREF
        }
    }
    SEAM(7);
    if (PH_ON(8) && IN(8)) {
        pg8::Gemm g{B1, Wo, DM, DM, DM, 0, 0}; pg8::Order S; S.init(T, DM, 1, G, bx);
        pg8::EpiResid E{out, out, B0, ss, 0};
        pg8::gemm_phase(ldsl, g, S, E);
    }
    SEAM(8);
    if (PH_ON(9) && IN(9)) {
        pg8::Gemm g{B0, (const bf16_t*)(ws + WS_WGU1), DM, DM, DM, 0, 0}; pg8::Order S; S.init(T, 2 * DFF, 1, G, bx);
        pg8::EpiSwiGLU E{MID, ss};
        pg8::gemm_phase(ldsl, g, S, E);
    }
    SEAM(9);
    if (PH_ON(10) && IN(10)) {
        pg8::Gemm g{MID, (const bf16_t*)(ws + WS_WDN1), DFF, DFF, DFF, 0, 0}; pg8::Order S; S.init(T, DM, 1, G, bx);
        pg8::EpiResid E{out, out, nullptr, ss, 0};
        pg8::gemm_phase(ldsl, g, S, E);
    }
    SEAM(10);
    if (PH_ON(11) && IN(11)) {
        const float* fg = a.in[18];
        for (int m = gw; m < T; m += NGW) {
            float s = lane < 32 ? ss[(size_t)m * 32 + lane] : 0.f; s = wave_sum(s);
            const float r = __builtin_amdgcn_rsqf(s * (1.f / DM) + EPS);
            f32x4* xr = (f32x4*)(out + (size_t)m * DM) + lane; const f32x4* gr = (const f32x4*)fg + lane;
#pragma unroll
            for (int j = 0; j < 8; ++j) { const f32x4 v = xr[64 * j]; xr[64 * j] = v * r * gr[64 * j]; }
        }
    }
#undef IN
#undef SEAM
}

extern "C" void kernel_launch(void* const* d_in, const int* in_sizes, int n_in, void* d_out, int out_size, void* d_ws, size_t ws_size, hipStream_t stream) {
    static int grid = 0;
    if (grid == 0) {
        if (n_in != 19 || in_sizes[0] != T * DM || out_size != T * DM || ws_size < WS_END) { fprintf(stderr, "kernel_launch: shape/workspace mismatch (n_in %d, in0 %d, out %d, ws %zu < %zu)\n", n_in, n_in > 0 ? in_sizes[0] : -1, out_size, ws_size, (size_t)WS_END); grid = -1; return; }
        int dev = 0, cus = 0, per_cu = 0;
        (void)hipGetDevice(&dev); (void)hipDeviceGetAttribute(&cus, hipDeviceAttributeMultiprocessorCount, dev);
        if (hipFuncSetAttribute((const void*)yoco_fwd, hipFuncAttributeMaxDynamicSharedMemorySize, LDS_BYTES) != hipSuccess) { fprintf(stderr, "kernel_launch: hipFuncSetAttribute failed\n"); grid = -1; return; }
        if (hipOccupancyMaxActiveBlocksPerMultiprocessor(&per_cu, (const void*)yoco_fwd, 512, LDS_BYTES) != hipSuccess || per_cu < 1) { fprintf(stderr, "kernel_launch: occupancy query says %d\n", per_cu); per_cu = 1; }
        (void)hipGetLastError();
        grid = cus * per_cu;
        if (grid <= 0) grid = 256;
    }
    if (grid < 0) return;
    Args a{};
    for (int i = 0; i < 19; ++i) a.in[i] = (const float*)d_in[i];
    a.out = (float*)d_out; a.ws = (unsigned char*)d_ws; a.ph_lo = 0; a.ph_hi = 12;
    void* args[] = {&a};
    hipError_t e = hipLaunchCooperativeKernel((const void*)yoco_fwd, dim3(grid), dim3(512), args, LDS_BYTES, stream);
    if (e != hipSuccess) fprintf(stderr, "cooperative launch failed: %s (grid %d)\n", hipGetErrorString(e), grid);
}
```

```cpp
#include <hip/hip_runtime.h>
#include <hip/hip_cooperative_groups.h>
#include <cstdio>
#include <cstdint>
namespace cg = cooperative_groups;

#define LAS __attribute__((address_space(3)))
typedef unsigned short bf16_t;
typedef short bf16x8 __attribute__((ext_vector_type(8)));
typedef short s16x4 __attribute__((ext_vector_type(4)));
typedef float f32x2 __attribute__((ext_vector_type(2)));
typedef float f32x4 __attribute__((ext_vector_type(4)));
typedef float f32x16 __attribute__((ext_vector_type(16)));
typedef unsigned u32x2 __attribute__((ext_vector_type(2)));
typedef unsigned u32x4 __attribute__((ext_vector_type(4)));

constexpr int DM = 2048, NB = 4, SEQ = 8192, T = NB * SEQ, DFF = 5632, NH = 16;
constexpr float EPS = 1e-6f;
constexpr float C2Q = 0.07216878364870322f * 1.4426950408889634f;

__device__ __forceinline__ unsigned cvt_pk_bf16(float lo, float hi) { unsigned r; asm volatile("v_cvt_pk_bf16_f32 %0, %1, %2" : "=v"(r) : "v"(lo), "v"(hi)); return r; }
__device__ __forceinline__ u32x4 pack8(f32x4 a, f32x4 b) { u32x4 w; w.x = cvt_pk_bf16(a[0], a[1]); w.y = cvt_pk_bf16(a[2], a[3]); w.z = cvt_pk_bf16(b[0], b[1]); w.w = cvt_pk_bf16(b[2], b[3]); return w; }
__device__ __forceinline__ float sq4(f32x4 v) { return (v[0] * v[0] + v[1] * v[1]) + (v[2] * v[2] + v[3] * v[3]); }

namespace pg8 {
constexpr int BM = 256, BK = 64, HALF = 128, HTB = HALF * BK * 2, STAGE_BYTES = 8 * HTB, NXCD = 8, WGM = 8;
__host__ __device__ __forceinline__ int lds_byte(int r, int c) { const int st = (r >> 4) * 2 + (c >> 5), rr = r & 15, cc = c & 31, ob = rr * 64 + cc * 2; return st * 1024 + (ob ^ (((ob >> 9) & 1) << 5)); }
__host__ __device__ __forceinline__ void stage_rc(int b, int& R, int& C) { const int st = b / 1024, sb = b % 1024, swz = sb ^ (((sb >> 9) & 1) << 5); R = (st >> 1) * 16 + swz / 64; C = (st & 1) * 32 + (swz % 64) / 2; }
__host__ __device__ __forceinline__ int perm32(int rho) { const int n = rho >> 4, i = rho & 15; return 8 * (i >> 2) + 4 * n + (i & 3); }

struct Unit { int pm, pn, grp; };
struct Gemm { const bf16_t* A; const bf16_t* Bt; int lda, ldb, K; long grpA, grpB; };

struct Order {
    int nM, nN, nwg, nG, G, c;
    __device__ void init(int M, int N, int nG_, int G_, int c_) { nM = M / BM; nN = N / BM; nwg = nM * nN; nG = nG_; G = G_; c = c_; }
    __device__ bool next(int i, Unit& u) const {
        const long L = (long)i * G + c; if (L >= (long)nwg * nG) return false;
        u.grp = (int)(L / nwg); int wgid = (int)(L % nwg);
        { const int q = nwg / NXCD, r = nwg % NXCD, xcd = wgid % NXCD, off = wgid / NXCD; wgid = (xcd < r ? xcd * (q + 1) : r * (q + 1) + (xcd - r) * q) + off; }
        const int nig = WGM * nN, gid = wgid / nig, fm = gid * WGM, gsz = (nM - fm) < WGM ? (nM - fm) : WGM;
        u.pm = fm + ((wgid % nig) % gsz); u.pn = (wgid % nig) / gsz; return true;
    }
};

template <class Epi>
__device__ __forceinline__ void gemm_phase(LAS unsigned char* lds, const Gemm g, const Order& S, const Epi& E) {
    const int tid = threadIdx.x, wid = __builtin_amdgcn_readfirstlane(tid >> 6), lane = tid & 63, wr = wid >> 2, wc = wid & 3, fr = lane & 15, fq = lane >> 4;
    const int K = g.K, nt = K / BK;
    unsigned voffA[2], voffB[2];
#pragma unroll
    for (int i = 0; i < 2; ++i) { int R, C; stage_rc(tid * 16 + i * 8192, R, C); const int Rb = (R & ~31) + perm32(R & 31);
        voffA[i] = (unsigned)(R * g.lda + C) * 2u; voffB[i] = (unsigned)(Rb * g.ldb + C) * 2u; }
    const size_t kstep = (size_t)(BK * 2);
    const size_t hstepA = (size_t)HALF * g.lda * 2, hstepB = (size_t)HALF * g.ldb * 2;
    const size_t tstepA = 2 * hstepA, tstepB = 2 * hstepB;
    const unsigned ldsw = (unsigned)wid * 1024u;
    const int aoff = lds_byte(wr * 64 + fr, fq * 8), boff = lds_byte(wc * 32 + fr, fq * 8);
#define PG8_SA(b, h) (((b) * 2 + (h)) * HTB)
#define PG8_SB(b, h) ((4 + (b) * 2 + (h)) * HTB)
#define PG8_STAGE(bufoff, gbase, voff) do { _Pragma("unroll") for (int _i = 0; _i < 2; ++_i) \
        __builtin_amdgcn_global_load_lds((const unsigned*)((const char*)(gbase) + (voff)[_i]), (LAS unsigned*)(lds + (bufoff) + ldsw + _i * 8192), 16, 0, 0); } while (0)
#define PG8_LDA(dst, b, h) do { _Pragma("unroll") for (int m = 0; m < 4; ++m) _Pragma("unroll") for (int k = 0; k < 2; ++k) dst[m][k] = *(const LAS bf16x8*)(lds + PG8_SA(b, h) + aoff + m * 2048 + k * 1024); } while (0)
#define PG8_LDB(dst, b, h) do { _Pragma("unroll") for (int n = 0; n < 2; ++n) _Pragma("unroll") for (int k = 0; k < 2; ++k) dst[n][k] = *(const LAS bf16x8*)(lds + PG8_SB(b, h) + boff + n * 2048 + k * 1024); } while (0)
#define PG8_MMA(ai, bj, At, Bt) do { __builtin_amdgcn_s_setprio(1); _Pragma("unroll") for (int m = 0; m < 4; ++m) _Pragma("unroll") for (int n = 0; n < 2; ++n) _Pragma("unroll") for (int k = 0; k < 2; ++k) \
        acc[ai][bj][m][n] = __builtin_amdgcn_mfma_f32_16x16x32_bf16(Bt[n][k], At[m][k], acc[ai][bj][m][n], 0, 0, 0); __builtin_amdgcn_s_setprio(0); } while (0)
#define PG8_WAIT_V(n) asm volatile("s_waitcnt vmcnt(" #n ")" ::: "memory")
#define PG8_WAIT_L(n) asm volatile("s_waitcnt lgkmcnt(" #n ")" ::: "memory")
#define PG8_BAR __builtin_amdgcn_s_barrier()
#define PG8_SCHED __builtin_amdgcn_sched_barrier(0)
    Unit cur, nxt; int ui = 0;
    if (!S.next(0, cur)) return;
    f32x4 acc[2][2][4][2];
#pragma unroll
    for (int a = 0; a < 2; ++a)
#pragma unroll
        for (int b = 0; b < 2; ++b)
#pragma unroll
            for (int m = 0; m < 4; ++m)
#pragma unroll
                for (int n = 0; n < 2; ++n) acc[a][b][m][n] = (f32x4){0.f, 0.f, 0.f, 0.f};
    bf16x8 At[4][2], B0[2][2], B1[2][2];
    const char* cA = (const char*)(g.A + (size_t)cur.grp * g.grpA) + (size_t)cur.pm * tstepA;
    const char* cB = (const char*)(g.Bt + (size_t)cur.grp * g.grpB) + (size_t)cur.pn * tstepB;
    PG8_STAGE(PG8_SB(0, 0), cB, voffB); PG8_STAGE(PG8_SB(0, 1), cB + hstepB, voffB); PG8_STAGE(PG8_SA(0, 0), cA, voffA); PG8_STAGE(PG8_SA(0, 1), cA + hstepA, voffA);
    if (wr == 1) PG8_BAR;
    PG8_WAIT_V(2); PG8_BAR;
    PG8_STAGE(PG8_SB(1, 0), cB + kstep, voffB); PG8_STAGE(PG8_SA(1, 0), cA + kstep, voffA); PG8_STAGE(PG8_SB(1, 1), cB + hstepB + kstep, voffB);
    PG8_WAIT_V(6); PG8_BAR;
    for (;;) {
        const bool has_next = S.next(ui + 1, nxt);
        const char* nA = has_next ? (const char*)(g.A + (size_t)nxt.grp * g.grpA) + (size_t)nxt.pm * tstepA : cA;
        const char* nB = has_next ? (const char*)(g.Bt + (size_t)nxt.grp * g.grpB) + (size_t)nxt.pn * tstepB : cB;
        for (int t = 0; t < nt; t += 2) {
            const bool last = (t == nt - 2);
            const char* a1 = cA + (size_t)(t + 1) * kstep;
            const char* a2 = last ? nA : cA + (size_t)(t + 2) * kstep; const char* b2 = last ? nB : cB + (size_t)(t + 2) * kstep;
            const char* a3 = a2 + kstep; const char* b3 = b2 + kstep;
            PG8_LDB(B0, 0, 0); PG8_LDB(B1, 0, 1); PG8_SCHED; PG8_LDA(At, 0, 0); PG8_STAGE(PG8_SA(1, 1), a1 + hstepA, voffA);
            PG8_WAIT_V(8); PG8_WAIT_L(0); PG8_BAR; PG8_MMA(0, 0, At, B0); PG8_MMA(0, 1, At, B1); PG8_BAR; PG8_SCHED;
            PG8_LDA(At, 0, 1); PG8_STAGE(PG8_SB(0, 0), b2, voffB); PG8_STAGE(PG8_SB(0, 1), b2 + hstepB, voffB); PG8_STAGE(PG8_SA(0, 0), a2, voffA);
            PG8_WAIT_V(8); PG8_WAIT_L(0); PG8_BAR; PG8_MMA(1, 0, At, B0); PG8_MMA(1, 1, At, B1); PG8_BAR; PG8_SCHED;
            PG8_LDB(B0, 1, 0); PG8_LDB(B1, 1, 1); PG8_SCHED; PG8_LDA(At, 1, 0); PG8_STAGE(PG8_SA(0, 1), a2 + hstepA, voffA);
            PG8_WAIT_V(8); PG8_WAIT_L(0); PG8_BAR; PG8_MMA(0, 0, At, B0); PG8_MMA(0, 1, At, B1); PG8_BAR; PG8_SCHED;
            PG8_LDA(At, 1, 1); PG8_STAGE(PG8_SB(1, 0), b3, voffB); PG8_STAGE(PG8_SB(1, 1), b3 + hstepB, voffB); PG8_STAGE(PG8_SA(1, 0), a3, voffA);
            PG8_WAIT_V(8); PG8_WAIT_L(0); PG8_BAR; PG8_MMA(1, 0, At, B0); PG8_MMA(1, 1, At, B1); PG8_BAR; PG8_SCHED;
        }
        if (wr == 0) PG8_BAR;
        E(acc, cur, wr, wc, fr, fq);
        if (!has_next) break;
#pragma unroll
        for (int a = 0; a < 2; ++a)
#pragma unroll
            for (int b = 0; b < 2; ++b)
#pragma unroll
                for (int m = 0; m < 4; ++m)
#pragma unroll
                    for (int n = 0; n < 2; ++n) acc[a][b][m][n] = (f32x4){0.f, 0.f, 0.f, 0.f};
        cur = nxt; cA = nA; cB = nB; ++ui;
        if (wr == 1) PG8_BAR;
    }
    PG8_WAIT_V(0);
    PG8_BAR;
#undef PG8_SA
#undef PG8_SB
#undef PG8_STAGE
#undef PG8_LDA
#undef PG8_LDB
#undef PG8_MMA
#undef PG8_WAIT_V
#undef PG8_WAIT_L
#undef PG8_BAR
#undef PG8_SCHED
}

template <int NP> __device__ __forceinline__ float row_rstd(const float* ss, int row, int fq, float invn) {
    const float* p = ss + (size_t)row * NP + fq * (NP / 4); float s;
    if constexpr (NP == 32) { const f32x4 a = *(const f32x4*)p, b = *(const f32x4*)(p + 4); s = ((a[0] + a[1]) + (a[2] + a[3])) + ((b[0] + b[1]) + (b[2] + b[3])); }
    else { const f32x2 a = *(const f32x2*)p; s = a[0] + a[1]; }
    s += __shfl_xor(s, 16); s += __shfl_xor(s, 32);
    return __builtin_amdgcn_rsqf(s * invn + EPS);
}
__device__ __forceinline__ float rowsum4(float q) { q += __shfl_xor(q, 16); q += __shfl_xor(q, 32); return q; }

struct EpiResid {
    const float* base; float* out; bf16_t* xb; float* ss; int colgrp; int dry;
    __device__ __forceinline__ void operator()(const f32x4 (&acc)[2][2][4][2], const Unit& u, int wr, int wc, int fr, int fq) const {
        const int row0 = u.pm * BM + wr * 64 + fr, colb = u.grp * colgrp + u.pn * BM, col0 = colb + wc * 32 + 8 * fq, pidx = (colb >> 6) + wc;
        f32x4 pre[3][4];
#define RB_LOAD(it, P) do { const size_t off_ = (size_t)(row0 + ((it) >> 2) * HALF + ((it) & 3) * 16) * DM + col0; \
        P[0] = *(const f32x4*)(base + off_); P[1] = *(const f32x4*)(base + off_ + 4); P[2] = *(const f32x4*)(base + off_ + HALF); P[3] = *(const f32x4*)(base + off_ + HALF + 4); } while (0)
        RB_LOAD(0, pre[0]); RB_LOAD(1, pre[1]);
#pragma unroll
        for (int it = 0; it < 8; ++it) { const int ai = it >> 2, m = it & 3, row = row0 + ai * HALF + m * 16; const size_t off = (size_t)row * DM + col0; float q = 0.f;
            if (it + 2 < 8) RB_LOAD(it + 2, pre[(it + 2) % 3]);
#pragma unroll
            for (int bj = 0; bj < 2; ++bj) {
                const f32x4 v0 = acc[ai][bj][m][0] + pre[it % 3][2 * bj], v1 = acc[ai][bj][m][1] + pre[it % 3][2 * bj + 1];
                if (!dry) { *(f32x4*)(out + off + bj * HALF) = v0; *(f32x4*)(out + off + bj * HALF + 4) = v1; }
                if (xb) *(u32x4*)(xb + off + bj * HALF) = pack8(v0, v1);
                q += sq4(v0) + sq4(v1); }
            q = rowsum4(q); if (fq == 0) ss[(size_t)row * 32 + pidx] = q; }
#undef RB_LOAD
    }
};
struct EpiSwiGLU {
    bf16_t* mid; const float* ss;
    __device__ __forceinline__ void operator()(const f32x4 (&acc)[2][2][4][2], const Unit& u, int wr, int wc, int fr, int fq) const {
        const int row0 = u.pm * BM + wr * 64 + fr, col0 = u.pn * HALF + wc * 32 + 8 * fq;
#pragma unroll
        for (int ai = 0; ai < 2; ++ai)
#pragma unroll
            for (int m = 0; m < 4; ++m) { const int row = row0 + ai * HALF + m * 16; const float s = row_rstd<32>(ss, row, fq, 1.f / DM);
                f32x4 h[2];
#pragma unroll
                for (int n = 0; n < 2; ++n) { const f32x4 gg = acc[ai][0][m][n] * s, uu = acc[ai][1][m][n] * s;
#pragma unroll
                    for (int e = 0; e < 4; ++e) h[n][e] = gg[e] * __builtin_amdgcn_rcpf(1.f + __builtin_amdgcn_exp2f(-1.4426950408889634f * gg[e])) * uu[e]; }
                *(u32x4*)(mid + (size_t)row * DFF + col0) = pack8(h[0], h[1]); }
    }
};
__device__ __forceinline__ void rope8(f32x4& v0, f32x4& v1, const float* cs  ) {
    const f32x4 c0 = *(const f32x4*)cs, c1 = *(const f32x4*)(cs + 4);
    const f32x4 a = v0, b = v1;
    v0 = (f32x4){a[0] * c0[0] - a[1] * c0[1], a[1] * c0[0] + a[0] * c0[1], a[2] * c0[2] - a[3] * c0[3], a[3] * c0[2] + a[2] * c0[3]};
    v1 = (f32x4){b[0] * c1[0] - b[1] * c1[1], b[1] * c1[0] + b[0] * c1[1], b[2] * c1[2] - b[3] * c1[3], b[3] * c1[2] + b[2] * c1[3]};
}
struct EpiA {
    const float* ss; bf16_t* qa; bf16_t* kva; float* ssq; float* sskv; bf16_t* Kb; const float* cs;
    __device__ __forceinline__ void operator()(const f32x4 (&acc)[2][2][4][2], const Unit& u, int wr, int wc, int fr, int fq) const {
        const int row0 = u.pm * BM + wr * 64 + fr;
        if (u.pn < 4) {
            bf16_t* dst = u.pn < 2 ? qa : kva; float* sso = u.pn < 2 ? ssq : sskv; const int colb = (u.pn & 1) * BM, col0 = colb + wc * 32 + 8 * fq, pidx = (u.pn & 1) * 4 + wc;
#pragma unroll
            for (int ai = 0; ai < 2; ++ai)
#pragma unroll
                for (int m = 0; m < 4; ++m) { const int row = row0 + ai * HALF + m * 16; const float s = row_rstd<32>(ss, row, fq, 1.f / DM); float q = 0.f;
#pragma unroll
                    for (int bj = 0; bj < 2; ++bj) { const f32x4 v0 = acc[ai][bj][m][0] * s, v1 = acc[ai][bj][m][1] * s;
                        *(u32x4*)(dst + (size_t)row * 512 + col0 + bj * HALF) = pack8(v0, v1); q += sq4(v0) + sq4(v1); }
                    q = rowsum4(q); if (fq == 0) sso[(size_t)row * 8 + pidx] = q; }
        } else {
            const int p0 = wc * 32 + 8 * fq;
#pragma unroll
            for (int ai = 0; ai < 2; ++ai)
#pragma unroll
                for (int m = 0; m < 4; ++m) { const int row = row0 + ai * HALF + m * 16; const float s = row_rstd<32>(ss, row, fq, 1.f / DM);
                    if (wc < 2) { f32x4 v0 = acc[ai][0][m][0] * s, v1 = acc[ai][0][m][1] * s; rope8(v0, v1, cs + ((size_t)row * 32 + (p0 >> 1)) * 2);
                        const u32x4 w = pack8(v0, v1); bf16_t* kp = Kb + (size_t)row * 3072 + 128 + p0;
#pragma unroll
                        for (int h = 0; h < NH; ++h) *(u32x4*)(kp + h * 192) = w; } }
        }
    }
};
struct EpiQ {
    const float* ssq; bf16_t* Q; const float* cs;
    __device__ __forceinline__ void operator()(const f32x4 (&acc)[2][2][4][2], const Unit& u, int wr, int wc, int fr, int fq) const {
        const int row0 = u.pm * BM + wr * 64 + fr;
#pragma unroll
        for (int ai = 0; ai < 2; ++ai)
#pragma unroll
            for (int m = 0; m < 4; ++m) { const int row = row0 + ai * HALF + m * 16; const float s = row_rstd<8>(ssq, row, fq, 1.f / 512.f) * C2Q;
#pragma unroll
                for (int bj = 0; bj < 2; ++bj) { f32x4 v0 = acc[ai][bj][m][0] * s, v1 = acc[ai][bj][m][1] * s;
                    if (u.pn < 8) { *(u32x4*)(Q + (size_t)row * 3072 + (2 * u.pn + bj) * 192 + wc * 32 + 8 * fq) = pack8(v0, v1); }
                    else { const int head = 4 * (u.pn - 8) + 2 * bj + (wc >> 1), p0 = 32 * (wc & 1) + 8 * fq; rope8(v0, v1, cs + ((size_t)row * 32 + (p0 >> 1)) * 2);
                        *(u32x4*)(Q + (size_t)row * 3072 + head * 192 + 128 + p0) = pack8(v0, v1); } } }
    }
};
struct EpiKV {
    const float* sskv; bf16_t* Kb; bf16_t* Vb;
    __device__ __forceinline__ void operator()(const f32x4 (&acc)[2][2][4][2], const Unit& u, int wr, int wc, int fr, int fq) const {
        const int row0 = u.pm * BM + wr * 64 + fr;
#pragma unroll
        for (int ai = 0; ai < 2; ++ai)
#pragma unroll
            for (int m = 0; m < 4; ++m) { const int row = row0 + ai * HALF + m * 16; const float s = row_rstd<8>(sskv, row, fq, 1.f / 512.f);
#pragma unroll
                for (int bj = 0; bj < 2; ++bj) { const f32x4 v0 = acc[ai][bj][m][0] * s, v1 = acc[ai][bj][m][1] * s;
                    bf16_t* d = u.pn < 8 ? Kb + (size_t)row * 3072 + (2 * u.pn + bj) * 192 + wc * 32 + 8 * fq : Vb + (size_t)row * 2048 + (2 * (u.pn - 8) + bj) * 128 + wc * 32 + 8 * fq;
                    *(u32x4*)d = pack8(v0, v1); } }
    }
};
}

namespace att {
constexpr int NW = 8, QBLK = 32, KVBLK = 64, QB = 256;
constexpr int LDQ = 3072, LDK = 3072, LDV = 2048, LDO = 2048;
constexpr int KROWB = 400;
constexpr int SHM_K = KVBLK * KROWB, SHM_V = KVBLK * 128 * 2;
constexpr int NQR = 12;
constexpr int LDS_K0 = 3 * SHM_V, LDS_WS = LDS_K0 + 2 * SHM_K, LDS_QS = LDS_WS + NW * 64 * 4, LDS_TOTAL = LDS_QS + NW * (12 - NQR) * 1024;
constexpr float THR = 8.f;
#define SBAR() __builtin_amdgcn_sched_barrier(0)
__device__ __forceinline__ int v_st(int k, int c) { const int kk = (k & ~0xC) | ((k & 4) << 1) | ((k & 8) >> 1); return ((kk >> 3) * 4 + (c >> 5)) * 512 + ((kk & 7) * 32 + (c & 31)) * 2; }
__device__ __forceinline__ int v_rd_base(int lane) { return ((lane & 3) << 3) | (((lane >> 2) & 3) << 6) | (((lane >> 4) & 1) << 5) | (((lane >> 5) & 1) << 8); }
constexpr int v_rd_off(int d0, int ks, int half) { return d0 * 512 + ks * 4096 + half * 2048; }
__device__ __forceinline__ int crow(int r, int hi) { return (r & 3) + 8 * (r >> 2) + 4 * hi; }
__device__ __forceinline__ bf16x8 ldg8(const bf16_t* base, unsigned off) { return *reinterpret_cast<const bf16x8*>(base + off); }
__device__ __forceinline__ void mask_tile(f32x16& p0, f32x16& p1, int dq) {
    const float NEG = -__builtin_inff();
#pragma unroll
    for (int r = 0; r < 16; ++r) { const int c = (r & 3) + 8 * (r >> 2); if (dq - c < 0) p0[r] = NEG; if (dq - c - 32 < 0) p1[r] = NEG; }
}
__device__ __forceinline__ void qkt(f32x16& p0, f32x16& p1, const char* a, const char* qs, const bf16x8* qr, float negm) {
#pragma unroll
    for (int r = 0; r < 16; ++r) { p0[r] = negm; p1[r] = negm; }
    bf16x8 kA[3], kB[3], qv[3];
#define KL(d) do { kA[(d) % 3] = *reinterpret_cast<const bf16x8*>(a + (d) * 32); kB[(d) % 3] = *reinterpret_cast<const bf16x8*>(a + (d) * 32 + 32 * KROWB); \
        if ((d) >= NQR) qv[(d) % 3] = *reinterpret_cast<const bf16x8*>(qs + ((d) - NQR) * 1024); } while (0)
    KL(0); KL(1);
#pragma unroll
    for (int d0 = 0; d0 < 12; ++d0) {
        if (d0 + 2 < 12) KL(d0 + 2);
        SBAR();
        const bf16x8 q = d0 < NQR ? qr[d0 < NQR ? d0 : 0] : qv[d0 % 3];
        p0 = __builtin_amdgcn_mfma_f32_32x32x16_bf16(kA[d0 % 3], q, p0, 0, 0, 0);
        p1 = __builtin_amdgcn_mfma_f32_32x32x16_bf16(kB[d0 % 3], q, p1, 0, 0, 0);
        SBAR(); }
#undef KL
}
__device__ __forceinline__ void softmax_tile(f32x16& p0, f32x16& p1, float& m_reg, float& l_reg, float& alpha, bf16x8& pa0, bf16x8& pa1, bf16x8& pa2, bf16x8& pa3) {
    float pmax = fmaxf(p0[0], p1[0]);
#pragma unroll
    for (int r = 1; r < 16; ++r) pmax = fmaxf(fmaxf(pmax, p0[r]), p1[r]);
    { auto rr = __builtin_amdgcn_permlane32_swap(__float_as_uint(pmax), __float_as_uint(pmax), false, false); pmax = fmaxf(__uint_as_float(rr[0]), __uint_as_float(rr[1])); }
    alpha = 1.f;
    if (__builtin_expect(!__all(pmax <= THR), 0)) { const float dl = fmaxf(pmax, 0.f); m_reg += dl; alpha = __builtin_amdgcn_exp2f(-dl);
#pragma unroll
        for (int r = 0; r < 16; ++r) { p0[r] -= dl; p1[r] -= dl; } }
#pragma unroll
    for (int r = 0; r < 16; ++r) { p0[r] = __builtin_amdgcn_exp2f(p0[r]); p1[r] = __builtin_amdgcn_exp2f(p1[r]); }
    float ps = 0.f;
#pragma unroll
    for (int r = 0; r < 16; ++r) ps += p0[r] + p1[r];
    { auto rr = __builtin_amdgcn_permlane32_swap(__float_as_uint(ps), __float_as_uint(ps), false, false); ps = __uint_as_float(rr[0]) + __uint_as_float(rr[1]); }
    l_reg = l_reg * alpha + ps;
#define PK4(P, B_, OUT) do { unsigned a0 = cvt_pk_bf16(P[B_+0], P[B_+1]), a1 = cvt_pk_bf16(P[B_+2], P[B_+3]); \
        unsigned b0 = cvt_pk_bf16(P[B_+4], P[B_+5]), b1 = cvt_pk_bf16(P[B_+6], P[B_+7]); \
        auto r0 = __builtin_amdgcn_permlane32_swap(a0, b0, false, false); auto r1 = __builtin_amdgcn_permlane32_swap(a1, b1, false, false); \
        u32x4 w = {r0[0], r1[0], r0[1], r1[1]}; OUT = *reinterpret_cast<bf16x8*>(&w); } while (0)
    PK4(p0, 0, pa0); PK4(p0, 8, pa1); PK4(p1, 0, pa2); PK4(p1, 8, pa3);
#undef PK4
}
__device__ __forceinline__ void pv_tile(f32x16* o, int vb, bf16x8 pa0, bf16x8 pa1, bf16x8 pa2, bf16x8 pa3) {
#define TRRD(dst, off) asm volatile("ds_read_b64_tr_b16 %0, %1 offset:%2" : "=&v"(dst) : "v"(vb), "i"(off) : "memory")
#define TR8(S, d0) do { constexpr int b_ = v_rd_off(d0, 0, 0); TRRD(S##l0, b_); TRRD(S##h0, b_ + 2048); TRRD(S##l1, b_ + 4096); TRRD(S##h1, b_ + 6144); \
        TRRD(S##l2, b_ + 8192); TRRD(S##h2, b_ + 10240); TRRD(S##l3, b_ + 12288); TRRD(S##h3, b_ + 14336); } while (0)
#define MM4(S, d0) do { \
        o[d0] = __builtin_amdgcn_mfma_f32_32x32x16_bf16(pa0, (bf16x8){S##l0[0], S##l0[1], S##l0[2], S##l0[3], S##h0[0], S##h0[1], S##h0[2], S##h0[3]}, o[d0], 0, 0, 0); \
        o[d0] = __builtin_amdgcn_mfma_f32_32x32x16_bf16(pa1, (bf16x8){S##l1[0], S##l1[1], S##l1[2], S##l1[3], S##h1[0], S##h1[1], S##h1[2], S##h1[3]}, o[d0], 0, 0, 0); \
        o[d0] = __builtin_amdgcn_mfma_f32_32x32x16_bf16(pa2, (bf16x8){S##l2[0], S##l2[1], S##l2[2], S##l2[3], S##h2[0], S##h2[1], S##h2[2], S##h2[3]}, o[d0], 0, 0, 0); \
        o[d0] = __builtin_amdgcn_mfma_f32_32x32x16_bf16(pa3, (bf16x8){S##l3[0], S##l3[1], S##l3[2], S##l3[3], S##h3[0], S##h3[1], S##h3[2], S##h3[3]}, o[d0], 0, 0, 0); } while (0)
    s16x4 Al0, Al1, Al2, Al3, Ah0, Ah1, Ah2, Ah3, Bl0, Bl1, Bl2, Bl3, Bh0, Bh1, Bh2, Bh3;
    TR8(A, 0); TR8(B, 1);
    asm volatile("s_waitcnt lgkmcnt(8)" ::: "memory"); SBAR(); MM4(A, 0); SBAR();
    TR8(A, 2);
    asm volatile("s_waitcnt lgkmcnt(8)" ::: "memory"); SBAR(); MM4(B, 1); SBAR();
    TR8(B, 3);
    asm volatile("s_waitcnt lgkmcnt(8)" ::: "memory"); SBAR(); MM4(A, 2); SBAR();
    asm volatile("s_waitcnt lgkmcnt(0)" ::: "memory"); SBAR(); MM4(B, 3);
#undef MM4
#undef TR8
#undef TRRD
}
#define VMW() asm volatile("s_waitcnt vmcnt(0)" ::: "memory")
#define SLOAD(Kp, Vp) do { const bf16_t* vp_ = (Vp); st_v0 = ldg8(vp_, voff); st_v1 = ldg8(vp_ + 32 * LDV, voff); \
        const bf16_t* kp_ = (Kp); st_k0 = ldg8(kp_, koff); st_k1 = ldg8(kp_ + 64, koff); st_k2 = ldg8(kp_ + 128, koff); } while (0)
#define SWRITE(kb_, vb_) do { char* d_ = K_lds + (kb_) * SHM_K + kws; *(bf16x8*)d_ = st_k0; *(bf16x8*)(d_ + 128) = st_k1; *(bf16x8*)(d_ + 256) = st_k2; \
        *(bf16x8*)(V_lds + (vb_) * SHM_V + vst0) = st_v0; *(bf16x8*)(V_lds + (vb_) * SHM_V + vst1) = st_v1; } while (0)
#define BLK_BH(ii) (xcd * 8 + (ii))
#define BLK_QB(ii) (((ii) & 1) ? 31 - j : j)
#define TILEPTR(ii, nn, Kp, Vp) do { const int bh_ = BLK_BH(ii), qb_ = BLK_QB(ii), tl_ = ((ii) & 1) ? 4 * qb_ + 3 - (nn) : (nn); \
        const size_t row_ = (size_t)(bh_ >> 4) * SEQ + (size_t)tl_ * KVBLK; Kp = Kall + row_ * LDK + (bh_ & 15) * 192; Vp = Vall + row_ * LDV + (bh_ & 15) * 128; } while (0)
__device__ __forceinline__ void attn_stream(const bf16_t* Qall, const bf16_t* Kall, const bf16_t* Vall, bf16_t* Oall, int sid, char* lds) {
    const int xcd = sid >> 5, j = sid & 31;
    const int tid = threadIdx.x, wid = __builtin_amdgcn_readfirstlane(tid >> 6), lane = tid & 63, r32 = lane & 31, hi = lane >> 5;
    const int sr = tid >> 4, sc = (tid & 15) * 8, kr = tid >> 3;
    const unsigned voff = (unsigned)(sr * LDV + sc), koff = (unsigned)(kr * LDK + (tid & 7) * 8), qoff = (unsigned)((wid * QBLK + r32) * LDQ + hi * 8);
    const int kws = kr * KROWB + (tid & 7) * 16, vst0 = v_st(sr, sc), vst1 = v_st(32 + sr, sc);
    char* V_lds = lds; char* K_lds = lds + LDS_K0; char* qs = lds + LDS_QS + wid * ((12 - NQR) * 1024) + lane * 16;
    float* ws = (float*)(lds + LDS_WS) + wid * 64; float* li_l = ws, * al_l = ws + 32;
    const char* ka0 = K_lds + r32 * KROWB + hi * 16;
    const int vrb = (int)(uintptr_t)V_lds + v_rd_base(lane);
    const bool grpB = wid >= 4;
    bf16x8 st_v0, st_v1, st_k0, st_k1, st_k2;
    bf16x8 qr[NQR];
    f32x16 o[4], p0, p1; float m_reg, l_reg, al; bf16x8 pa0, pa1, pa2, pa3;
    const bf16_t* kp; const bf16_t* vp;
    { const int bh0 = BLK_BH(0); const bf16_t* Q0 = Qall + ((size_t)(bh0 >> 4) * SEQ + (size_t)BLK_QB(0) * QB) * LDQ + (bh0 & 15) * 192;
#pragma unroll
      for (int d0 = 0; d0 < NQR; ++d0) qr[d0] = ldg8(Q0 + d0 * 16, qoff);
#pragma unroll
      for (int d0 = NQR; d0 < 12; ++d0) *(bf16x8*)(qs + (d0 - NQR) * 1024) = ldg8(Q0 + d0 * 16, qoff);
#pragma unroll
      for (int d0 = 0; d0 < NQR; ++d0) asm volatile("" : "+v"(qr[d0]));
      TILEPTR(0, 0, kp, vp); SLOAD(kp, vp); VMW(); SWRITE(0, 0); }
    __syncthreads();
    if (grpB) { TILEPTR(0, 1, kp, vp); SLOAD(kp, vp); }
    int kb = 0, vb = 0;
    for (int i = 0; i < 8; ++i) {
        const int bh = BLK_BH(i), qb = BLK_QB(i), NT = 4 * qb + 4, qlo = qb * QB + wid * QBLK, qm = qlo + r32 - 4 * hi;
        const bool more = i < 7, desc = i & 1;
        m_reg = 0.f; l_reg = 0.f;
#pragma unroll
        for (int d = 0; d < 4; ++d) o[d] = f32x16{};
        for (int n = 0; n < NT; ++n) {
            const int t = desc ? NT - 1 - n : n;
            const bool v1 = (n + 1 < NT) || more; bool v2 = true; if (n + 2 >= NT) v2 = more;
            const int kb1 = kb ^ 1, vb1 = vb == 2 ? 0 : vb + 1;
            if (!grpB && v1) { if (n + 1 < NT) TILEPTR(i, n + 1, kp, vp); else TILEPTR(i + 1, 0, kp, vp); SLOAD(kp, vp); }
            SBAR(); qkt(p0, p1, ka0 + kb * SHM_K, qs, qr, -m_reg); SBAR();
            if (grpB) { if (v1) { VMW(); SWRITE(kb1, vb1); } __syncthreads();
                        if (v2) { if (n + 2 < NT) TILEPTR(i, n + 2, kp, vp); else TILEPTR(i + 1, n + 2 - NT, kp, vp); SLOAD(kp, vp); } }
            SBAR();
            { const int kb_ = t * KVBLK; if (kb_ + KVBLK - 1 > qlo) mask_tile(p0, p1, qm - kb_); }
            softmax_tile(p0, p1, m_reg, l_reg, al, pa0, pa1, pa2, pa3);
            if (__any(al < 1.f)) { if (hi == 0) al_l[r32] = al; asm volatile("s_waitcnt lgkmcnt(0)" ::: "memory");
#pragma unroll
                for (int d_ = 0; d_ < 4; ++d_)
#pragma unroll
                    for (int r = 0; r < 16; ++r) o[d_][r] *= al_l[crow(r, hi)]; }
            SBAR(); pv_tile(o, vrb + vb * SHM_V, pa0, pa1, pa2, pa3); SBAR();
            if (!grpB) { if (v1) { VMW(); SWRITE(kb1, vb1); } __syncthreads(); }
            kb = kb1; vb = vb1;
        }
        {
            if (hi == 0) li_l[r32] = l_reg; asm volatile("s_waitcnt lgkmcnt(0)" ::: "memory");
            bf16_t* Ow = Oall + ((size_t)(bh >> 4) * SEQ + (size_t)qb * QB) * LDO + (bh & 15) * 128; unsigned ooff = (unsigned)((wid * QBLK + 4 * hi) * LDO + r32); asm volatile("" : "+v"(ooff));
#pragma unroll
            for (int r = 0; r < 16; ++r) { const int orow = (r & 3) + 8 * (r >> 2); const float rl = __builtin_amdgcn_rcpf(li_l[crow(r, hi)]);
#pragma unroll
                for (int d0 = 0; d0 < 4; ++d0) { const float v = o[d0][r] * rl; const float vn = __shfl_xor(v, 1);
                    if ((r32 & 1) == 0) *(unsigned*)(Ow + orow * LDO + d0 * 32 + ooff) = cvt_pk_bf16(v, vn); } }
            if (more) {
                const int bhn = BLK_BH(i + 1); const bf16_t* Qn = Qall + ((size_t)(bhn >> 4) * SEQ + (size_t)BLK_QB(i + 1) * QB) * LDQ + (bhn & 15) * 192;
#pragma unroll
                for (int d0 = 0; d0 < NQR; ++d0) qr[d0] = ldg8(Qn + d0 * 16, qoff);
#pragma unroll
                for (int d0 = NQR; d0 < 12; ++d0) *(bf16x8*)(qs + (d0 - NQR) * 1024) = ldg8(Qn + d0 * 16, qoff);
#pragma unroll
                for (int d0 = 0; d0 < NQR; ++d0) asm volatile("" : "+v"(qr[d0])); } }
    }
    asm volatile("s_waitcnt vmcnt(0)" ::: "memory"); __syncthreads();
}
#undef BLK_BH
#undef BLK_QB
#undef TILEPTR
#undef VMW
#undef SLOAD
#undef SWRITE
#undef SBAR
}

constexpr size_t MiB = 1u << 20;
constexpr size_t WS_BAR = 7 * MiB, WS_RSTD0 = 0, WS_SSQ = 1 * MiB, WS_SSKV = 2 * MiB, WS_SS = 3 * MiB, WS_CS = 8 * MiB;
constexpr size_t WS_WPOOL = 16 * MiB, WS_WA = 18 * MiB, WS_WQB = 23 * MiB, WS_WKVB = 26 * MiB, WS_WO = 30 * MiB;
constexpr size_t WS_WGU0 = 38 * MiB, WS_WDN0 = 82 * MiB, WS_WGU1 = 104 * MiB, WS_WDN1 = 148 * MiB;
constexpr size_t WS_B0 = 170 * MiB, WS_B1 = 298 * MiB, WS_QA = 426 * MiB, WS_KVA = 458 * MiB;
constexpr size_t WS_Q = 490 * MiB, WS_K = 682 * MiB, WS_V = 874 * MiB, WS_MID = 490 * MiB, WS_END = 1002 * MiB;
constexpr int LDS_BYTES = 155648;
static_assert(att::LDS_TOTAL <= LDS_BYTES && pg8::STAGE_BYTES <= LDS_BYTES, "LDS map");

#define XB_TMO      128
#define XB_XCNT(j)  (256  + 64 * (j))
#define XB_XSUB(j)  (1280 + 64 * (j))
#define XB_XGEN(j)  (2304 + 64 * (j))
#define XB_TOP      3328
#define XB_TOPGEN   3392
#define XCD_BAR_WORDS 3456
#define XB_SPIN_CAP (1u << 18)
__device__ __forceinline__ unsigned xb_ld(unsigned* p)              { return __hip_atomic_load(p, __ATOMIC_RELAXED, __HIP_MEMORY_SCOPE_AGENT); }
__device__ __forceinline__ unsigned xb_add(unsigned* p, unsigned v) { return __hip_atomic_fetch_add(p, v, __ATOMIC_RELAXED, __HIP_MEMORY_SCOPE_AGENT); }
__device__ __forceinline__ unsigned xb_xcc_id() { return (unsigned)__builtin_amdgcn_s_getreg((3 << 11) | 20) & 0xFu; }
#define XB_SPIN(cond, bar) do { unsigned _sp = 0; while (cond) { __builtin_amdgcn_s_sleep(1); \
    if ((++_sp & 255u) == 0u) { if (xb_ld(&(bar)[XB_TMO])) break; if (_sp > XB_SPIN_CAP) { atomicAdd(&(bar)[XB_TMO], 1u); break; } } } } while (0)
struct XcdBarrier { unsigned* bar; unsigned x; volatile LAS unsigned* st; };
__device__ __forceinline__ XcdBarrier xcd_barrier_post(unsigned* bar, volatile LAS unsigned* st) {
    XcdBarrier b; b.bar = bar; b.x = xb_xcc_id(); b.st = st;
    if (threadIdx.x == 0) (void)xb_add(&bar[XB_XCNT(b.x)], 1u);
    return b;
}
__device__ __forceinline__ void xcd_barrier_complete(unsigned* bar, unsigned x, unsigned& nloc, unsigned& nx) {
    const unsigned G = gridDim.x * gridDim.y * gridDim.z;
    unsigned sum, cnt, mine, sp = 0u;
    for (;;) {
        sum = 0u; cnt = 0u; mine = 0u;
#pragma unroll
        for (unsigned j = 0; j < 16; ++j) { const unsigned c = xb_ld(&bar[XB_XCNT(j)]); sum += c; cnt += (c > 0u) ? 1u : 0u; mine = (j == x) ? c : mine; }
        if (sum == G) break;
        __builtin_amdgcn_s_sleep(1);
        if ((++sp & 255u) == 0u) { if (xb_ld(&bar[XB_TMO])) break; if (sp > XB_SPIN_CAP) { atomicAdd(&bar[XB_TMO], 1u); break; } }
    }
    nloc = mine > 0u ? mine : 1u; nx = cnt > 0u ? cnt : 1u;
}
__device__ __forceinline__ void xcd_barrier(const XcdBarrier& b) {
    asm volatile("s_waitcnt vmcnt(0)" ::: "memory");
    __syncthreads();
    if (threadIdx.x == 0) {
        unsigned* bar = b.bar;
        __builtin_amdgcn_s_waitcnt(0);
        unsigned nloc = b.st[0], nx = b.st[1];
        if (nloc == 0u) { xcd_barrier_complete(bar, b.x, nloc, nx); b.st[0] = nloc; b.st[1] = nx; }
        const unsigned old = xb_add(&bar[XB_XSUB(b.x)], 1u);
        const unsigned gen = old / nloc;
        if (old + 1u == (gen + 1u) * nloc) {
            __builtin_amdgcn_fence(__ATOMIC_RELEASE, "agent");
            asm volatile("s_waitcnt vmcnt(0)" ::: "memory");
            const unsigned og = xb_add(&bar[XB_TOP], 1u);
            const unsigned tg = og / nx;
            if (og + 1u == (tg + 1u) * nx) xb_add(&bar[XB_TOPGEN], 1u);
            else XB_SPIN(xb_ld(&bar[XB_TOPGEN]) == tg, bar);
            __builtin_amdgcn_fence(__ATOMIC_ACQUIRE, "agent");
            xb_add(&bar[XB_XGEN(b.x)], 1u);
            asm volatile("s_waitcnt vmcnt(0)" ::: "memory");
        } else {
            XB_SPIN(xb_ld(&bar[XB_XGEN(b.x)]) == gen, bar);
            __builtin_amdgcn_fence(__ATOMIC_ACQUIRE, "agent");
            asm volatile("s_waitcnt vmcnt(0)" ::: "memory");
        }
    }
    __syncthreads();
}

#ifndef PH_MASK
#define PH_MASK 0xFFF
#endif
#define PH_ON(k) (((PH_MASK) >> (k)) & 1)
struct Args { const float* in[19]; float* out; unsigned char* ws; int ph_lo, ph_hi; };

__device__ __forceinline__ float wave_sum(float v) {
#pragma unroll
    for (int o = 1; o < 64; o <<= 1) v += __shfl_xor(v, o);
    return v;
}
__device__ __forceinline__ int map_row(int mode, int n) {
    switch (mode) {
        case 1: return (n >> 7) * 256 + (n & 127);
        case 2: return (n >> 7) * 256 + 128 + (n & 127);
        case 3: { if (n < 512) return 512 + n; const int j = n - 512; return 1024 + 2 * (j & 31) + (j >> 5); }
        case 4: { const int h = n / 192, d = n % 192; if (d < 128) return h * 128 + d; const int j = d - 128; return 2048 + h * 64 + 2 * (j & 31) + (j >> 5); }
        case 5: { const int h = n >> 8, d = n & 255; return d < 128 ? h * 128 + d : 2048 + h * 128 + (d - 128); }
        default: return n;
    }
}
__device__ __forceinline__ void transpose_item(const float* W, int K, int N, bf16_t* WT, int mode, const float* ks, const float* cs, LAS float* scr, int item, int lane) {
    const int nblk = N / 64, kb = item / nblk, nb = item % nblk, k0 = 64 * kb, n0 = 64 * nb;
    const int lr = lane >> 4, lc = (lane & 15) * 4;
    f32x4 v[16];
#pragma unroll
    for (int i = 0; i < 16; ++i) v[i] = *(const f32x4*)(W + (size_t)(k0 + 4 * i + lr) * N + n0 + lc);
#pragma unroll
    for (int i = 0; i < 16; ++i) { const int kk = 4 * i + lr; f32x4 t = v[i]; if (ks) t = t * ks[k0 + kk]; LAS float* d = scr + kk * 65 + lc; d[0] = t[0]; d[1] = t[1]; d[2] = t[2]; d[3] = t[3]; }
    asm volatile("s_waitcnt lgkmcnt(0)" ::: "memory");
    const int c = lane & 7;
#pragma unroll
    for (int j = 0; j < 8; ++j) { const int n = (lane >> 3) + 8 * j; const LAS float* s = scr + (8 * c) * 65 + n; const float csn = cs ? cs[n0 + n] : 1.f;
        u32x4 o; o.x = cvt_pk_bf16(s[0 * 65] * csn, s[1 * 65] * csn); o.y = cvt_pk_bf16(s[2 * 65] * csn, s[3 * 65] * csn); o.z = cvt_pk_bf16(s[4 * 65] * csn, s[5 * 65] * csn); o.w = cvt_pk_bf16(s[6 * 65] * csn, s[7 * 65] * csn);
        *(u32x4*)(WT + (size_t)map_row(mode, n0 + n) * K + k0 + 8 * c) = o; }
    asm volatile("s_waitcnt lgkmcnt(0)" ::: "memory");
}

__global__ void __launch_bounds__(512, 2) yoco_fwd(Args a) {
    extern __shared__ __attribute__((aligned(16))) unsigned char lds[];
    cg::grid_group grid = cg::this_grid();
    const int tid = threadIdx.x, lane = tid & 63, wave = __builtin_amdgcn_readfirstlane(tid >> 6);
    const int G = gridDim.x, bx = blockIdx.x, vcu = (G % 8 == 0) ? (bx % 8) * (G / 8) + bx / 8 : bx;
    const int gw = vcu * 8 + wave, NGW = G * 8;
    unsigned char* ws = a.ws;
    const float* x = a.in[0]; const int* positions = (const int*)a.in[1];
    float* out = a.out;
    float* rstd0 = (float*)(ws + WS_RSTD0); float* ssq = (float*)(ws + WS_SSQ); float* sskv = (float*)(ws + WS_SSKV); float* ss = (float*)(ws + WS_SS); float* cs = (float*)(ws + WS_CS);
    bf16_t* Wpool = (bf16_t*)(ws + WS_WPOOL); bf16_t* Wa = (bf16_t*)(ws + WS_WA); bf16_t* Wqb = (bf16_t*)(ws + WS_WQB); bf16_t* Wkvb = (bf16_t*)(ws + WS_WKVB); bf16_t* Wo = (bf16_t*)(ws + WS_WO);
    bf16_t* B0 = (bf16_t*)(ws + WS_B0); bf16_t* B1 = (bf16_t*)(ws + WS_B1); bf16_t* QA = (bf16_t*)(ws + WS_QA); bf16_t* KVA = (bf16_t*)(ws + WS_KVA);
    bf16_t* Qb = (bf16_t*)(ws + WS_Q); bf16_t* Kb = (bf16_t*)(ws + WS_K); bf16_t* Vb = (bf16_t*)(ws + WS_V); bf16_t* MID = (bf16_t*)(ws + WS_MID);
    LAS unsigned char* ldsl = (LAS unsigned char*)lds;
    const int lo = a.ph_lo, hi = a.ph_hi;
    volatile LAS unsigned* bst = (volatile LAS unsigned*)(ldsl + LDS_BYTES - 64);
    if (tid == 0) { bst[0] = 0u; bst[1] = 0u; }
    __syncthreads();
    XcdBarrier xbar = xcd_barrier_post((unsigned*)(ws + WS_BAR), bst);
#define IN(k) (lo <= (k) && (k) < hi)
#define SEAM(k) do { if (IN(k) && IN((k) + 1)) { if ((k) == 0) grid.sync(); else xcd_barrier(xbar); } } while (0)

    if (PH_ON(0) && IN(0)) {
        LAS float* scr = (LAS float*)(ldsl + wave * 16640);
        constexpr int I_POOL = 8 * 8, I_GU = 32 * 88, I_DN = 88 * 32, I_QA = 32 * 8, I_KVA = 32 * 9, I_QB = 8 * 48, I_KVB = 8 * 64, I_WO = 32 * 32;
        constexpr int NITEMS = 4 * I_POOL + 2 * (2 * I_GU + I_DN) + I_QA + I_KVA + I_QB + I_KVB + I_WO;
        for (int it = gw; it < NITEMS; it += NGW) {
            int r = it;
#define JOB(cnt, W_, K_, N_, dst_, mode_, ks_, cs_) if (r < (cnt)) { transpose_item(W_, K_, N_, dst_, mode_, ks_, cs_, scr, r, lane); continue; } r -= (cnt);
            JOB(I_POOL, a.in[3] + 0 * 262144, 512, 512, Wpool + 0 * 262144, 0, a.in[2] + 0, a.in[4] + 0)
            JOB(I_POOL, a.in[3] + 1 * 262144, 512, 512, Wpool + 1 * 262144, 0, a.in[2] + 512, a.in[4] + 512)
            JOB(I_POOL, a.in[3] + 2 * 262144, 512, 512, Wpool + 2 * 262144, 0, a.in[2] + 1024, a.in[4] + 1024)
            JOB(I_POOL, a.in[3] + 3 * 262144, 512, 512, Wpool + 3 * 262144, 0, a.in[2] + 1536, a.in[4] + 1536)
            JOB(I_GU, a.in[15], DM, DFF, (bf16_t*)(ws + WS_WGU0), 1, a.in[14], nullptr)
            JOB(I_GU, a.in[16], DM, DFF, (bf16_t*)(ws + WS_WGU0), 2, a.in[14], nullptr)
            JOB(I_DN, a.in[17], DFF, DM, (bf16_t*)(ws + WS_WDN0), 0, nullptr, nullptr)
            JOB(I_GU, a.in[15] + (size_t)DM * DFF, DM, DFF, (bf16_t*)(ws + WS_WGU1), 1, a.in[14] + DM, nullptr)
            JOB(I_GU, a.in[16] + (size_t)DM * DFF, DM, DFF, (bf16_t*)(ws + WS_WGU1), 2, a.in[14] + DM, nullptr)
            JOB(I_DN, a.in[17] + (size_t)DM * DFF, DFF, DM, (bf16_t*)(ws + WS_WDN1), 0, nullptr, nullptr)
            JOB(I_QA, a.in[10], DM, 512, Wa, 0, a.in[9], nullptr)
            JOB(I_KVA, a.in[6], DM, 576, Wa, 3, a.in[5], nullptr)
            JOB(I_QB, a.in[12], 512, 3072, Wqb, 4, a.in[11], nullptr)
            JOB(I_KVB, a.in[8], 512, 4096, Wkvb, 5, a.in[7], nullptr)
            JOB(I_WO, a.in[13], DM, DM, Wo, 0, nullptr, nullptr)
#undef JOB
        }
        for (int m = gw; m < T; m += NGW) {
            const f32x4* xr = (const f32x4*)(x + (size_t)m * DM) + lane; float s = 0.f;
#pragma unroll
            for (int j = 0; j < 8; ++j) s += sq4(xr[64 * j]);
            s = wave_sum(s);
            if (lane == 0) rstd0[m] = __builtin_amdgcn_rsqf(s * (1.f / DM) + EPS);
            if (lane < 32) {
                const float invf = (float)exp2(-(double)lane * (13.287712379549449 / 32.0));
                const float ang = (float)positions[m] * invf;
                double rev = (double)ang * 0.15915494309189535; rev -= rint(rev);
                const float rf = (float)rev;
                *(f32x2*)(cs + ((size_t)m * 32 + lane) * 2) = (f32x2){__builtin_amdgcn_cosf(rf), __builtin_amdgcn_sinf(rf)};
            }
        }
    }
    SEAM(0);
    if (PH_ON(1) && IN(1)) {
        for (int item = gw; item < (T / 64) * 8; item += NGW) {
            const int slab = item & 7, chunk = item >> 3, t0 = chunk * 64, c0 = slab * 256 + lane * 4, w = 2 << (slab >> 1), tin0 = t0 & (SEQ - 1);
            const float* xc = x + c0; f32x4 s = {0.f, 0.f, 0.f, 0.f};
            for (int j = 1; j < w; ++j) if (tin0 - j >= 0) s += *(const f32x4*)(xc + (size_t)(t0 - j) * DM) * rstd0[t0 - j];
#pragma unroll 4
            for (int i = 0; i < 64; ++i) { const int t = t0 + i, tin = tin0 + i;
                const f32x4 h = *(const f32x4*)(xc + (size_t)t * DM) * rstd0[t]; s += h;
                const int cnt = tin + 1 < w ? tin + 1 : w; const f32x4 d = s * (1.f / (float)cnt) - h;
                u32x2 o; o.x = cvt_pk_bf16(d[0], d[1]); o.y = cvt_pk_bf16(d[2], d[3]); *(u32x2*)(B0 + (size_t)t * DM + c0) = o;
                if (tin - w + 1 >= 0) s -= *(const f32x4*)(xc + (size_t)(t - w + 1) * DM) * rstd0[t - w + 1]; }
        }
    }
    SEAM(1);
    if (PH_ON(2) && IN(2)) {
        pg8::Gemm g{B0, Wpool, DM, 512, 512, 512, 262144}; pg8::Order S; S.init(T, 512, 4, G, bx);
        pg8::EpiResid E{x, out, B1, ss, 512, 0};
        pg8::gemm_phase(ldsl, g, S, E);
    }
    SEAM(2);
    if (PH_ON(3) && IN(3)) {
        pg8::Gemm g{B1, (const bf16_t*)(ws + WS_WGU0), DM, DM, DM, 0, 0}; pg8::Order S; S.init(T, 2 * DFF, 1, G, bx);
        pg8::EpiSwiGLU E{MID, ss};
#ifndef REP3
#define REP3 1
#endif
        for (int rep3 = 0; rep3 < REP3; ++rep3) pg8::gemm_phase(ldsl, g, S, E);
    }
    SEAM(3);
    if (PH_ON(4) && IN(4)) {
        pg8::Gemm g{MID, (const bf16_t*)(ws + WS_WDN0), DFF, DFF, DFF, 0, 0}; pg8::Order S; S.init(T, DM, 1, G, bx);
        pg8::EpiResid E{out, out, B0, ss, 0, 0};
        pg8::gemm_phase(ldsl, g, S, E);
    }
    SEAM(4);
    if (PH_ON(5) && IN(5)) {
        pg8::Gemm g{B0, Wa, DM, DM, DM, 0, 0}; pg8::Order S; S.init(T, 1280, 1, G, bx);
        pg8::EpiA E{ss, QA, KVA, ssq, sskv, Kb, cs};
        pg8::gemm_phase(ldsl, g, S, E);
    }
    SEAM(5);
    if (PH_ON(6) && IN(6)) {
        { pg8::Gemm g{QA, Wqb, 512, 512, 512, 0, 0}; pg8::Order S; S.init(T, 3072, 1, G, bx);
          pg8::EpiQ E{ssq, Qb, cs}; pg8::gemm_phase(ldsl, g, S, E); }
        { pg8::Gemm g{KVA, Wkvb, 512, 512, 512, 0, 0}; pg8::Order S; S.init(T, 4096, 1, G, bx);
          pg8::EpiKV E{sskv, Kb, Vb}; pg8::gemm_phase(ldsl, g, S, E); }
    }
    SEAM(6);
    if (PH_ON(7) && IN(7)) {
#ifndef REP7
#define REP7 1
#endif
        for (int rep7 = 0; rep7 < REP7; ++rep7)
        for (int sid = vcu; sid < 256; sid += G) att::attn_stream(Qb, Kb, Vb, B1, sid, (char*)lds);
    }
    SEAM(7);
    if (PH_ON(8) && IN(8)) {
        pg8::Gemm g{B1, Wo, DM, DM, DM, 0, 0}; pg8::Order S; S.init(T, DM, 1, G, bx);
        pg8::EpiResid E{out, out, B0, ss, 0, 0};
        pg8::gemm_phase(ldsl, g, S, E);
    }
    SEAM(8);
    if (PH_ON(9) && IN(9)) {
        pg8::Gemm g{B0, (const bf16_t*)(ws + WS_WGU1), DM, DM, DM, 0, 0}; pg8::Order S; S.init(T, 2 * DFF, 1, G, bx);
        pg8::EpiSwiGLU E{MID, ss};
        pg8::gemm_phase(ldsl, g, S, E);
    }
    SEAM(9);
    if (PH_ON(10) && IN(10)) {
        pg8::Gemm g{MID, (const bf16_t*)(ws + WS_WDN1), DFF, DFF, DFF, 0, 0}; pg8::Order S; S.init(T, DM, 1, G, bx);
        pg8::EpiResid E{out, out, nullptr, ss, 0, 0};
        pg8::gemm_phase(ldsl, g, S, E);
    }
    SEAM(10);
    if (PH_ON(11) && IN(11)) {
        const float* fg = a.in[18];
        for (int m = gw; m < T; m += NGW) {
            float s = lane < 32 ? ss[(size_t)m * 32 + lane] : 0.f; s = wave_sum(s);
            const float r = __builtin_amdgcn_rsqf(s * (1.f / DM) + EPS);
            f32x4* xr = (f32x4*)(out + (size_t)m * DM) + lane; const f32x4* gr = (const f32x4*)fg + lane;
#pragma unroll
            for (int j = 0; j < 8; ++j) { const f32x4 v = xr[64 * j]; xr[64 * j] = v * r * gr[64 * j]; }
        }
    }
#undef IN
#undef SEAM
}

extern "C" void kernel_launch(void* const* d_in, const int* in_sizes, int n_in, void* d_out, int out_size, void* d_ws, size_t ws_size, hipStream_t stream) {
    static int grid = 0;
    if (grid == 0) {
        if (n_in != 19 || in_sizes[0] != T * DM || out_size != T * DM || ws_size < WS_END) { fprintf(stderr, "kernel_launch: shape/workspace mismatch (n_in %d, in0 %d, out %d, ws %zu < %zu)\n", n_in, n_in > 0 ? in_sizes[0] : -1, out_size, ws_size, (size_t)WS_END); grid = -1; return; }
        int dev = 0, cus = 0, per_cu = 0;
        (void)hipGetDevice(&dev); (void)hipDeviceGetAttribute(&cus, hipDeviceAttributeMultiprocessorCount, dev);
        if (hipFuncSetAttribute((const void*)yoco_fwd, hipFuncAttributeMaxDynamicSharedMemorySize, LDS_BYTES) != hipSuccess) { fprintf(stderr, "kernel_launch: hipFuncSetAttribute failed\n"); grid = -1; return; }
        if (hipOccupancyMaxActiveBlocksPerMultiprocessor(&per_cu, (const void*)yoco_fwd, 512, LDS_BYTES) != hipSuccess || per_cu < 1) { fprintf(stderr, "kernel_launch: occupancy query says %d\n", per_cu); per_cu = 1; }
        (void)hipGetLastError();
        grid = cus * per_cu;
        if (grid <= 0) grid = 256;
    }
    if (grid < 0) return;
    if (hipMemsetAsync((char*)d_ws + WS_BAR, 0, XCD_BAR_WORDS * 4, stream) != hipSuccess) { fprintf(stderr, "kernel_launch: memset of the barrier words failed\n"); return; }
    Args a{};
    for (int i = 0; i < 19; ++i) a.in[i] = (const float*)d_in[i];
    a.out = (float*)d_out; a.ws = (unsigned char*)d_ws; a.ph_lo = 0; a.ph_hi = 12;
    void* args[] = {&a};
    hipError_t e = hipLaunchCooperativeKernel((const void*)yoco_fwd, dim3(grid), dim3(512), args, LDS_BYTES, stream);
    if (e != hipSuccess) fprintf(stderr, "cooperative launch failed: %s (grid %d)\n", hipGetErrorString(e), grid);
}
```

```cpp
#include <hip/hip_runtime.h>
#include <hip/hip_cooperative_groups.h>
#include <cstdio>
#include <cstdint>
namespace cg = cooperative_groups;

#define LAS __attribute__((address_space(3)))
typedef unsigned short bf16_t;
typedef short bf16x8 __attribute__((ext_vector_type(8)));
typedef short s16x4 __attribute__((ext_vector_type(4)));
typedef float f32x2 __attribute__((ext_vector_type(2)));
typedef float f32x4 __attribute__((ext_vector_type(4)));
typedef float f32x16 __attribute__((ext_vector_type(16)));
typedef unsigned u32x2 __attribute__((ext_vector_type(2)));
typedef unsigned u32x4 __attribute__((ext_vector_type(4)));

constexpr int DM = 2048, NB = 4, SEQ = 8192, T = NB * SEQ, DFF = 5632, NH = 16;
constexpr float EPS = 1e-6f;
constexpr float C2Q = 0.07216878364870322f * 1.4426950408889634f;

__device__ __forceinline__ unsigned cvt_pk_bf16(float lo, float hi) { unsigned r; asm volatile("v_cvt_pk_bf16_f32 %0, %1, %2" : "=v"(r) : "v"(lo), "v"(hi)); return r; }
__device__ __forceinline__ u32x4 pack8(f32x4 a, f32x4 b) { u32x4 w; w.x = cvt_pk_bf16(a[0], a[1]); w.y = cvt_pk_bf16(a[2], a[3]); w.z = cvt_pk_bf16(b[0], b[1]); w.w = cvt_pk_bf16(b[2], b[3]); return w; }
__device__ __forceinline__ float sq4(f32x4 v) { return (v[0] * v[0] + v[1] * v[1]) + (v[2] * v[2] + v[3] * v[3]); }

namespace pg8 {
constexpr int BM = 256, BK = 64, HALF = 128, HTB = HALF * BK * 2, STAGE_BYTES = 8 * HTB, NXCD = 8, WGM = 8;
__host__ __device__ __forceinline__ int lds_byte(int r, int c) { const int st = (r >> 4) * 2 + (c >> 5), rr = r & 15, cc = c & 31, ob = rr * 64 + cc * 2; return st * 1024 + (ob ^ (((ob >> 9) & 1) << 5)); }
__host__ __device__ __forceinline__ void stage_rc(int b, int& R, int& C) { const int st = b / 1024, sb = b % 1024, swz = sb ^ (((sb >> 9) & 1) << 5); R = (st >> 1) * 16 + swz / 64; C = (st & 1) * 32 + (swz % 64) / 2; }
__host__ __device__ __forceinline__ int perm32(int rho) { const int n = rho >> 4, i = rho & 15; return 8 * (i >> 2) + 4 * n + (i & 3); }

struct Unit { int pm, pn, grp; };
struct Gemm { const bf16_t* A; const bf16_t* Bt; int lda, ldb, K; long grpA, grpB; };

struct Order {
    int nM, nN, nwg, nG, G, c;
    __device__ void init(int M, int N, int nG_, int G_, int c_) { nM = M / BM; nN = N / BM; nwg = nM * nN; nG = nG_; G = G_; c = c_; }
    __device__ bool next(int i, Unit& u) const {
        const long L = (long)i * G + c; if (L >= (long)nwg * nG) return false;
        u.grp = (int)(L / nwg); int wgid = (int)(L % nwg);
        { const int q = nwg / NXCD, r = nwg % NXCD, xcd = wgid % NXCD, off = wgid / NXCD; wgid = (xcd < r ? xcd * (q + 1) : r * (q + 1) + (xcd - r) * q) + off; }
        const int nig = WGM * nN, gid = wgid / nig, fm = gid * WGM, gsz = (nM - fm) < WGM ? (nM - fm) : WGM;
        u.pm = fm + ((wgid % nig) % gsz); u.pn = (wgid % nig) / gsz; return true;
    }
};

template <class Epi>
__device__ __forceinline__ void gemm_phase(LAS unsigned char* lds, const Gemm g, const Order& S, const Epi& E) {
    const int tid = threadIdx.x, wid = __builtin_amdgcn_readfirstlane(tid >> 6), lane = tid & 63, wr = wid >> 2, wc = wid & 3, fr = lane & 15, fq = lane >> 4;
    const int K = g.K, nt = K / BK;
    unsigned voffA[2], voffB[2];
#pragma unroll
    for (int i = 0; i < 2; ++i) { int R, C; stage_rc(tid * 16 + i * 8192, R, C); const int Rb = (R & ~31) + perm32(R & 31);
        voffA[i] = (unsigned)(R * g.lda + C) * 2u; voffB[i] = (unsigned)(Rb * g.ldb + C) * 2u; }
    const size_t kstep = (size_t)(BK * 2);
    const size_t hstepA = (size_t)HALF * g.lda * 2, hstepB = (size_t)HALF * g.ldb * 2;
    const size_t tstepA = 2 * hstepA, tstepB = 2 * hstepB;
    const unsigned ldsw = (unsigned)wid * 1024u;
    const int aoff = lds_byte(wr * 64 + fr, fq * 8), boff = lds_byte(wc * 32 + fr, fq * 8);
#define PG8_SA(b, h) (((b) * 2 + (h)) * HTB)
#define PG8_SB(b, h) ((4 + (b) * 2 + (h)) * HTB)
#define PG8_STAGE(bufoff, gbase, voff) do { _Pragma("unroll") for (int _i = 0; _i < 2; ++_i) \
        __builtin_amdgcn_global_load_lds((const unsigned*)((const char*)(gbase) + (voff)[_i]), (LAS unsigned*)(lds + (bufoff) + ldsw + _i * 8192), 16, 0, 0); } while (0)
#define PG8_LDA(dst, b, h) do { _Pragma("unroll") for (int m = 0; m < 4; ++m) _Pragma("unroll") for (int k = 0; k < 2; ++k) dst[m][k] = *(const LAS bf16x8*)(lds + PG8_SA(b, h) + aoff + m * 2048 + k * 1024); } while (0)
#define PG8_LDB(dst, b, h) do { _Pragma("unroll") for (int n = 0; n < 2; ++n) _Pragma("unroll") for (int k = 0; k < 2; ++k) dst[n][k] = *(const LAS bf16x8*)(lds + PG8_SB(b, h) + boff + n * 2048 + k * 1024); } while (0)
#define PG8_MMA(ai, bj, At, Bt) do { __builtin_amdgcn_s_setprio(1); _Pragma("unroll") for (int m = 0; m < 4; ++m) _Pragma("unroll") for (int n = 0; n < 2; ++n) _Pragma("unroll") for (int k = 0; k < 2; ++k) \
        acc[ai][bj][m][n] = __builtin_amdgcn_mfma_f32_16x16x32_bf16(Bt[n][k], At[m][k], acc[ai][bj][m][n], 0, 0, 0); __builtin_amdgcn_s_setprio(0); } while (0)
#define PG8_WAIT_V(n) asm volatile("s_waitcnt vmcnt(" #n ")" ::: "memory")
#define PG8_WAIT_L(n) asm volatile("s_waitcnt lgkmcnt(" #n ")" ::: "memory")
#define PG8_BAR __builtin_amdgcn_s_barrier()
#define PG8_SCHED __builtin_amdgcn_sched_barrier(0)
    Unit cur, nxt; int ui = 0;
    if (!S.next(0, cur)) return;
    f32x4 acc[2][2][4][2];
#pragma unroll
    for (int a = 0; a < 2; ++a)
#pragma unroll
        for (int b = 0; b < 2; ++b)
#pragma unroll
            for (int m = 0; m < 4; ++m)
#pragma unroll
                for (int n = 0; n < 2; ++n) acc[a][b][m][n] = (f32x4){0.f, 0.f, 0.f, 0.f};
    bf16x8 At[4][2], B0[2][2], B1[2][2];
    const char* cA = (const char*)(g.A + (size_t)cur.grp * g.grpA) + (size_t)cur.pm * tstepA;
    const char* cB = (const char*)(g.Bt + (size_t)cur.grp * g.grpB) + (size_t)cur.pn * tstepB;
    PG8_STAGE(PG8_SB(0, 0), cB, voffB); PG8_STAGE(PG8_SB(0, 1), cB + hstepB, voffB); PG8_STAGE(PG8_SA(0, 0), cA, voffA); PG8_STAGE(PG8_SA(0, 1), cA + hstepA, voffA);
    if (wr == 1) PG8_BAR;
    PG8_WAIT_V(2); PG8_BAR;
    PG8_STAGE(PG8_SB(1, 0), cB + kstep, voffB); PG8_STAGE(PG8_SA(1, 0), cA + kstep, voffA); PG8_STAGE(PG8_SB(1, 1), cB + hstepB + kstep, voffB);
    PG8_WAIT_V(6); PG8_BAR;
    for (;;) {
        const bool has_next = S.next(ui + 1, nxt);
        const char* nA = has_next ? (const char*)(g.A + (size_t)nxt.grp * g.grpA) + (size_t)nxt.pm * tstepA : cA;
        const char* nB = has_next ? (const char*)(g.Bt + (size_t)nxt.grp * g.grpB) + (size_t)nxt.pn * tstepB : cB;
        for (int t = 0; t < nt; t += 2) {
            const bool last = (t == nt - 2);
            const char* a1 = cA + (size_t)(t + 1) * kstep;
            const char* a2 = last ? nA : cA + (size_t)(t + 2) * kstep; const char* b2 = last ? nB : cB + (size_t)(t + 2) * kstep;
            const char* a3 = a2 + kstep; const char* b3 = b2 + kstep;
            PG8_LDB(B0, 0, 0); PG8_LDB(B1, 0, 1); PG8_SCHED; PG8_LDA(At, 0, 0); PG8_STAGE(PG8_SA(1, 1), a1 + hstepA, voffA);
            PG8_WAIT_V(8); PG8_WAIT_L(0); PG8_BAR; PG8_MMA(0, 0, At, B0); PG8_MMA(0, 1, At, B1); PG8_BAR; PG8_SCHED;
            PG8_LDA(At, 0, 1); PG8_STAGE(PG8_SB(0, 0), b2, voffB); PG8_STAGE(PG8_SB(0, 1), b2 + hstepB, voffB); PG8_STAGE(PG8_SA(0, 0), a2, voffA);
            PG8_WAIT_V(8); PG8_WAIT_L(0); PG8_BAR; PG8_MMA(1, 0, At, B0); PG8_MMA(1, 1, At, B1); PG8_BAR; PG8_SCHED;
            PG8_LDB(B0, 1, 0); PG8_LDB(B1, 1, 1); PG8_SCHED; PG8_LDA(At, 1, 0); PG8_STAGE(PG8_SA(0, 1), a2 + hstepA, voffA);
            PG8_WAIT_V(8); PG8_WAIT_L(0); PG8_BAR; PG8_MMA(0, 0, At, B0); PG8_MMA(0, 1, At, B1); PG8_BAR; PG8_SCHED;
            PG8_LDA(At, 1, 1); PG8_STAGE(PG8_SB(1, 0), b3, voffB); PG8_STAGE(PG8_SB(1, 1), b3 + hstepB, voffB); PG8_STAGE(PG8_SA(1, 0), a3, voffA);
            PG8_WAIT_V(8); PG8_WAIT_L(0); PG8_BAR; PG8_MMA(1, 0, At, B0); PG8_MMA(1, 1, At, B1); PG8_BAR; PG8_SCHED;
        }
        if (wr == 0) PG8_BAR;
        E(acc, cur, wr, wc, fr, fq);
        if (!has_next) break;
#pragma unroll
        for (int a = 0; a < 2; ++a)
#pragma unroll
            for (int b = 0; b < 2; ++b)
#pragma unroll
                for (int m = 0; m < 4; ++m)
#pragma unroll
                    for (int n = 0; n < 2; ++n) acc[a][b][m][n] = (f32x4){0.f, 0.f, 0.f, 0.f};
        cur = nxt; cA = nA; cB = nB; ++ui;
        if (wr == 1) PG8_BAR;
    }
    PG8_WAIT_V(0);
    PG8_BAR;
#undef PG8_SA
#undef PG8_SB
#undef PG8_STAGE
#undef PG8_LDA
#undef PG8_LDB
#undef PG8_MMA
#undef PG8_WAIT_V
#undef PG8_WAIT_L
#undef PG8_BAR
#undef PG8_SCHED
}

template <int NP> __device__ __forceinline__ float row_rstd(const float* ss, int row, int fq, float invn) {
    const float* p = ss + (size_t)row * NP + fq * (NP / 4); float s;
    if constexpr (NP == 32) { const f32x4 a = *(const f32x4*)p, b = *(const f32x4*)(p + 4); s = ((a[0] + a[1]) + (a[2] + a[3])) + ((b[0] + b[1]) + (b[2] + b[3])); }
    else { const f32x2 a = *(const f32x2*)p; s = a[0] + a[1]; }
    s += __shfl_xor(s, 16); s += __shfl_xor(s, 32);
    return __builtin_amdgcn_rsqf(s * invn + EPS);
}
__device__ __forceinline__ float rowsum4(float q) { q += __shfl_xor(q, 16); q += __shfl_xor(q, 32); return q; }

struct EpiResid {
    const float* basf; const bf16_t* basb; bf16_t* xb; float* ss; int colgrp;
    __device__ __forceinline__ void operator()(const f32x4 (&acc)[2][2][4][2], const Unit& u, int wr, int wc, int fr, int fq) const {
        const int row0 = u.pm * BM + wr * 64 + fr, colb = u.grp * colgrp + u.pn * BM, col0 = colb + wc * 32 + 8 * fq, pidx = (colb >> 6) + wc;
        f32x4 pre[3][4];
#define RB_LOAD(it, P) do { const size_t off_ = (size_t)(row0 + ((it) >> 2) * HALF + ((it) & 3) * 16) * DM + col0; \
        if (basf) { P[0] = *(const f32x4*)(basf + off_); P[1] = *(const f32x4*)(basf + off_ + 4); P[2] = *(const f32x4*)(basf + off_ + HALF); P[3] = *(const f32x4*)(basf + off_ + HALF + 4); } \
        else { const u32x4 w0_ = *(const u32x4*)(basb + off_), w1_ = *(const u32x4*)(basb + off_ + HALF); \
               P[0] = (f32x4){__uint_as_float(w0_.x << 16), __uint_as_float(w0_.x & 0xffff0000u), __uint_as_float(w0_.y << 16), __uint_as_float(w0_.y & 0xffff0000u)}; \
               P[1] = (f32x4){__uint_as_float(w0_.z << 16), __uint_as_float(w0_.z & 0xffff0000u), __uint_as_float(w0_.w << 16), __uint_as_float(w0_.w & 0xffff0000u)}; \
               P[2] = (f32x4){__uint_as_float(w1_.x << 16), __uint_as_float(w1_.x & 0xffff0000u), __uint_as_float(w1_.y << 16), __uint_as_float(w1_.y & 0xffff0000u)}; \
               P[3] = (f32x4){__uint_as_float(w1_.z << 16), __uint_as_float(w1_.z & 0xffff0000u), __uint_as_float(w1_.w << 16), __uint_as_float(w1_.w & 0xffff0000u)}; } } while (0)
        RB_LOAD(0, pre[0]); RB_LOAD(1, pre[1]);
#pragma unroll
        for (int it = 0; it < 8; ++it) { const int ai = it >> 2, m = it & 3, row = row0 + ai * HALF + m * 16; const size_t off = (size_t)row * DM + col0; float q = 0.f;
            if (it + 2 < 8) RB_LOAD(it + 2, pre[(it + 2) % 3]);
#pragma unroll
            for (int bj = 0; bj < 2; ++bj) {
                const f32x4 v0 = acc[ai][bj][m][0] + pre[it % 3][2 * bj], v1 = acc[ai][bj][m][1] + pre[it % 3][2 * bj + 1];
                *(u32x4*)(xb + off + bj * HALF) = pack8(v0, v1);
                q += sq4(v0) + sq4(v1); }
            q = rowsum4(q); if (fq == 0) ss[(size_t)row * 32 + pidx] = q; }
#undef RB_LOAD
    }
};
struct EpiSwiGLU {
    bf16_t* mid; const float* ss;
    __device__ __forceinline__ void operator()(const f32x4 (&acc)[2][2][4][2], const Unit& u, int wr, int wc, int fr, int fq) const {
        const int row0 = u.pm * BM + wr * 64 + fr, col0 = u.pn * HALF + wc * 32 + 8 * fq;
#pragma unroll
        for (int ai = 0; ai < 2; ++ai)
#pragma unroll
            for (int m = 0; m < 4; ++m) { const int row = row0 + ai * HALF + m * 16; const float s = row_rstd<32>(ss, row, fq, 1.f / DM);
                f32x4 h[2];
#pragma unroll
                for (int n = 0; n < 2; ++n) { const f32x4 gg = acc[ai][0][m][n] * s, uu = acc[ai][1][m][n] * s;
#pragma unroll
                    for (int e = 0; e < 4; ++e) h[n][e] = gg[e] * __builtin_amdgcn_rcpf(1.f + __builtin_amdgcn_exp2f(-1.4426950408889634f * gg[e])) * uu[e]; }
                *(u32x4*)(mid + (size_t)row * DFF + col0) = pack8(h[0], h[1]); }
    }
};
__device__ __forceinline__ void rope8(f32x4& v0, f32x4& v1, const float* cs  ) {
    const f32x4 c0 = *(const f32x4*)cs, c1 = *(const f32x4*)(cs + 4);
    const f32x4 a = v0, b = v1;
    v0 = (f32x4){a[0] * c0[0] - a[1] * c0[1], a[1] * c0[0] + a[0] * c0[1], a[2] * c0[2] - a[3] * c0[3], a[3] * c0[2] + a[2] * c0[3]};
    v1 = (f32x4){b[0] * c1[0] - b[1] * c1[1], b[1] * c1[0] + b[0] * c1[1], b[2] * c1[2] - b[3] * c1[3], b[3] * c1[2] + b[2] * c1[3]};
}
struct EpiA {
    const float* ss; bf16_t* qa; bf16_t* kva; float* ssq; float* sskv; bf16_t* Kb; const float* cs;
    __device__ __forceinline__ void operator()(const f32x4 (&acc)[2][2][4][2], const Unit& u, int wr, int wc, int fr, int fq) const {
        const int row0 = u.pm * BM + wr * 64 + fr;
        if (u.pn < 4) {
            bf16_t* dst = u.pn < 2 ? qa : kva; float* sso = u.pn < 2 ? ssq : sskv; const int colb = (u.pn & 1) * BM, col0 = colb + wc * 32 + 8 * fq, pidx = (u.pn & 1) * 4 + wc;
#pragma unroll
            for (int ai = 0; ai < 2; ++ai)
#pragma unroll
                for (int m = 0; m < 4; ++m) { const int row = row0 + ai * HALF + m * 16; const float s = row_rstd<32>(ss, row, fq, 1.f / DM); float q = 0.f;
#pragma unroll
                    for (int bj = 0; bj < 2; ++bj) { const f32x4 v0 = acc[ai][bj][m][0] * s, v1 = acc[ai][bj][m][1] * s;
                        *(u32x4*)(dst + (size_t)row * 512 + col0 + bj * HALF) = pack8(v0, v1); q += sq4(v0) + sq4(v1); }
                    q = rowsum4(q); if (fq == 0) sso[(size_t)row * 8 + pidx] = q; }
        } else {
            const int p0 = wc * 32 + 8 * fq;
#pragma unroll
            for (int ai = 0; ai < 2; ++ai)
#pragma unroll
                for (int m = 0; m < 4; ++m) { const int row = row0 + ai * HALF + m * 16; const float s = row_rstd<32>(ss, row, fq, 1.f / DM);
                    if (wc < 2) { f32x4 v0 = acc[ai][0][m][0] * s, v1 = acc[ai][0][m][1] * s; rope8(v0, v1, cs + ((size_t)row * 32 + (p0 >> 1)) * 2);
                        const u32x4 w = pack8(v0, v1); bf16_t* kp = Kb + (size_t)row * 3072 + 128 + p0;
#pragma unroll
                        for (int h = 0; h < NH; ++h) *(u32x4*)(kp + h * 192) = w; } }
        }
    }
};
struct EpiQ {
    const float* ssq; bf16_t* Q; const float* cs;
    __device__ __forceinline__ void operator()(const f32x4 (&acc)[2][2][4][2], const Unit& u, int wr, int wc, int fr, int fq) const {
        const int row0 = u.pm * BM + wr * 64 + fr;
#pragma unroll
        for (int ai = 0; ai < 2; ++ai)
#pragma unroll
            for (int m = 0; m < 4; ++m) { const int row = row0 + ai * HALF + m * 16; const float s = row_rstd<8>(ssq, row, fq, 1.f / 512.f) * C2Q;
#pragma unroll
                for (int bj = 0; bj < 2; ++bj) { f32x4 v0 = acc[ai][bj][m][0] * s, v1 = acc[ai][bj][m][1] * s;
                    if (u.pn < 8) { *(u32x4*)(Q + (size_t)row * 3072 + (2 * u.pn + bj) * 192 + wc * 32 + 8 * fq) = pack8(v0, v1); }
                    else { const int head = 4 * (u.pn - 8) + 2 * bj + (wc >> 1), p0 = 32 * (wc & 1) + 8 * fq; rope8(v0, v1, cs + ((size_t)row * 32 + (p0 >> 1)) * 2);
                        *(u32x4*)(Q + (size_t)row * 3072 + head * 192 + 128 + p0) = pack8(v0, v1); } } }
    }
};
struct EpiKV {
    const float* sskv; bf16_t* Kb; bf16_t* Vb;
    __device__ __forceinline__ void operator()(const f32x4 (&acc)[2][2][4][2], const Unit& u, int wr, int wc, int fr, int fq) const {
        const int row0 = u.pm * BM + wr * 64 + fr;
#pragma unroll
        for (int ai = 0; ai < 2; ++ai)
#pragma unroll
            for (int m = 0; m < 4; ++m) { const int row = row0 + ai * HALF + m * 16; const float s = row_rstd<8>(sskv, row, fq, 1.f / 512.f);
#pragma unroll
                for (int bj = 0; bj < 2; ++bj) { const f32x4 v0 = acc[ai][bj][m][0] * s, v1 = acc[ai][bj][m][1] * s;
                    bf16_t* d = u.pn < 8 ? Kb + (size_t)row * 3072 + (2 * u.pn + bj) * 192 + wc * 32 + 8 * fq : Vb + (size_t)row * 2048 + (2 * (u.pn - 8) + bj) * 128 + wc * 32 + 8 * fq;
                    *(u32x4*)d = pack8(v0, v1); } }
    }
};
}

namespace att {
constexpr int NW = 8, QBLK = 32, KVBLK = 64, QB = 256;
constexpr int LDQ = 3072, LDK = 3072, LDV = 2048, LDO = 2048;
constexpr int KROWB = 400;
constexpr int SHM_K = KVBLK * KROWB, SHM_V = KVBLK * 128 * 2;
constexpr int NQR = 12;
constexpr int LDS_K0 = 3 * SHM_V, LDS_WS = LDS_K0 + 2 * SHM_K, LDS_QS = LDS_WS + NW * 64 * 4, LDS_TOTAL = LDS_QS + NW * (12 - NQR) * 1024;
constexpr float THR = 8.f;
#define SBAR() __builtin_amdgcn_sched_barrier(0)
__device__ __forceinline__ int v_st(int k, int c) { const int kk = (k & ~0xC) | ((k & 4) << 1) | ((k & 8) >> 1); return ((kk >> 3) * 4 + (c >> 5)) * 512 + ((kk & 7) * 32 + (c & 31)) * 2; }
__device__ __forceinline__ int v_rd_base(int lane) { return ((lane & 3) << 3) | (((lane >> 2) & 3) << 6) | (((lane >> 4) & 1) << 5) | (((lane >> 5) & 1) << 8); }
constexpr int v_rd_off(int d0, int ks, int half) { return d0 * 512 + ks * 4096 + half * 2048; }
__device__ __forceinline__ int crow(int r, int hi) { return (r & 3) + 8 * (r >> 2) + 4 * hi; }
__device__ __forceinline__ bf16x8 ldg8(const bf16_t* base, unsigned off) { return *reinterpret_cast<const bf16x8*>(base + off); }
__device__ __forceinline__ void mask_tile(f32x16& p0, f32x16& p1, int dq) {
    const float NEG = -__builtin_inff();
#pragma unroll
    for (int r = 0; r < 16; ++r) { const int c = (r & 3) + 8 * (r >> 2); if (dq - c < 0) p0[r] = NEG; if (dq - c - 32 < 0) p1[r] = NEG; }
}
__device__ __forceinline__ void qkt(f32x16& p0, f32x16& p1, const char* a, const char* qs, const bf16x8* qr, float negm) {
#pragma unroll
    for (int r = 0; r < 16; ++r) { p0[r] = negm; p1[r] = negm; }
    bf16x8 kA[3], kB[3], qv[3];
#define KL(d) do { kA[(d) % 3] = *reinterpret_cast<const bf16x8*>(a + (d) * 32); kB[(d) % 3] = *reinterpret_cast<const bf16x8*>(a + (d) * 32 + 32 * KROWB); \
        if ((d) >= NQR) qv[(d) % 3] = *reinterpret_cast<const bf16x8*>(qs + ((d) - NQR) * 1024); } while (0)
    KL(0); KL(1);
#pragma unroll
    for (int d0 = 0; d0 < 12; ++d0) {
        if (d0 + 2 < 12) KL(d0 + 2);
        SBAR();
        const bf16x8 q = d0 < NQR ? qr[d0 < NQR ? d0 : 0] : qv[d0 % 3];
        p0 = __builtin_amdgcn_mfma_f32_32x32x16_bf16(kA[d0 % 3], q, p0, 0, 0, 0);
        p1 = __builtin_amdgcn_mfma_f32_32x32x16_bf16(kB[d0 % 3], q, p1, 0, 0, 0);
        SBAR(); }
#undef KL
}
__device__ __forceinline__ void softmax_tile(f32x16& p0, f32x16& p1, float& m_reg, float& l_reg, float& alpha, bf16x8& pa0, bf16x8& pa1, bf16x8& pa2, bf16x8& pa3) {
    float pmax = fmaxf(p0[0], p1[0]);
#pragma unroll
    for (int r = 1; r < 16; ++r) pmax = fmaxf(fmaxf(pmax, p0[r]), p1[r]);
    { auto rr = __builtin_amdgcn_permlane32_swap(__float_as_uint(pmax), __float_as_uint(pmax), false, false); pmax = fmaxf(__uint_as_float(rr[0]), __uint_as_float(rr[1])); }
    alpha = 1.f;
    if (__builtin_expect(!__all(pmax <= THR), 0)) { const float dl = fmaxf(pmax, 0.f); m_reg += dl; alpha = __builtin_amdgcn_exp2f(-dl);
#pragma unroll
        for (int r = 0; r < 16; ++r) { p0[r] -= dl; p1[r] -= dl; } }
#pragma unroll
    for (int r = 0; r < 16; ++r) { p0[r] = __builtin_amdgcn_exp2f(p0[r]); p1[r] = __builtin_amdgcn_exp2f(p1[r]); }
    float ps = 0.f;
#pragma unroll
    for (int r = 0; r < 16; ++r) ps += p0[r] + p1[r];
    { auto rr = __builtin_amdgcn_permlane32_swap(__float_as_uint(ps), __float_as_uint(ps), false, false); ps = __uint_as_float(rr[0]) + __uint_as_float(rr[1]); }
    l_reg = l_reg * alpha + ps;
#define PK4(P, B_, OUT) do { unsigned a0 = cvt_pk_bf16(P[B_+0], P[B_+1]), a1 = cvt_pk_bf16(P[B_+2], P[B_+3]); \
        unsigned b0 = cvt_pk_bf16(P[B_+4], P[B_+5]), b1 = cvt_pk_bf16(P[B_+6], P[B_+7]); \
        auto r0 = __builtin_amdgcn_permlane32_swap(a0, b0, false, false); auto r1 = __builtin_amdgcn_permlane32_swap(a1, b1, false, false); \
        u32x4 w = {r0[0], r1[0], r0[1], r1[1]}; OUT = *reinterpret_cast<bf16x8*>(&w); } while (0)
    PK4(p0, 0, pa0); PK4(p0, 8, pa1); PK4(p1, 0, pa2); PK4(p1, 8, pa3);
#undef PK4
}
__device__ __forceinline__ void pv_tile(f32x16* o, int vb, bf16x8 pa0, bf16x8 pa1, bf16x8 pa2, bf16x8 pa3) {
#define TRRD(dst, off) asm volatile("ds_read_b64_tr_b16 %0, %1 offset:%2" : "=&v"(dst) : "v"(vb), "i"(off) : "memory")
#define TR8(S, d0) do { constexpr int b_ = v_rd_off(d0, 0, 0); TRRD(S##l0, b_); TRRD(S##h0, b_ + 2048); TRRD(S##l1, b_ + 4096); TRRD(S##h1, b_ + 6144); \
        TRRD(S##l2, b_ + 8192); TRRD(S##h2, b_ + 10240); TRRD(S##l3, b_ + 12288); TRRD(S##h3, b_ + 14336); } while (0)
#define MM4(S, d0) do { \
        o[d0] = __builtin_amdgcn_mfma_f32_32x32x16_bf16(pa0, (bf16x8){S##l0[0], S##l0[1], S##l0[2], S##l0[3], S##h0[0], S##h0[1], S##h0[2], S##h0[3]}, o[d0], 0, 0, 0); \
        o[d0] = __builtin_amdgcn_mfma_f32_32x32x16_bf16(pa1, (bf16x8){S##l1[0], S##l1[1], S##l1[2], S##l1[3], S##h1[0], S##h1[1], S##h1[2], S##h1[3]}, o[d0], 0, 0, 0); \
        o[d0] = __builtin_amdgcn_mfma_f32_32x32x16_bf16(pa2, (bf16x8){S##l2[0], S##l2[1], S##l2[2], S##l2[3], S##h2[0], S##h2[1], S##h2[2], S##h2[3]}, o[d0], 0, 0, 0); \
        o[d0] = __builtin_amdgcn_mfma_f32_32x32x16_bf16(pa3, (bf16x8){S##l3[0], S##l3[1], S##l3[2], S##l3[3], S##h3[0], S##h3[1], S##h3[2], S##h3[3]}, o[d0], 0, 0, 0); } while (0)
    s16x4 Al0, Al1, Al2, Al3, Ah0, Ah1, Ah2, Ah3, Bl0, Bl1, Bl2, Bl3, Bh0, Bh1, Bh2, Bh3;
    TR8(A, 0); TR8(B, 1);
    asm volatile("s_waitcnt lgkmcnt(8)" ::: "memory"); SBAR(); MM4(A, 0); SBAR();
    TR8(A, 2);
    asm volatile("s_waitcnt lgkmcnt(8)" ::: "memory"); SBAR(); MM4(B, 1); SBAR();
    TR8(B, 3);
    asm volatile("s_waitcnt lgkmcnt(8)" ::: "memory"); SBAR(); MM4(A, 2); SBAR();
    asm volatile("s_waitcnt lgkmcnt(0)" ::: "memory"); SBAR(); MM4(B, 3);
#undef MM4
#undef TR8
#undef TRRD
}
#define VMW() asm volatile("s_waitcnt vmcnt(0)" ::: "memory")
#define SLOAD(Kp, Vp) do { const bf16_t* vp_ = (Vp); st_v0 = ldg8(vp_, voff); st_v1 = ldg8(vp_ + 32 * LDV, voff); \
        const bf16_t* kp_ = (Kp); st_k0 = ldg8(kp_, koff); st_k1 = ldg8(kp_ + 64, koff); st_k2 = ldg8(kp_ + 128, koff); } while (0)
#define SWRITE(kb_, vb_) do { char* d_ = K_lds + (kb_) * SHM_K + kws; *(bf16x8*)d_ = st_k0; *(bf16x8*)(d_ + 128) = st_k1; *(bf16x8*)(d_ + 256) = st_k2; \
        *(bf16x8*)(V_lds + (vb_) * SHM_V + vst0) = st_v0; *(bf16x8*)(V_lds + (vb_) * SHM_V + vst1) = st_v1; } while (0)
#define BLK_BH(ii) (xcd * 8 + (ii))
#define BLK_QB(ii) (((ii) & 1) ? 31 - j : j)
#define TILEPTR(ii, nn, Kp, Vp) do { const int bh_ = BLK_BH(ii), qb_ = BLK_QB(ii), tl_ = ((ii) & 1) ? 4 * qb_ + 3 - (nn) : (nn); \
        const size_t row_ = (size_t)(bh_ >> 4) * SEQ + (size_t)tl_ * KVBLK; Kp = Kall + row_ * LDK + (bh_ & 15) * 192; Vp = Vall + row_ * LDV + (bh_ & 15) * 128; } while (0)
__device__ __forceinline__ void attn_stream(const bf16_t* Qall, const bf16_t* Kall, const bf16_t* Vall, bf16_t* Oall, int sid, char* lds) {
    const int xcd = sid >> 5, j = sid & 31;
    const int tid = threadIdx.x, wid = __builtin_amdgcn_readfirstlane(tid >> 6), lane = tid & 63, r32 = lane & 31, hi = lane >> 5;
    const int sr = tid >> 4, sc = (tid & 15) * 8, kr = tid >> 3;
    const unsigned voff = (unsigned)(sr * LDV + sc), koff = (unsigned)(kr * LDK + (tid & 7) * 8), qoff = (unsigned)((wid * QBLK + r32) * LDQ + hi * 8);
    const int kws = kr * KROWB + (tid & 7) * 16, vst0 = v_st(sr, sc), vst1 = v_st(32 + sr, sc);
    char* V_lds = lds; char* K_lds = lds + LDS_K0; char* qs = lds + LDS_QS + wid * ((12 - NQR) * 1024) + lane * 16;
    float* ws = (float*)(lds + LDS_WS) + wid * 64; float* li_l = ws, * al_l = ws + 32;
    const char* ka0 = K_lds + r32 * KROWB + hi * 16;
    const int vrb = (int)(uintptr_t)V_lds + v_rd_base(lane);
    const bool grpB = wid >= 4;
    bf16x8 st_v0, st_v1, st_k0, st_k1, st_k2;
    bf16x8 qr[NQR];
    f32x16 o[4], p0, p1; float m_reg, l_reg, al; bf16x8 pa0, pa1, pa2, pa3;
    const bf16_t* kp; const bf16_t* vp;
    { const int bh0 = BLK_BH(0); const bf16_t* Q0 = Qall + ((size_t)(bh0 >> 4) * SEQ + (size_t)BLK_QB(0) * QB) * LDQ + (bh0 & 15) * 192;
#pragma unroll
      for (int d0 = 0; d0 < NQR; ++d0) qr[d0] = ldg8(Q0 + d0 * 16, qoff);
#pragma unroll
      for (int d0 = NQR; d0 < 12; ++d0) *(bf16x8*)(qs + (d0 - NQR) * 1024) = ldg8(Q0 + d0 * 16, qoff);
#pragma unroll
      for (int d0 = 0; d0 < NQR; ++d0) asm volatile("" : "+v"(qr[d0]));
      TILEPTR(0, 0, kp, vp); SLOAD(kp, vp); VMW(); SWRITE(0, 0); }
    __syncthreads();
    if (grpB) { TILEPTR(0, 1, kp, vp); SLOAD(kp, vp); }
    int kb = 0, vb = 0;
    for (int i = 0; i < 8; ++i) {
        const int bh = BLK_BH(i), qb = BLK_QB(i), NT = 4 * qb + 4, qlo = qb * QB + wid * QBLK, qm = qlo + r32 - 4 * hi;
        const bool more = i < 7, desc = i & 1;
        m_reg = 0.f; l_reg = 0.f;
#pragma unroll
        for (int d = 0; d < 4; ++d) o[d] = f32x16{};
        for (int n = 0; n < NT; ++n) {
            const int t = desc ? NT - 1 - n : n;
            const bool v1 = (n + 1 < NT) || more; bool v2 = true; if (n + 2 >= NT) v2 = more;
            const int kb1 = kb ^ 1, vb1 = vb == 2 ? 0 : vb + 1;
            if (!grpB && v1) { if (n + 1 < NT) TILEPTR(i, n + 1, kp, vp); else TILEPTR(i + 1, 0, kp, vp); SLOAD(kp, vp); }
            SBAR(); qkt(p0, p1, ka0 + kb * SHM_K, qs, qr, -m_reg); SBAR();
            if (grpB) { if (v1) { VMW(); SWRITE(kb1, vb1); } __syncthreads();
                        if (v2) { if (n + 2 < NT) TILEPTR(i, n + 2, kp, vp); else TILEPTR(i + 1, n + 2 - NT, kp, vp); SLOAD(kp, vp); } }
            SBAR();
            { const int kb_ = t * KVBLK; if (kb_ + KVBLK - 1 > qlo) mask_tile(p0, p1, qm - kb_); }
            softmax_tile(p0, p1, m_reg, l_reg, al, pa0, pa1, pa2, pa3);
            if (__any(al < 1.f)) { if (hi == 0) al_l[r32] = al; asm volatile("s_waitcnt lgkmcnt(0)" ::: "memory");
#pragma unroll
                for (int d_ = 0; d_ < 4; ++d_)
#pragma unroll
                    for (int r = 0; r < 16; ++r) o[d_][r] *= al_l[crow(r, hi)]; }
            SBAR(); pv_tile(o, vrb + vb * SHM_V, pa0, pa1, pa2, pa3); SBAR();
            if (!grpB) { if (v1) { VMW(); SWRITE(kb1, vb1); } __syncthreads(); }
            kb = kb1; vb = vb1;
        }
        {
            if (hi == 0) li_l[r32] = l_reg; asm volatile("s_waitcnt lgkmcnt(0)" ::: "memory");
            bf16_t* Ow = Oall + ((size_t)(bh >> 4) * SEQ + (size_t)qb * QB) * LDO + (bh & 15) * 128; unsigned ooff = (unsigned)((wid * QBLK + 4 * hi) * LDO + r32); asm volatile("" : "+v"(ooff));
#pragma unroll
            for (int r = 0; r < 16; ++r) { const int orow = (r & 3) + 8 * (r >> 2); const float rl = __builtin_amdgcn_rcpf(li_l[crow(r, hi)]);
#pragma unroll
                for (int d0 = 0; d0 < 4; ++d0) { const float v = o[d0][r] * rl; const float vn = __shfl_xor(v, 1);
                    if ((r32 & 1) == 0) *(unsigned*)(Ow + orow * LDO + d0 * 32 + ooff) = cvt_pk_bf16(v, vn); } }
            if (more) {
                const int bhn = BLK_BH(i + 1); const bf16_t* Qn = Qall + ((size_t)(bhn >> 4) * SEQ + (size_t)BLK_QB(i + 1) * QB) * LDQ + (bhn & 15) * 192;
#pragma unroll
                for (int d0 = 0; d0 < NQR; ++d0) qr[d0] = ldg8(Qn + d0 * 16, qoff);
#pragma unroll
                for (int d0 = NQR; d0 < 12; ++d0) *(bf16x8*)(qs + (d0 - NQR) * 1024) = ldg8(Qn + d0 * 16, qoff);
#pragma unroll
                for (int d0 = 0; d0 < NQR; ++d0) asm volatile("" : "+v"(qr[d0])); } }
    }
    asm volatile("s_waitcnt vmcnt(0)" ::: "memory"); __syncthreads();
}
#undef BLK_BH
#undef BLK_QB
#undef TILEPTR
#undef VMW
#undef SLOAD
#undef SWRITE
#undef SBAR
}

constexpr size_t MiB = 1u << 20;
constexpr size_t WS_BAR = 7 * MiB, WS_RSTD0 = 0, WS_SSQ = 1 * MiB, WS_SSKV = 2 * MiB, WS_SS = 3 * MiB, WS_CS = 8 * MiB;
constexpr size_t WS_WPOOL = 16 * MiB, WS_WA = 18 * MiB, WS_WQB = 23 * MiB, WS_WKVB = 26 * MiB, WS_WO = 30 * MiB;
constexpr size_t WS_WGU0 = 38 * MiB, WS_WDN0 = 82 * MiB, WS_WGU1 = 104 * MiB, WS_WDN1 = 148 * MiB;
constexpr size_t WS_B0 = 170 * MiB, WS_B1 = 298 * MiB, WS_QA = 426 * MiB, WS_KVA = 458 * MiB;
constexpr size_t WS_Q = 490 * MiB, WS_K = 682 * MiB, WS_V = 874 * MiB, WS_MID = 490 * MiB, WS_END = 1002 * MiB;
constexpr int LDS_BYTES = 155648;
static_assert(att::LDS_TOTAL <= LDS_BYTES && pg8::STAGE_BYTES <= LDS_BYTES, "LDS map");

#define XB_TMO      128
#define XB_XCNT(j)  (256  + 64 * (j))
#define XB_XSUB(j)  (1280 + 64 * (j))
#define XB_XGEN(j)  (2304 + 64 * (j))
#define XB_TOP      3328
#define XB_TOPGEN   3392
#define XCD_BAR_WORDS 3456
#define XB_SPIN_CAP (1u << 18)
__device__ __forceinline__ unsigned xb_ld(unsigned* p)              { return __hip_atomic_load(p, __ATOMIC_RELAXED, __HIP_MEMORY_SCOPE_AGENT); }
__device__ __forceinline__ unsigned xb_add(unsigned* p, unsigned v) { return __hip_atomic_fetch_add(p, v, __ATOMIC_RELAXED, __HIP_MEMORY_SCOPE_AGENT); }
__device__ __forceinline__ unsigned xb_xcc_id() { return (unsigned)__builtin_amdgcn_s_getreg((3 << 11) | 20) & 0xFu; }
#define XB_SPIN(cond, bar) do { unsigned _sp = 0; while (cond) { __builtin_amdgcn_s_sleep(1); \
    if ((++_sp & 255u) == 0u) { if (xb_ld(&(bar)[XB_TMO])) break; if (_sp > XB_SPIN_CAP) { atomicAdd(&(bar)[XB_TMO], 1u); break; } } } } while (0)
struct XcdBarrier { unsigned* bar; unsigned x; volatile LAS unsigned* st; };
__device__ __forceinline__ XcdBarrier xcd_barrier_post(unsigned* bar, volatile LAS unsigned* st) {
    XcdBarrier b; b.bar = bar; b.x = xb_xcc_id(); b.st = st;
    if (threadIdx.x == 0) (void)xb_add(&bar[XB_XCNT(b.x)], 1u);
    return b;
}
__device__ __forceinline__ void xcd_barrier_complete(unsigned* bar, unsigned x, unsigned& nloc, unsigned& nx) {
    const unsigned G = gridDim.x * gridDim.y * gridDim.z;
    unsigned sum, cnt, mine, sp = 0u;
    for (;;) {
        sum = 0u; cnt = 0u; mine = 0u;
#pragma unroll
        for (unsigned j = 0; j < 16; ++j) { const unsigned c = xb_ld(&bar[XB_XCNT(j)]); sum += c; cnt += (c > 0u) ? 1u : 0u; mine = (j == x) ? c : mine; }
        if (sum == G) break;
        __builtin_amdgcn_s_sleep(1);
        if ((++sp & 255u) == 0u) { if (xb_ld(&bar[XB_TMO])) break; if (sp > XB_SPIN_CAP) { atomicAdd(&bar[XB_TMO], 1u); break; } }
    }
    nloc = mine > 0u ? mine : 1u; nx = cnt > 0u ? cnt : 1u;
}
__device__ __forceinline__ void xcd_barrier(const XcdBarrier& b) {
    asm volatile("s_waitcnt vmcnt(0)" ::: "memory");
    __syncthreads();
    if (threadIdx.x == 0) {
        unsigned* bar = b.bar;
        __builtin_amdgcn_s_waitcnt(0);
        unsigned nloc = b.st[0], nx = b.st[1];
        if (nloc == 0u) { xcd_barrier_complete(bar, b.x, nloc, nx); b.st[0] = nloc; b.st[1] = nx; }
        const unsigned old = xb_add(&bar[XB_XSUB(b.x)], 1u);
        const unsigned gen = old / nloc;
        if (old + 1u == (gen + 1u) * nloc) {
            __builtin_amdgcn_fence(__ATOMIC_RELEASE, "agent");
            asm volatile("s_waitcnt vmcnt(0)" ::: "memory");
            const unsigned og = xb_add(&bar[XB_TOP], 1u);
            const unsigned tg = og / nx;
            if (og + 1u == (tg + 1u) * nx) xb_add(&bar[XB_TOPGEN], 1u);
            else XB_SPIN(xb_ld(&bar[XB_TOPGEN]) == tg, bar);
            __builtin_amdgcn_fence(__ATOMIC_ACQUIRE, "agent");
            xb_add(&bar[XB_XGEN(b.x)], 1u);
            asm volatile("s_waitcnt vmcnt(0)" ::: "memory");
        } else {
            XB_SPIN(xb_ld(&bar[XB_XGEN(b.x)]) == gen, bar);
            __builtin_amdgcn_fence(__ATOMIC_ACQUIRE, "agent");
            asm volatile("s_waitcnt vmcnt(0)" ::: "memory");
        }
    }
    __syncthreads();
}

#ifndef PH_MASK
#define PH_MASK 0xFFF
#endif
#define PH_ON(k) (((PH_MASK) >> (k)) & 1)
struct Args { const float* in[19]; float* out; unsigned char* ws; int ph_lo, ph_hi; };

__device__ __forceinline__ float wave_sum(float v) {
#pragma unroll
    for (int o = 1; o < 64; o <<= 1) v += __shfl_xor(v, o);
    return v;
}
__device__ __forceinline__ int map_row(int mode, int n) {
    switch (mode) {
        case 1: return (n >> 7) * 256 + (n & 127);
        case 2: return (n >> 7) * 256 + 128 + (n & 127);
        case 3: { if (n < 512) return 512 + n; const int j = n - 512; return 1024 + 2 * (j & 31) + (j >> 5); }
        case 4: { const int h = n / 192, d = n % 192; if (d < 128) return h * 128 + d; const int j = d - 128; return 2048 + h * 64 + 2 * (j & 31) + (j >> 5); }
        case 5: { const int h = n >> 8, d = n & 255; return d < 128 ? h * 128 + d : 2048 + h * 128 + (d - 128); }
        default: return n;
    }
}
__device__ __forceinline__ void transpose_item(const float* W, int K, int N, bf16_t* WT, int mode, const float* ks, const float* cs, LAS float* scr, int item, int lane) {
    const int nblk = N / 64, kb = item / nblk, nb = item % nblk, k0 = 64 * kb, n0 = 64 * nb;
    const int lr = lane >> 4, lc = (lane & 15) * 4;
    f32x4 v[16];
#pragma unroll
    for (int i = 0; i < 16; ++i) v[i] = *(const f32x4*)(W + (size_t)(k0 + 4 * i + lr) * N + n0 + lc);
#pragma unroll
    for (int i = 0; i < 16; ++i) { const int kk = 4 * i + lr; f32x4 t = v[i]; if (ks) t = t * ks[k0 + kk]; LAS float* d = scr + kk * 65 + lc; d[0] = t[0]; d[1] = t[1]; d[2] = t[2]; d[3] = t[3]; }
    asm volatile("s_waitcnt lgkmcnt(0)" ::: "memory");
    const int c = lane & 7;
#pragma unroll
    for (int j = 0; j < 8; ++j) { const int n = (lane >> 3) + 8 * j; const LAS float* s = scr + (8 * c) * 65 + n; const float csn = cs ? cs[n0 + n] : 1.f;
        u32x4 o; o.x = cvt_pk_bf16(s[0 * 65] * csn, s[1 * 65] * csn); o.y = cvt_pk_bf16(s[2 * 65] * csn, s[3 * 65] * csn); o.z = cvt_pk_bf16(s[4 * 65] * csn, s[5 * 65] * csn); o.w = cvt_pk_bf16(s[6 * 65] * csn, s[7 * 65] * csn);
        *(u32x4*)(WT + (size_t)map_row(mode, n0 + n) * K + k0 + 8 * c) = o; }
    asm volatile("s_waitcnt lgkmcnt(0)" ::: "memory");
}

__global__ void __launch_bounds__(512, 2) yoco_fwd(Args a) {
    extern __shared__ __attribute__((aligned(16))) unsigned char lds[];
    cg::grid_group grid = cg::this_grid();
    const int tid = threadIdx.x, lane = tid & 63, wave = __builtin_amdgcn_readfirstlane(tid >> 6);
    const int G = gridDim.x, bx = blockIdx.x, vcu = (G % 8 == 0) ? (bx % 8) * (G / 8) + bx / 8 : bx;
    const int gw = vcu * 8 + wave, NGW = G * 8;
    unsigned char* ws = a.ws;
    const float* x = a.in[0]; const int* positions = (const int*)a.in[1];
    float* out = a.out;
    float* rstd0 = (float*)(ws + WS_RSTD0); float* ssq = (float*)(ws + WS_SSQ); float* sskv = (float*)(ws + WS_SSKV); float* ss = (float*)(ws + WS_SS); float* cs = (float*)(ws + WS_CS);
    bf16_t* Wpool = (bf16_t*)(ws + WS_WPOOL); bf16_t* Wa = (bf16_t*)(ws + WS_WA); bf16_t* Wqb = (bf16_t*)(ws + WS_WQB); bf16_t* Wkvb = (bf16_t*)(ws + WS_WKVB); bf16_t* Wo = (bf16_t*)(ws + WS_WO);
    bf16_t* B0 = (bf16_t*)(ws + WS_B0); bf16_t* B1 = (bf16_t*)(ws + WS_B1); bf16_t* QA = (bf16_t*)(ws + WS_QA); bf16_t* KVA = (bf16_t*)(ws + WS_KVA);
    bf16_t* Qb = (bf16_t*)(ws + WS_Q); bf16_t* Kb = (bf16_t*)(ws + WS_K); bf16_t* Vb = (bf16_t*)(ws + WS_V); bf16_t* MID = (bf16_t*)(ws + WS_MID);
    LAS unsigned char* ldsl = (LAS unsigned char*)lds;
    const int lo = a.ph_lo, hi = a.ph_hi;
    volatile LAS unsigned* bst = (volatile LAS unsigned*)(ldsl + LDS_BYTES - 64);
    if (tid == 0) { bst[0] = 0u; bst[1] = 0u; }
    __syncthreads();
    XcdBarrier xbar = xcd_barrier_post((unsigned*)(ws + WS_BAR), bst);
#define IN(k) (lo <= (k) && (k) < hi)
#define SEAM(k) do { if (IN(k) && IN((k) + 1)) { if ((k) == 0) grid.sync(); else xcd_barrier(xbar); } } while (0)

    if (PH_ON(0) && IN(0)) {
        LAS float* scr = (LAS float*)(ldsl + wave * 16640);
        constexpr int I_POOL = 8 * 8, I_GU = 32 * 88, I_DN = 88 * 32, I_QA = 32 * 8, I_KVA = 32 * 9, I_QB = 8 * 48, I_KVB = 8 * 64, I_WO = 32 * 32;
        constexpr int NITEMS = 4 * I_POOL + 2 * (2 * I_GU + I_DN) + I_QA + I_KVA + I_QB + I_KVB + I_WO;
        for (int it = gw; it < NITEMS; it += NGW) {
            int r = it;
#define JOB(cnt, W_, K_, N_, dst_, mode_, ks_, cs_) if (r < (cnt)) { transpose_item(W_, K_, N_, dst_, mode_, ks_, cs_, scr, r, lane); continue; } r -= (cnt);
            JOB(I_POOL, a.in[3] + 0 * 262144, 512, 512, Wpool + 0 * 262144, 0, a.in[2] + 0, a.in[4] + 0)
            JOB(I_POOL, a.in[3] + 1 * 262144, 512, 512, Wpool + 1 * 262144, 0, a.in[2] + 512, a.in[4] + 512)
            JOB(I_POOL, a.in[3] + 2 * 262144, 512, 512, Wpool + 2 * 262144, 0, a.in[2] + 1024, a.in[4] + 1024)
            JOB(I_POOL, a.in[3] + 3 * 262144, 512, 512, Wpool + 3 * 262144, 0, a.in[2] + 1536, a.in[4] + 1536)
            JOB(I_GU, a.in[15], DM, DFF, (bf16_t*)(ws + WS_WGU0), 1, a.in[14], nullptr)
            JOB(I_GU, a.in[16], DM, DFF, (bf16_t*)(ws + WS_WGU0), 2, a.in[14], nullptr)
            JOB(I_DN, a.in[17], DFF, DM, (bf16_t*)(ws + WS_WDN0), 0, nullptr, nullptr)
            JOB(I_GU, a.in[15] + (size_t)DM * DFF, DM, DFF, (bf16_t*)(ws + WS_WGU1), 1, a.in[14] + DM, nullptr)
            JOB(I_GU, a.in[16] + (size_t)DM * DFF, DM, DFF, (bf16_t*)(ws + WS_WGU1), 2, a.in[14] + DM, nullptr)
            JOB(I_DN, a.in[17] + (size_t)DM * DFF, DFF, DM, (bf16_t*)(ws + WS_WDN1), 0, nullptr, nullptr)
            JOB(I_QA, a.in[10], DM, 512, Wa, 0, a.in[9], nullptr)
            JOB(I_KVA, a.in[6], DM, 576, Wa, 3, a.in[5], nullptr)
            JOB(I_QB, a.in[12], 512, 3072, Wqb, 4, a.in[11], nullptr)
            JOB(I_KVB, a.in[8], 512, 4096, Wkvb, 5, a.in[7], nullptr)
            JOB(I_WO, a.in[13], DM, DM, Wo, 0, nullptr, nullptr)
#undef JOB
        }
        for (int m = gw; m < T; m += NGW) {
            const f32x4* xr = (const f32x4*)(x + (size_t)m * DM) + lane; float s = 0.f;
#pragma unroll
            for (int j = 0; j < 8; ++j) s += sq4(xr[64 * j]);
            s = wave_sum(s);
            if (lane == 0) rstd0[m] = __builtin_amdgcn_rsqf(s * (1.f / DM) + EPS);
            if (lane < 32) {
                const float invf = (float)exp2(-(double)lane * (13.287712379549449 / 32.0));
                const float ang = (float)positions[m] * invf;
                double rev = (double)ang * 0.15915494309189535; rev -= rint(rev);
                const float rf = (float)rev;
                *(f32x2*)(cs + ((size_t)m * 32 + lane) * 2) = (f32x2){__builtin_amdgcn_cosf(rf), __builtin_amdgcn_sinf(rf)};
            }
        }
    }
    SEAM(0);
    if (PH_ON(1) && IN(1)) {
        for (int item = gw; item < (T / 64) * 8; item += NGW) {
            const int slab = item & 7, chunk = item >> 3, t0 = chunk * 64, c0 = slab * 256 + lane * 4, w = 2 << (slab >> 1), tin0 = t0 & (SEQ - 1);
            const float* xc = x + c0; f32x4 s = {0.f, 0.f, 0.f, 0.f};
            for (int j = 1; j < w; ++j) if (tin0 - j >= 0) s += *(const f32x4*)(xc + (size_t)(t0 - j) * DM) * rstd0[t0 - j];
#pragma unroll 4
            for (int i = 0; i < 64; ++i) { const int t = t0 + i, tin = tin0 + i;
                const f32x4 h = *(const f32x4*)(xc + (size_t)t * DM) * rstd0[t]; s += h;
                const int cnt = tin + 1 < w ? tin + 1 : w; const f32x4 d = s * (1.f / (float)cnt) - h;
                u32x2 o; o.x = cvt_pk_bf16(d[0], d[1]); o.y = cvt_pk_bf16(d[2], d[3]); *(u32x2*)(B0 + (size_t)t * DM + c0) = o;
                if (tin - w + 1 >= 0) s -= *(const f32x4*)(xc + (size_t)(t - w + 1) * DM) * rstd0[t - w + 1]; }
        }
    }
    SEAM(1);
    if (PH_ON(2) && IN(2)) {
        pg8::Gemm g{B0, Wpool, DM, 512, 512, 512, 262144}; pg8::Order S; S.init(T, 512, 4, G, bx);
        pg8::EpiResid E{x, nullptr, B1, ss, 512};
        pg8::gemm_phase(ldsl, g, S, E);
    }
    SEAM(2);
    if (PH_ON(3) && IN(3)) {
        pg8::Gemm g{B1, (const bf16_t*)(ws + WS_WGU0), DM, DM, DM, 0, 0}; pg8::Order S; S.init(T, 2 * DFF, 1, G, bx);
        pg8::EpiSwiGLU E{MID, ss};
#ifndef REP3
#define REP3 1
#endif
        for (int rep3 = 0; rep3 < REP3; ++rep3) pg8::gemm_phase(ldsl, g, S, E);
    }
    SEAM(3);
    if (PH_ON(4) && IN(4)) {
        pg8::Gemm g{MID, (const bf16_t*)(ws + WS_WDN0), DFF, DFF, DFF, 0, 0}; pg8::Order S; S.init(T, DM, 1, G, bx);
        pg8::EpiResid E{nullptr, B1, B0, ss, 0};
        pg8::gemm_phase(ldsl, g, S, E);
    }
    SEAM(4);
    if (PH_ON(5) && IN(5)) {
        pg8::Gemm g{B0, Wa, DM, DM, DM, 0, 0}; pg8::Order S; S.init(T, 1280, 1, G, bx);
        pg8::EpiA E{ss, QA, KVA, ssq, sskv, Kb, cs};
        pg8::gemm_phase(ldsl, g, S, E);
    }
    SEAM(5);
    if (PH_ON(6) && IN(6)) {
        { pg8::Gemm g{QA, Wqb, 512, 512, 512, 0, 0}; pg8::Order S; S.init(T, 3072, 1, G, bx);
          pg8::EpiQ E{ssq, Qb, cs}; pg8::gemm_phase(ldsl, g, S, E); }
        { pg8::Gemm g{KVA, Wkvb, 512, 512, 512, 0, 0}; pg8::Order S; S.init(T, 4096, 1, G, bx);
          pg8::EpiKV E{sskv, Kb, Vb}; pg8::gemm_phase(ldsl, g, S, E); }
    }
    SEAM(6);
    if (PH_ON(7) && IN(7)) {
#ifndef REP7
#define REP7 1
#endif
        for (int rep7 = 0; rep7 < REP7; ++rep7)
        for (int sid = vcu; sid < 256; sid += G) att::attn_stream(Qb, Kb, Vb, B1, sid, (char*)lds);
    }
    SEAM(7);
    if (PH_ON(8) && IN(8)) {
        pg8::Gemm g{B1, Wo, DM, DM, DM, 0, 0}; pg8::Order S; S.init(T, DM, 1, G, bx);
        pg8::EpiResid E{nullptr, B0, B0, ss, 0};
        pg8::gemm_phase(ldsl, g, S, E);
    }
    SEAM(8);
    if (PH_ON(9) && IN(9)) {
        pg8::Gemm g{B0, (const bf16_t*)(ws + WS_WGU1), DM, DM, DM, 0, 0}; pg8::Order S; S.init(T, 2 * DFF, 1, G, bx);
        pg8::EpiSwiGLU E{MID, ss};
        pg8::gemm_phase(ldsl, g, S, E);
    }
    SEAM(9);
    if (PH_ON(10) && IN(10)) {
        pg8::Gemm g{MID, (const bf16_t*)(ws + WS_WDN1), DFF, DFF, DFF, 0, 0}; pg8::Order S; S.init(T, DM, 1, G, bx);
        pg8::EpiResid E{nullptr, B0, B0, ss, 0};
        pg8::gemm_phase(ldsl, g, S, E);
    }
    SEAM(10);
    if (PH_ON(11) && IN(11)) {
        const float* fg = a.in[18];
        for (int m = gw; m < T; m += NGW) {
            float s = lane < 32 ? ss[(size_t)m * 32 + lane] : 0.f; s = wave_sum(s);
            const float r = __builtin_amdgcn_rsqf(s * (1.f / DM) + EPS);
            const u32x4* xr = (const u32x4*)(B0 + (size_t)m * DM) + lane; f32x4* orow = (f32x4*)(out + (size_t)m * DM) + 2 * lane; const f32x4* gr = (const f32x4*)fg + 2 * lane;
#pragma unroll
            for (int j = 0; j < 4; ++j) { const u32x4 w = xr[64 * j];
                const f32x4 v0 = {__uint_as_float(w.x << 16), __uint_as_float(w.x & 0xffff0000u), __uint_as_float(w.y << 16), __uint_as_float(w.y & 0xffff0000u)};
                const f32x4 v1 = {__uint_as_float(w.z << 16), __uint_as_float(w.z & 0xffff0000u), __uint_as_float(w.w << 16), __uint_as_float(w.w & 0xffff0000u)};
                orow[128 * j] = v0 * r * gr[128 * j]; orow[128 * j + 1] = v1 * r * gr[128 * j + 1]; }
        }
    }
#undef IN
#undef SEAM
}

extern "C" void kernel_launch(void* const* d_in, const int* in_sizes, int n_in, void* d_out, int out_size, void* d_ws, size_t ws_size, hipStream_t stream) {
    static int grid = 0;
    if (grid == 0) {
        if (n_in != 19 || in_sizes[0] != T * DM || out_size != T * DM || ws_size < WS_END) { fprintf(stderr, "kernel_launch: shape/workspace mismatch (n_in %d, in0 %d, out %d, ws %zu < %zu)\n", n_in, n_in > 0 ? in_sizes[0] : -1, out_size, ws_size, (size_t)WS_END); grid = -1; return; }
        int dev = 0, cus = 0, per_cu = 0;
        (void)hipGetDevice(&dev); (void)hipDeviceGetAttribute(&cus, hipDeviceAttributeMultiprocessorCount, dev);
        if (hipFuncSetAttribute((const void*)yoco_fwd, hipFuncAttributeMaxDynamicSharedMemorySize, LDS_BYTES) != hipSuccess) { fprintf(stderr, "kernel_launch: hipFuncSetAttribute failed\n"); grid = -1; return; }
        if (hipOccupancyMaxActiveBlocksPerMultiprocessor(&per_cu, (const void*)yoco_fwd, 512, LDS_BYTES) != hipSuccess || per_cu < 1) { fprintf(stderr, "kernel_launch: occupancy query says %d\n", per_cu); per_cu = 1; }
        (void)hipGetLastError();
        grid = cus * per_cu;
        if (grid <= 0) grid = 256;
    }
    if (grid < 0) return;
    if (hipMemsetAsync((char*)d_ws + WS_BAR, 0, XCD_BAR_WORDS * 4, stream) != hipSuccess) { fprintf(stderr, "kernel_launch: memset of the barrier words failed\n"); return; }
    Args a{};
    for (int i = 0; i < 19; ++i) a.in[i] = (const float*)d_in[i];
    a.out = (float*)d_out; a.ws = (unsigned char*)d_ws; a.ph_lo = 0; a.ph_hi = 12;
    void* args[] = {&a};
    hipError_t e = hipLaunchCooperativeKernel((const void*)yoco_fwd, dim3(grid), dim3(512), args, LDS_BYTES, stream);
    if (e != hipSuccess) fprintf(stderr, "cooperative launch failed: %s (grid %d)\n", hipGetErrorString(e), grid);
}
```

```cpp
#include <hip/hip_runtime.h>
#include <hip/hip_cooperative_groups.h>
#include <cstdio>
#include <cstdint>
namespace cg = cooperative_groups;

#define LAS __attribute__((address_space(3)))
typedef unsigned short bf16_t;
typedef short bf16x8 __attribute__((ext_vector_type(8)));
typedef short s16x4 __attribute__((ext_vector_type(4)));
typedef float f32x2 __attribute__((ext_vector_type(2)));
typedef float f32x4 __attribute__((ext_vector_type(4)));
typedef float f32x16 __attribute__((ext_vector_type(16)));
typedef unsigned u32x2 __attribute__((ext_vector_type(2)));
typedef unsigned u32x4 __attribute__((ext_vector_type(4)));

constexpr int DM = 2048, NB = 4, SEQ = 8192, T = NB * SEQ, DFF = 5632, NH = 16;
constexpr float EPS = 1e-6f;
constexpr float C2Q = 0.07216878364870322f * 1.4426950408889634f;

__device__ __forceinline__ unsigned cvt_pk_bf16(float lo, float hi) { unsigned r; asm volatile("v_cvt_pk_bf16_f32 %0, %1, %2" : "=v"(r) : "v"(lo), "v"(hi)); return r; }
__device__ __forceinline__ u32x4 pack8(f32x4 a, f32x4 b) { u32x4 w; w.x = cvt_pk_bf16(a[0], a[1]); w.y = cvt_pk_bf16(a[2], a[3]); w.z = cvt_pk_bf16(b[0], b[1]); w.w = cvt_pk_bf16(b[2], b[3]); return w; }
__device__ __forceinline__ float sq4(f32x4 v) { return (v[0] * v[0] + v[1] * v[1]) + (v[2] * v[2] + v[3] * v[3]); }

namespace pg8 {
constexpr int BM = 256, BK = 64, HALF = 128, HTB = HALF * BK * 2, STAGE_BYTES = 8 * HTB, NXCD = 8, WGM = 8;
__host__ __device__ __forceinline__ int lds_byte(int r, int c) { const int st = (r >> 4) * 2 + (c >> 5), rr = r & 15, cc = c & 31, ob = rr * 64 + cc * 2; return st * 1024 + (ob ^ (((ob >> 9) & 1) << 5)); }
__host__ __device__ __forceinline__ void stage_rc(int b, int& R, int& C) { const int st = b / 1024, sb = b % 1024, swz = sb ^ (((sb >> 9) & 1) << 5); R = (st >> 1) * 16 + swz / 64; C = (st & 1) * 32 + (swz % 64) / 2; }
__host__ __device__ __forceinline__ int perm32(int rho) { const int n = rho >> 4, i = rho & 15; return 8 * (i >> 2) + 4 * n + (i & 3); }

struct Unit { int pm, pn, grp; };
struct Gemm { const bf16_t* A; const bf16_t* Bt; int lda, ldb, K; long grpA, grpB; };

struct Order {
    int nM, nN, nwg, nG, G, c;
    __device__ void init(int M, int N, int nG_, int G_, int c_) { nM = M / BM; nN = N / BM; nwg = nM * nN; nG = nG_; G = G_; c = c_; }
    __device__ bool next(int i, Unit& u) const {
        const long L = (long)i * G + c; if (L >= (long)nwg * nG) return false;
        u.grp = (int)(L / nwg); int wgid = (int)(L % nwg);
        { const int q = nwg / NXCD, r = nwg % NXCD, xcd = wgid % NXCD, off = wgid / NXCD; wgid = (xcd < r ? xcd * (q + 1) : r * (q + 1) + (xcd - r) * q) + off; }
        const int nig = WGM * nN, gid = wgid / nig, fm = gid * WGM, gsz = (nM - fm) < WGM ? (nM - fm) : WGM;
        u.pm = fm + ((wgid % nig) % gsz); u.pn = (wgid % nig) / gsz; return true;
    }
};

template <class Epi>
__device__ __forceinline__ void gemm_phase(LAS unsigned char* lds, const Gemm g, const Order& S, const Epi& E) {
    const int tid = threadIdx.x, wid = __builtin_amdgcn_readfirstlane(tid >> 6), lane = tid & 63, wr = wid >> 2, wc = wid & 3, fr = lane & 15, fq = lane >> 4;
    const int K = g.K, nt = K / BK;
    unsigned voffA[2], voffB[2];
#pragma unroll
    for (int i = 0; i < 2; ++i) { int R, C; stage_rc(tid * 16 + i * 8192, R, C); const int Rb = (R & ~31) + perm32(R & 31);
        voffA[i] = (unsigned)(R * g.lda + C) * 2u; voffB[i] = (unsigned)(Rb * g.ldb + C) * 2u; }
    const size_t kstep = (size_t)(BK * 2);
    const size_t hstepA = (size_t)HALF * g.lda * 2, hstepB = (size_t)HALF * g.ldb * 2;
    const size_t tstepA = 2 * hstepA, tstepB = 2 * hstepB;
    const unsigned ldsw = (unsigned)wid * 1024u;
    const int aoff = lds_byte(wr * 64 + fr, fq * 8), boff = lds_byte(wc * 32 + fr, fq * 8);
#define PG8_SA(b, h) (((b) * 2 + (h)) * HTB)
#define PG8_SB(b, h) ((4 + (b) * 2 + (h)) * HTB)
#define PG8_STAGE(bufoff, gbase, voff) do { _Pragma("unroll") for (int _i = 0; _i < 2; ++_i) \
        __builtin_amdgcn_global_load_lds((const unsigned*)((const char*)(gbase) + (voff)[_i]), (LAS unsigned*)(lds + (bufoff) + ldsw + _i * 8192), 16, 0, 0); } while (0)
#define PG8_LDA(dst, b, h) do { _Pragma("unroll") for (int m = 0; m < 4; ++m) _Pragma("unroll") for (int k = 0; k < 2; ++k) dst[m][k] = *(const LAS bf16x8*)(lds + PG8_SA(b, h) + aoff + m * 2048 + k * 1024); } while (0)
#define PG8_LDB(dst, b, h) do { _Pragma("unroll") for (int n = 0; n < 2; ++n) _Pragma("unroll") for (int k = 0; k < 2; ++k) dst[n][k] = *(const LAS bf16x8*)(lds + PG8_SB(b, h) + boff + n * 2048 + k * 1024); } while (0)
#define PG8_MMA(ai, bj, At, Bt) do { __builtin_amdgcn_s_setprio(1); _Pragma("unroll") for (int m = 0; m < 4; ++m) _Pragma("unroll") for (int n = 0; n < 2; ++n) _Pragma("unroll") for (int k = 0; k < 2; ++k) \
        acc[ai][bj][m][n] = __builtin_amdgcn_mfma_f32_16x16x32_bf16(Bt[n][k], At[m][k], acc[ai][bj][m][n], 0, 0, 0); __builtin_amdgcn_s_setprio(0); } while (0)
#define PG8_WAIT_V(n) asm volatile("s_waitcnt vmcnt(" #n ")" ::: "memory")
#define PG8_WAIT_L(n) asm volatile("s_waitcnt lgkmcnt(" #n ")" ::: "memory")
#define PG8_BAR __builtin_amdgcn_s_barrier()
#define PG8_SCHED __builtin_amdgcn_sched_barrier(0)
    Unit cur, nxt; int ui = 0;
    if (!S.next(0, cur)) return;
    f32x4 acc[2][2][4][2];
#pragma unroll
    for (int a = 0; a < 2; ++a)
#pragma unroll
        for (int b = 0; b < 2; ++b)
#pragma unroll
            for (int m = 0; m < 4; ++m)
#pragma unroll
                for (int n = 0; n < 2; ++n) acc[a][b][m][n] = (f32x4){0.f, 0.f, 0.f, 0.f};
    bf16x8 At[4][2], B0[2][2], B1[2][2];
    const char* cA = (const char*)(g.A + (size_t)cur.grp * g.grpA) + (size_t)cur.pm * tstepA;
    const char* cB = (const char*)(g.Bt + (size_t)cur.grp * g.grpB) + (size_t)cur.pn * tstepB;
    PG8_STAGE(PG8_SB(0, 0), cB, voffB); PG8_STAGE(PG8_SB(0, 1), cB + hstepB, voffB); PG8_STAGE(PG8_SA(0, 0), cA, voffA); PG8_STAGE(PG8_SA(0, 1), cA + hstepA, voffA);
    if (wr == 1) PG8_BAR;
    PG8_WAIT_V(2); PG8_BAR;
    PG8_STAGE(PG8_SB(1, 0), cB + kstep, voffB); PG8_STAGE(PG8_SA(1, 0), cA + kstep, voffA); PG8_STAGE(PG8_SB(1, 1), cB + hstepB + kstep, voffB);
    PG8_WAIT_V(6); PG8_BAR;
    for (;;) {
        const bool has_next = S.next(ui + 1, nxt);
        const char* nA = has_next ? (const char*)(g.A + (size_t)nxt.grp * g.grpA) + (size_t)nxt.pm * tstepA : cA;
        const char* nB = has_next ? (const char*)(g.Bt + (size_t)nxt.grp * g.grpB) + (size_t)nxt.pn * tstepB : cB;
        for (int t = 0; t < nt; t += 2) {
            const bool last = (t == nt - 2);
            const char* a1 = cA + (size_t)(t + 1) * kstep;
            const char* a2 = last ? nA : cA + (size_t)(t + 2) * kstep; const char* b2 = last ? nB : cB + (size_t)(t + 2) * kstep;
            const char* a3 = a2 + kstep; const char* b3 = b2 + kstep;
            PG8_LDB(B0, 0, 0); PG8_LDB(B1, 0, 1); PG8_SCHED; PG8_LDA(At, 0, 0); PG8_STAGE(PG8_SA(1, 1), a1 + hstepA, voffA);
            PG8_WAIT_V(8); PG8_WAIT_L(0); PG8_BAR; PG8_MMA(0, 0, At, B0); PG8_MMA(0, 1, At, B1); PG8_BAR; PG8_SCHED;
            PG8_LDA(At, 0, 1); PG8_STAGE(PG8_SB(0, 0), b2, voffB); PG8_STAGE(PG8_SB(0, 1), b2 + hstepB, voffB); PG8_STAGE(PG8_SA(0, 0), a2, voffA);
            PG8_WAIT_V(8); PG8_WAIT_L(0); PG8_BAR; PG8_MMA(1, 0, At, B0); PG8_MMA(1, 1, At, B1); PG8_BAR; PG8_SCHED;
            PG8_LDB(B0, 1, 0); PG8_LDB(B1, 1, 1); PG8_SCHED; PG8_LDA(At, 1, 0); PG8_STAGE(PG8_SA(0, 1), a2 + hstepA, voffA);
            PG8_WAIT_V(8); PG8_WAIT_L(0); PG8_BAR; PG8_MMA(0, 0, At, B0); PG8_MMA(0, 1, At, B1); PG8_BAR; PG8_SCHED;
            PG8_LDA(At, 1, 1); PG8_STAGE(PG8_SB(1, 0), b3, voffB); PG8_STAGE(PG8_SB(1, 1), b3 + hstepB, voffB); PG8_STAGE(PG8_SA(1, 0), a3, voffA);
            PG8_WAIT_V(8); PG8_WAIT_L(0); PG8_BAR; PG8_MMA(1, 0, At, B0); PG8_MMA(1, 1, At, B1); PG8_BAR; PG8_SCHED;
        }
        if (wr == 0) PG8_BAR;
        E(acc, cur, wr, wc, fr, fq);
        if (!has_next) break;
#pragma unroll
        for (int a = 0; a < 2; ++a)
#pragma unroll
            for (int b = 0; b < 2; ++b)
#pragma unroll
                for (int m = 0; m < 4; ++m)
#pragma unroll
                    for (int n = 0; n < 2; ++n) acc[a][b][m][n] = (f32x4){0.f, 0.f, 0.f, 0.f};
        cur = nxt; cA = nA; cB = nB; ++ui;
        if (wr == 1) PG8_BAR;
    }
    PG8_WAIT_V(0);
    PG8_BAR;
#undef PG8_SA
#undef PG8_SB
#undef PG8_STAGE
#undef PG8_LDA
#undef PG8_LDB
#undef PG8_MMA
#undef PG8_WAIT_V
#undef PG8_WAIT_L
#undef PG8_BAR
#undef PG8_SCHED
}

template <int NP> __device__ __forceinline__ float row_rstd(const float* ss, int row, int fq, float invn) {
    const float* p = ss + (size_t)row * NP + fq * (NP / 4); float s;
    if constexpr (NP == 32) { const f32x4 a = *(const f32x4*)p, b = *(const f32x4*)(p + 4); s = ((a[0] + a[1]) + (a[2] + a[3])) + ((b[0] + b[1]) + (b[2] + b[3])); }
    else { const f32x2 a = *(const f32x2*)p; s = a[0] + a[1]; }
    s += __shfl_xor(s, 16); s += __shfl_xor(s, 32);
    return __builtin_amdgcn_rsqf(s * invn + EPS);
}
__device__ __forceinline__ float rowsum4(float q) { q += __shfl_xor(q, 16); q += __shfl_xor(q, 32); return q; }

struct EpiResid {
    const float* basf; const bf16_t* basb; bf16_t* xb; float* ss; int colgrp;
    __device__ __forceinline__ void operator()(const f32x4 (&acc)[2][2][4][2], const Unit& u, int wr, int wc, int fr, int fq) const {
        const int row0 = u.pm * BM + wr * 64 + fr, colb = u.grp * colgrp + u.pn * BM, col0 = colb + wc * 32 + 8 * fq, pidx = (colb >> 6) + wc;
        f32x4 pre[3][4];
#define RB_LOAD(it, P) do { const size_t off_ = (size_t)(row0 + ((it) >> 2) * HALF + ((it) & 3) * 16) * DM + col0; \
        if (basf) { P[0] = *(const f32x4*)(basf + off_); P[1] = *(const f32x4*)(basf + off_ + 4); P[2] = *(const f32x4*)(basf + off_ + HALF); P[3] = *(const f32x4*)(basf + off_ + HALF + 4); } \
        else { const u32x4 w0_ = *(const u32x4*)(basb + off_), w1_ = *(const u32x4*)(basb + off_ + HALF); \
               P[0] = (f32x4){__uint_as_float(w0_.x << 16), __uint_as_float(w0_.x & 0xffff0000u), __uint_as_float(w0_.y << 16), __uint_as_float(w0_.y & 0xffff0000u)}; \
               P[1] = (f32x4){__uint_as_float(w0_.z << 16), __uint_as_float(w0_.z & 0xffff0000u), __uint_as_float(w0_.w << 16), __uint_as_float(w0_.w & 0xffff0000u)}; \
               P[2] = (f32x4){__uint_as_float(w1_.x << 16), __uint_as_float(w1_.x & 0xffff0000u), __uint_as_float(w1_.y << 16), __uint_as_float(w1_.y & 0xffff0000u)}; \
               P[3] = (f32x4){__uint_as_float(w1_.z << 16), __uint_as_float(w1_.z & 0xffff0000u), __uint_as_float(w1_.w << 16), __uint_as_float(w1_.w & 0xffff0000u)}; } } while (0)
        RB_LOAD(0, pre[0]); RB_LOAD(1, pre[1]);
#pragma unroll
        for (int it = 0; it < 8; ++it) { const int ai = it >> 2, m = it & 3, row = row0 + ai * HALF + m * 16; const size_t off = (size_t)row * DM + col0; float q = 0.f;
            if (it + 2 < 8) RB_LOAD(it + 2, pre[(it + 2) % 3]);
#pragma unroll
            for (int bj = 0; bj < 2; ++bj) {
                const f32x4 v0 = acc[ai][bj][m][0] + pre[it % 3][2 * bj], v1 = acc[ai][bj][m][1] + pre[it % 3][2 * bj + 1];
                *(u32x4*)(xb + off + bj * HALF) = pack8(v0, v1);
                q += sq4(v0) + sq4(v1); }
            q = rowsum4(q); if (fq == 0) ss[(size_t)row * 32 + pidx] = q; }
#undef RB_LOAD
    }
};
struct EpiSwiGLU {
    bf16_t* mid; const float* ss;
    __device__ __forceinline__ void operator()(const f32x4 (&acc)[2][2][4][2], const Unit& u, int wr, int wc, int fr, int fq) const {
        const int row0 = u.pm * BM + wr * 64 + fr, col0 = u.pn * HALF + wc * 32 + 8 * fq;
#pragma unroll
        for (int ai = 0; ai < 2; ++ai)
#pragma unroll
            for (int m = 0; m < 4; ++m) { const int row = row0 + ai * HALF + m * 16; const float s = row_rstd<32>(ss, row, fq, 1.f / DM);
                const float sneg = -1.4426950408889634f * s, s2 = s * s; unsigned w[4];
#pragma unroll
                for (int n = 0; n < 2; ++n)
#pragma unroll
                    for (int e = 0; e < 2; ++e) { const f32x2 gg = {acc[ai][0][m][n][2 * e], acc[ai][0][m][n][2 * e + 1]}, uu = {acc[ai][1][m][n][2 * e], acc[ai][1][m][n][2 * e + 1]};
                        const f32x2 t = gg * sneg; f32x2 d; d.x = __builtin_amdgcn_exp2f(t.x); d.y = __builtin_amdgcn_exp2f(t.y); d = d + 1.0f;
                        f32x2 r; r.x = __builtin_amdgcn_rcpf(d.x); r.y = __builtin_amdgcn_rcpf(d.y);
                        const f32x2 h = (gg * uu) * (r * s2); w[2 * n + e] = cvt_pk_bf16(h.x, h.y); }
                *(u32x4*)(mid + (size_t)row * DFF + col0) = (u32x4){w[0], w[1], w[2], w[3]}; }
    }
};
__device__ __forceinline__ void rope8(f32x4& v0, f32x4& v1, const float* cs  ) {
    const f32x4 c0 = *(const f32x4*)cs, c1 = *(const f32x4*)(cs + 4);
    const f32x4 a = v0, b = v1;
    v0 = (f32x4){a[0] * c0[0] - a[1] * c0[1], a[1] * c0[0] + a[0] * c0[1], a[2] * c0[2] - a[3] * c0[3], a[3] * c0[2] + a[2] * c0[3]};
    v1 = (f32x4){b[0] * c1[0] - b[1] * c1[1], b[1] * c1[0] + b[0] * c1[1], b[2] * c1[2] - b[3] * c1[3], b[3] * c1[2] + b[2] * c1[3]};
}
struct EpiA {
    const float* ss; bf16_t* qa; bf16_t* kva; float* ssq; float* sskv; bf16_t* Kb; const float* cs;
    __device__ __forceinline__ void operator()(const f32x4 (&acc)[2][2][4][2], const Unit& u, int wr, int wc, int fr, int fq) const {
        const int row0 = u.pm * BM + wr * 64 + fr;
        if (u.pn < 4) {
            bf16_t* dst = u.pn < 2 ? qa : kva; float* sso = u.pn < 2 ? ssq : sskv; const int colb = (u.pn & 1) * BM, col0 = colb + wc * 32 + 8 * fq, pidx = (u.pn & 1) * 4 + wc;
#pragma unroll
            for (int ai = 0; ai < 2; ++ai)
#pragma unroll
                for (int m = 0; m < 4; ++m) { const int row = row0 + ai * HALF + m * 16; const float s = row_rstd<32>(ss, row, fq, 1.f / DM); float q = 0.f;
#pragma unroll
                    for (int bj = 0; bj < 2; ++bj) { const f32x4 v0 = acc[ai][bj][m][0] * s, v1 = acc[ai][bj][m][1] * s;
                        *(u32x4*)(dst + (size_t)row * 512 + col0 + bj * HALF) = pack8(v0, v1); q += sq4(v0) + sq4(v1); }
                    q = rowsum4(q); if (fq == 0) sso[(size_t)row * 8 + pidx] = q; }
        } else {
            const int p0 = wc * 32 + 8 * fq;
#pragma unroll
            for (int ai = 0; ai < 2; ++ai)
#pragma unroll
                for (int m = 0; m < 4; ++m) { const int row = row0 + ai * HALF + m * 16; const float s = row_rstd<32>(ss, row, fq, 1.f / DM);
                    if (wc < 2) { f32x4 v0 = acc[ai][0][m][0] * s, v1 = acc[ai][0][m][1] * s; rope8(v0, v1, cs + ((size_t)row * 32 + (p0 >> 1)) * 2);
                        const u32x4 w = pack8(v0, v1); bf16_t* kp = Kb + (size_t)row * 3072 + 128 + p0;
#pragma unroll
                        for (int h = 0; h < NH; ++h) *(u32x4*)(kp + h * 192) = w; } }
        }
    }
};
struct EpiQ {
    const float* ssq; bf16_t* Q; const float* cs;
    __device__ __forceinline__ void operator()(const f32x4 (&acc)[2][2][4][2], const Unit& u, int wr, int wc, int fr, int fq) const {
        const int row0 = u.pm * BM + wr * 64 + fr;
#pragma unroll
        for (int ai = 0; ai < 2; ++ai)
#pragma unroll
            for (int m = 0; m < 4; ++m) { const int row = row0 + ai * HALF + m * 16; const float s = row_rstd<8>(ssq, row, fq, 1.f / 512.f) * C2Q;
#pragma unroll
                for (int bj = 0; bj < 2; ++bj) { f32x4 v0 = acc[ai][bj][m][0] * s, v1 = acc[ai][bj][m][1] * s;
                    if (u.pn < 8) { *(u32x4*)(Q + (size_t)row * 3072 + (2 * u.pn + bj) * 192 + wc * 32 + 8 * fq) = pack8(v0, v1); }
                    else { const int head = 4 * (u.pn - 8) + 2 * bj + (wc >> 1), p0 = 32 * (wc & 1) + 8 * fq; rope8(v0, v1, cs + ((size_t)row * 32 + (p0 >> 1)) * 2);
                        *(u32x4*)(Q + (size_t)row * 3072 + head * 192 + 128 + p0) = pack8(v0, v1); } } }
    }
};
struct EpiKV {
    const float* sskv; bf16_t* Kb; bf16_t* Vb;
    __device__ __forceinline__ void operator()(const f32x4 (&acc)[2][2][4][2], const Unit& u, int wr, int wc, int fr, int fq) const {
        const int row0 = u.pm * BM + wr * 64 + fr;
#pragma unroll
        for (int ai = 0; ai < 2; ++ai)
#pragma unroll
            for (int m = 0; m < 4; ++m) { const int row = row0 + ai * HALF + m * 16; const float s = row_rstd<8>(sskv, row, fq, 1.f / 512.f);
#pragma unroll
                for (int bj = 0; bj < 2; ++bj) { const f32x4 v0 = acc[ai][bj][m][0] * s, v1 = acc[ai][bj][m][1] * s;
                    bf16_t* d = u.pn < 8 ? Kb + (size_t)row * 3072 + (2 * u.pn + bj) * 192 + wc * 32 + 8 * fq : Vb + (size_t)row * 2048 + (2 * (u.pn - 8) + bj) * 128 + wc * 32 + 8 * fq;
                    *(u32x4*)d = pack8(v0, v1); } }
    }
};
}

namespace att {
constexpr int NW = 8, QBLK = 32, KVBLK = 64, QB = 256;
constexpr int LDQ = 3072, LDK = 3072, LDV = 2048, LDO = 2048;
constexpr int KROWB = 400;
constexpr int SHM_K = KVBLK * KROWB, SHM_V = KVBLK * 128 * 2;
constexpr int NQR = 12;
constexpr int LDS_K0 = 3 * SHM_V, LDS_WS = LDS_K0 + 2 * SHM_K, LDS_QS = LDS_WS + NW * 64 * 4, LDS_TOTAL = LDS_QS + NW * (12 - NQR) * 1024;
constexpr float THR = 8.f;
#define SBAR() __builtin_amdgcn_sched_barrier(0)
__device__ __forceinline__ int v_st(int k, int c) { const int kk = (k & ~0xC) | ((k & 4) << 1) | ((k & 8) >> 1); return ((kk >> 3) * 4 + (c >> 5)) * 512 + ((kk & 7) * 32 + (c & 31)) * 2; }
__device__ __forceinline__ int v_rd_base(int lane) { return ((lane & 3) << 3) | (((lane >> 2) & 3) << 6) | (((lane >> 4) & 1) << 5) | (((lane >> 5) & 1) << 8); }
constexpr int v_rd_off(int d0, int ks, int half) { return d0 * 512 + ks * 4096 + half * 2048; }
__device__ __forceinline__ int crow(int r, int hi) { return (r & 3) + 8 * (r >> 2) + 4 * hi; }
__device__ __forceinline__ bf16x8 ldg8(const bf16_t* base, unsigned off) { return *reinterpret_cast<const bf16x8*>(base + off); }
__device__ __forceinline__ void mask_tile(f32x16& p0, f32x16& p1, int dq) {
    const float NEG = -__builtin_inff();
#pragma unroll
    for (int r = 0; r < 16; ++r) { const int c = (r & 3) + 8 * (r >> 2); if (dq - c < 0) p0[r] = NEG; if (dq - c - 32 < 0) p1[r] = NEG; }
}
__device__ __forceinline__ void qkt(f32x16& p0, f32x16& p1, const char* a, const char* qs, const bf16x8* qr, float negm) {
#pragma unroll
    for (int r = 0; r < 16; ++r) { p0[r] = negm; p1[r] = negm; }
    bf16x8 kA[3], kB[3], qv[3];
#define KL(d) do { kA[(d) % 3] = *reinterpret_cast<const bf16x8*>(a + (d) * 32); kB[(d) % 3] = *reinterpret_cast<const bf16x8*>(a + (d) * 32 + 32 * KROWB); \
        if ((d) >= NQR) qv[(d) % 3] = *reinterpret_cast<const bf16x8*>(qs + ((d) - NQR) * 1024); } while (0)
    KL(0); KL(1);
#pragma unroll
    for (int d0 = 0; d0 < 12; ++d0) {
        if (d0 + 2 < 12) KL(d0 + 2);
        SBAR();
        const bf16x8 q = d0 < NQR ? qr[d0 < NQR ? d0 : 0] : qv[d0 % 3];
        p0 = __builtin_amdgcn_mfma_f32_32x32x16_bf16(kA[d0 % 3], q, p0, 0, 0, 0);
        p1 = __builtin_amdgcn_mfma_f32_32x32x16_bf16(kB[d0 % 3], q, p1, 0, 0, 0);
        SBAR(); }
#undef KL
}
__device__ __forceinline__ void softmax_tile(f32x16& p0, f32x16& p1, float& m_reg, float& l_reg, float& alpha, bf16x8& pa0, bf16x8& pa1, bf16x8& pa2, bf16x8& pa3) {
    float pmax = fmaxf(p0[0], p1[0]);
#pragma unroll
    for (int r = 1; r < 16; ++r) pmax = fmaxf(fmaxf(pmax, p0[r]), p1[r]);
    { auto rr = __builtin_amdgcn_permlane32_swap(__float_as_uint(pmax), __float_as_uint(pmax), false, false); pmax = fmaxf(__uint_as_float(rr[0]), __uint_as_float(rr[1])); }
    alpha = 1.f;
    if (__builtin_expect(!__all(pmax <= THR), 0)) { const float dl = fmaxf(pmax, 0.f); m_reg += dl; alpha = __builtin_amdgcn_exp2f(-dl);
#pragma unroll
        for (int r = 0; r < 16; ++r) { p0[r] -= dl; p1[r] -= dl; } }
#pragma unroll
    for (int r = 0; r < 16; ++r) { p0[r] = __builtin_amdgcn_exp2f(p0[r]); p1[r] = __builtin_amdgcn_exp2f(p1[r]); }
    float ps = 0.f;
#pragma unroll
    for (int r = 0; r < 16; ++r) ps += p0[r] + p1[r];
    { auto rr = __builtin_amdgcn_permlane32_swap(__float_as_uint(ps), __float_as_uint(ps), false, false); ps = __uint_as_float(rr[0]) + __uint_as_float(rr[1]); }
    l_reg = l_reg * alpha + ps;
#define PK4(P, B_, OUT) do { unsigned a0 = cvt_pk_bf16(P[B_+0], P[B_+1]), a1 = cvt_pk_bf16(P[B_+2], P[B_+3]); \
        unsigned b0 = cvt_pk_bf16(P[B_+4], P[B_+5]), b1 = cvt_pk_bf16(P[B_+6], P[B_+7]); \
        auto r0 = __builtin_amdgcn_permlane32_swap(a0, b0, false, false); auto r1 = __builtin_amdgcn_permlane32_swap(a1, b1, false, false); \
        u32x4 w = {r0[0], r1[0], r0[1], r1[1]}; OUT = *reinterpret_cast<bf16x8*>(&w); } while (0)
    PK4(p0, 0, pa0); PK4(p0, 8, pa1); PK4(p1, 0, pa2); PK4(p1, 8, pa3);
#undef PK4
}
__device__ __forceinline__ void pv_tile(f32x16* o, int vb, bf16x8 pa0, bf16x8 pa1, bf16x8 pa2, bf16x8 pa3) {
#define TRRD(dst, off) asm volatile("ds_read_b64_tr_b16 %0, %1 offset:%2" : "=&v"(dst) : "v"(vb), "i"(off) : "memory")
#define TR8(S, d0) do { constexpr int b_ = v_rd_off(d0, 0, 0); TRRD(S##l0, b_); TRRD(S##h0, b_ + 2048); TRRD(S##l1, b_ + 4096); TRRD(S##h1, b_ + 6144); \
        TRRD(S##l2, b_ + 8192); TRRD(S##h2, b_ + 10240); TRRD(S##l3, b_ + 12288); TRRD(S##h3, b_ + 14336); } while (0)
#define MM4(S, d0) do { \
        o[d0] = __builtin_amdgcn_mfma_f32_32x32x16_bf16(pa0, (bf16x8){S##l0[0], S##l0[1], S##l0[2], S##l0[3], S##h0[0], S##h0[1], S##h0[2], S##h0[3]}, o[d0], 0, 0, 0); \
        o[d0] = __builtin_amdgcn_mfma_f32_32x32x16_bf16(pa1, (bf16x8){S##l1[0], S##l1[1], S##l1[2], S##l1[3], S##h1[0], S##h1[1], S##h1[2], S##h1[3]}, o[d0], 0, 0, 0); \
        o[d0] = __builtin_amdgcn_mfma_f32_32x32x16_bf16(pa2, (bf16x8){S##l2[0], S##l2[1], S##l2[2], S##l2[3], S##h2[0], S##h2[1], S##h2[2], S##h2[3]}, o[d0], 0, 0, 0); \
        o[d0] = __builtin_amdgcn_mfma_f32_32x32x16_bf16(pa3, (bf16x8){S##l3[0], S##l3[1], S##l3[2], S##l3[3], S##h3[0], S##h3[1], S##h3[2], S##h3[3]}, o[d0], 0, 0, 0); } while (0)
    s16x4 Al0, Al1, Al2, Al3, Ah0, Ah1, Ah2, Ah3, Bl0, Bl1, Bl2, Bl3, Bh0, Bh1, Bh2, Bh3;
    TR8(A, 0); TR8(B, 1);
    asm volatile("s_waitcnt lgkmcnt(8)" ::: "memory"); SBAR(); MM4(A, 0); SBAR();
    TR8(A, 2);
    asm volatile("s_waitcnt lgkmcnt(8)" ::: "memory"); SBAR(); MM4(B, 1); SBAR();
    TR8(B, 3);
    asm volatile("s_waitcnt lgkmcnt(8)" ::: "memory"); SBAR(); MM4(A, 2); SBAR();
    asm volatile("s_waitcnt lgkmcnt(0)" ::: "memory"); SBAR(); MM4(B, 3);
#undef MM4
#undef TR8
#undef TRRD
}
#define VMW() asm volatile("s_waitcnt vmcnt(0)" ::: "memory")
#define SLOAD(Kp, Vp) do { const bf16_t* vp_ = (Vp); st_v0 = ldg8(vp_, voff); st_v1 = ldg8(vp_ + 32 * LDV, voff); \
        const bf16_t* kp_ = (Kp); st_k0 = ldg8(kp_, koff); st_k1 = ldg8(kp_ + 64, koff); st_k2 = ldg8(kp_ + 128, koff); } while (0)
#define SWRITE(kb_, vb_) do { char* d_ = K_lds + (kb_) * SHM_K + kws; *(bf16x8*)d_ = st_k0; *(bf16x8*)(d_ + 128) = st_k1; *(bf16x8*)(d_ + 256) = st_k2; \
        *(bf16x8*)(V_lds + (vb_) * SHM_V + vst0) = st_v0; *(bf16x8*)(V_lds + (vb_) * SHM_V + vst1) = st_v1; } while (0)
#define BLK_BH(ii) (xcd * 8 + (ii))
#define BLK_QB(ii) (((ii) & 1) ? 31 - j : j)
#define TILEPTR(ii, nn, Kp, Vp) do { const int bh_ = BLK_BH(ii), qb_ = BLK_QB(ii), tl_ = ((ii) & 1) ? 4 * qb_ + 3 - (nn) : (nn); \
        const size_t row_ = (size_t)(bh_ >> 4) * SEQ + (size_t)tl_ * KVBLK; Kp = Kall + row_ * LDK + (bh_ & 15) * 192; Vp = Vall + row_ * LDV + (bh_ & 15) * 128; } while (0)
__device__ __forceinline__ void attn_stream(const bf16_t* Qall, const bf16_t* Kall, const bf16_t* Vall, bf16_t* Oall, int sid, char* lds) {
    const int xcd = sid >> 5, j = sid & 31;
    const int tid = threadIdx.x, wid = __builtin_amdgcn_readfirstlane(tid >> 6), lane = tid & 63, r32 = lane & 31, hi = lane >> 5;
    const int sr = tid >> 4, sc = (tid & 15) * 8, kr = tid >> 3;
    const unsigned voff = (unsigned)(sr * LDV + sc), koff = (unsigned)(kr * LDK + (tid & 7) * 8), qoff = (unsigned)((wid * QBLK + r32) * LDQ + hi * 8);
    const int kws = kr * KROWB + (tid & 7) * 16, vst0 = v_st(sr, sc), vst1 = v_st(32 + sr, sc);
    char* V_lds = lds; char* K_lds = lds + LDS_K0; char* qs = lds + LDS_QS + wid * ((12 - NQR) * 1024) + lane * 16;
    float* ws = (float*)(lds + LDS_WS) + wid * 64; float* li_l = ws, * al_l = ws + 32;
    const char* ka0 = K_lds + r32 * KROWB + hi * 16;
    const int vrb = (int)(uintptr_t)V_lds + v_rd_base(lane);
    const bool grpB = wid >= 4;
    if (wid >= 4) __builtin_amdgcn_s_setprio(1);
    bf16x8 st_v0, st_v1, st_k0, st_k1, st_k2;
    bf16x8 qr[NQR];
    f32x16 o[4], p0, p1; float m_reg, l_reg, al; bf16x8 pa0, pa1, pa2, pa3;
    const bf16_t* kp; const bf16_t* vp;
    { const int bh0 = BLK_BH(0); const bf16_t* Q0 = Qall + ((size_t)(bh0 >> 4) * SEQ + (size_t)BLK_QB(0) * QB) * LDQ + (bh0 & 15) * 192;
#pragma unroll
      for (int d0 = 0; d0 < NQR; ++d0) qr[d0] = ldg8(Q0 + d0 * 16, qoff);
#pragma unroll
      for (int d0 = NQR; d0 < 12; ++d0) *(bf16x8*)(qs + (d0 - NQR) * 1024) = ldg8(Q0 + d0 * 16, qoff);
#pragma unroll
      for (int d0 = 0; d0 < NQR; ++d0) asm volatile("" : "+v"(qr[d0]));
      TILEPTR(0, 0, kp, vp); SLOAD(kp, vp); VMW(); SWRITE(0, 0); }
    __syncthreads();
    if (grpB) { TILEPTR(0, 1, kp, vp); SLOAD(kp, vp); }
    int kb = 0, vb = 0;
    for (int i = 0; i < 8; ++i) {
        const int bh = BLK_BH(i), qb = BLK_QB(i), NT = 4 * qb + 4, qlo = qb * QB + wid * QBLK, qm = qlo + r32 - 4 * hi;
        const bool more = i < 7, desc = i & 1;
        m_reg = 0.f; l_reg = 0.f;
#pragma unroll
        for (int d = 0; d < 4; ++d) o[d] = f32x16{};
#define STEP(ACT) do { \
            const int t = desc ? NT - 1 - n : n; \
            const bool v1 = (n + 1 < NT) || more; bool v2 = true; if (n + 2 >= NT) v2 = more; \
            const int kb1 = kb ^ 1, vb1 = vb == 2 ? 0 : vb + 1; \
            if (!grpB && v1) { if (n + 1 < NT) TILEPTR(i, n + 1, kp, vp); else TILEPTR(i + 1, 0, kp, vp); SLOAD(kp, vp); } \
            if (ACT) { SBAR(); qkt(p0, p1, ka0 + kb * SHM_K, qs, qr, -m_reg); SBAR(); } \
            if (grpB) { if (v1) { VMW(); SWRITE(kb1, vb1); } __syncthreads(); \
                        if (v2) { if (n + 2 < NT) TILEPTR(i, n + 2, kp, vp); else TILEPTR(i + 1, n + 2 - NT, kp, vp); SLOAD(kp, vp); } } \
            if (ACT) { SBAR(); \
                { const int kb_ = t * KVBLK; if (kb_ + KVBLK - 1 > qlo) mask_tile(p0, p1, qm - kb_); } \
                softmax_tile(p0, p1, m_reg, l_reg, al, pa0, pa1, pa2, pa3); \
                if (__any(al < 1.f)) { if (hi == 0) al_l[r32] = al; asm volatile("s_waitcnt lgkmcnt(0)" ::: "memory"); \
                    _Pragma("unroll") for (int d_ = 0; d_ < 4; ++d_) _Pragma("unroll") for (int r = 0; r < 16; ++r) o[d_][r] *= al_l[crow(r, hi)]; } \
                SBAR(); pv_tile(o, vrb + vb * SHM_V, pa0, pa1, pa2, pa3); SBAR(); } \
            if (!grpB) { if (v1) { VMW(); SWRITE(kb1, vb1); } __syncthreads(); } \
            kb = kb1; vb = vb1; } while (0)
        const int NTa = 4 * qb + (wid >> 1) + 1;
        const int n0 = desc ? NT - NTa : 0, n1 = n0 + NTa;
        int n = 0;
        for (; n < n0; ++n) STEP(0);
        for (; n < n1; ++n) STEP(1);
        for (; n < NT; ++n) STEP(0);
#undef STEP
        {
            if (hi == 0) li_l[r32] = l_reg; asm volatile("s_waitcnt lgkmcnt(0)" ::: "memory");
            bf16_t* Ow = Oall + ((size_t)(bh >> 4) * SEQ + (size_t)qb * QB) * LDO + (bh & 15) * 128; unsigned ooff = (unsigned)((wid * QBLK + 4 * hi) * LDO + r32); asm volatile("" : "+v"(ooff));
#pragma unroll
            for (int r = 0; r < 16; ++r) { const int orow = (r & 3) + 8 * (r >> 2); const float rl = __builtin_amdgcn_rcpf(li_l[crow(r, hi)]);
#pragma unroll
                for (int d0 = 0; d0 < 4; ++d0) { const float v = o[d0][r] * rl; const float vn = __shfl_xor(v, 1);
                    if ((r32 & 1) == 0) *(unsigned*)(Ow + orow * LDO + d0 * 32 + ooff) = cvt_pk_bf16(v, vn); } }
            if (more) {
                const int bhn = BLK_BH(i + 1); const bf16_t* Qn = Qall + ((size_t)(bhn >> 4) * SEQ + (size_t)BLK_QB(i + 1) * QB) * LDQ + (bhn & 15) * 192;
#pragma unroll
                for (int d0 = 0; d0 < NQR; ++d0) qr[d0] = ldg8(Qn + d0 * 16, qoff);
#pragma unroll
                for (int d0 = NQR; d0 < 12; ++d0) *(bf16x8*)(qs + (d0 - NQR) * 1024) = ldg8(Qn + d0 * 16, qoff);
#pragma unroll
                for (int d0 = 0; d0 < NQR; ++d0) asm volatile("" : "+v"(qr[d0])); } }
    }
    __builtin_amdgcn_s_setprio(0);
    asm volatile("s_waitcnt vmcnt(0)" ::: "memory"); __syncthreads();
}
#undef BLK_BH
#undef BLK_QB
#undef TILEPTR
#undef VMW
#undef SLOAD
#undef SWRITE
#undef SBAR
}

constexpr size_t MiB = 1u << 20;
constexpr size_t WS_BAR = 7 * MiB, WS_RSTD0 = 0, WS_SSQ = 1 * MiB, WS_SSKV = 2 * MiB, WS_SS = 3 * MiB, WS_CS = 8 * MiB;
constexpr size_t WS_WPOOL = 16 * MiB, WS_WA = 18 * MiB, WS_WQB = 23 * MiB, WS_WKVB = 26 * MiB, WS_WO = 30 * MiB;
constexpr size_t WS_WGU0 = 38 * MiB, WS_WDN0 = 82 * MiB, WS_WGU1 = 104 * MiB, WS_WDN1 = 148 * MiB;
constexpr size_t WS_B0 = 170 * MiB, WS_B1 = 298 * MiB, WS_QA = 426 * MiB, WS_KVA = 458 * MiB;
constexpr size_t WS_Q = 490 * MiB, WS_K = 682 * MiB, WS_V = 874 * MiB, WS_MID = 490 * MiB, WS_END = 1002 * MiB;
constexpr int LDS_BYTES = 155648;
static_assert(att::LDS_TOTAL <= LDS_BYTES && pg8::STAGE_BYTES <= LDS_BYTES, "LDS map");

#define XB_TMO      128
#define XB_XCNT(j)  (256  + 64 * (j))
#define XB_XSUB(j)  (1280 + 64 * (j))
#define XB_XGEN(j)  (2304 + 64 * (j))
#define XB_TOP      3328
#define XB_TOPGEN   3392
#define XCD_BAR_WORDS 3456
#define XB_SPIN_CAP (1u << 18)
__device__ __forceinline__ unsigned xb_ld(unsigned* p)              { return __hip_atomic_load(p, __ATOMIC_RELAXED, __HIP_MEMORY_SCOPE_AGENT); }
__device__ __forceinline__ unsigned xb_add(unsigned* p, unsigned v) { return __hip_atomic_fetch_add(p, v, __ATOMIC_RELAXED, __HIP_MEMORY_SCOPE_AGENT); }
__device__ __forceinline__ unsigned xb_xcc_id() { return (unsigned)__builtin_amdgcn_s_getreg((3 << 11) | 20) & 0xFu; }
#define XB_SPIN(cond, bar) do { unsigned _sp = 0; while (cond) { __builtin_amdgcn_s_sleep(1); \
    if ((++_sp & 255u) == 0u) { if (xb_ld(&(bar)[XB_TMO])) break; if (_sp > XB_SPIN_CAP) { atomicAdd(&(bar)[XB_TMO], 1u); break; } } } } while (0)
struct XcdBarrier { unsigned* bar; unsigned x; volatile LAS unsigned* st; };
__device__ __forceinline__ XcdBarrier xcd_barrier_post(unsigned* bar, volatile LAS unsigned* st) {
    XcdBarrier b; b.bar = bar; b.x = xb_xcc_id(); b.st = st;
    if (threadIdx.x == 0) (void)xb_add(&bar[XB_XCNT(b.x)], 1u);
    return b;
}
__device__ __forceinline__ void xcd_barrier_complete(unsigned* bar, unsigned x, unsigned& nloc, unsigned& nx) {
    const unsigned G = gridDim.x * gridDim.y * gridDim.z;
    unsigned sum, cnt, mine, sp = 0u;
    for (;;) {
        sum = 0u; cnt = 0u; mine = 0u;
#pragma unroll
        for (unsigned j = 0; j < 16; ++j) { const unsigned c = xb_ld(&bar[XB_XCNT(j)]); sum += c; cnt += (c > 0u) ? 1u : 0u; mine = (j == x) ? c : mine; }
        if (sum == G) break;
        __builtin_amdgcn_s_sleep(1);
        if ((++sp & 255u) == 0u) { if (xb_ld(&bar[XB_TMO])) break; if (sp > XB_SPIN_CAP) { atomicAdd(&bar[XB_TMO], 1u); break; } }
    }
    nloc = mine > 0u ? mine : 1u; nx = cnt > 0u ? cnt : 1u;
}
__device__ __forceinline__ void xcd_barrier(const XcdBarrier& b) {
    asm volatile("s_waitcnt vmcnt(0)" ::: "memory");
    __syncthreads();
    if (threadIdx.x == 0) {
        unsigned* bar = b.bar;
        __builtin_amdgcn_s_waitcnt(0);
        unsigned nloc = b.st[0], nx = b.st[1];
        if (nloc == 0u) { xcd_barrier_complete(bar, b.x, nloc, nx); b.st[0] = nloc; b.st[1] = nx; }
        const unsigned old = xb_add(&bar[XB_XSUB(b.x)], 1u);
        const unsigned gen = old / nloc;
        if (old + 1u == (gen + 1u) * nloc) {
            __builtin_amdgcn_fence(__ATOMIC_RELEASE, "agent");
            asm volatile("s_waitcnt vmcnt(0)" ::: "memory");
            const unsigned og = xb_add(&bar[XB_TOP], 1u);
            const unsigned tg = og / nx;
            if (og + 1u == (tg + 1u) * nx) xb_add(&bar[XB_TOPGEN], 1u);
            else XB_SPIN(xb_ld(&bar[XB_TOPGEN]) == tg, bar);
            __builtin_amdgcn_fence(__ATOMIC_ACQUIRE, "agent");
            xb_add(&bar[XB_XGEN(b.x)], 1u);
            asm volatile("s_waitcnt vmcnt(0)" ::: "memory");
        } else {
            XB_SPIN(xb_ld(&bar[XB_XGEN(b.x)]) == gen, bar);
            __builtin_amdgcn_fence(__ATOMIC_ACQUIRE, "agent");
            asm volatile("s_waitcnt vmcnt(0)" ::: "memory");
        }
    }
    __syncthreads();
}

#ifndef PH_MASK
#define PH_MASK 0xFFF
#endif
#define PH_ON(k) (((PH_MASK) >> (k)) & 1)
struct Args { const float* in[19]; float* out; unsigned char* ws; int ph_lo, ph_hi; };

__device__ __forceinline__ float wave_sum(float v) {
#pragma unroll
    for (int o = 1; o < 64; o <<= 1) v += __shfl_xor(v, o);
    return v;
}
__device__ __forceinline__ int map_row(int mode, int n) {
    switch (mode) {
        case 1: return (n >> 7) * 256 + (n & 127);
        case 2: return (n >> 7) * 256 + 128 + (n & 127);
        case 3: { if (n < 512) return 512 + n; const int j = n - 512; return 1024 + 2 * (j & 31) + (j >> 5); }
        case 4: { const int h = n / 192, d = n % 192; if (d < 128) return h * 128 + d; const int j = d - 128; return 2048 + h * 64 + 2 * (j & 31) + (j >> 5); }
        case 5: { const int h = n >> 8, d = n & 255; return d < 128 ? h * 128 + d : 2048 + h * 128 + (d - 128); }
        default: return n;
    }
}
__device__ __forceinline__ void transpose_item(const float* W, int K, int N, bf16_t* WT, int mode, const float* ks, const float* cs, LAS float* scr, int item, int lane) {
    const int nblk = N / 64, kb = item / nblk, nb = item % nblk, k0 = 64 * kb, n0 = 64 * nb;
    const int lr = lane >> 4, lc = (lane & 15) * 4;
    f32x4 v[16];
#pragma unroll
    for (int i = 0; i < 16; ++i) v[i] = *(const f32x4*)(W + (size_t)(k0 + 4 * i + lr) * N + n0 + lc);
#pragma unroll
    for (int i = 0; i < 16; ++i) { const int kk = 4 * i + lr; f32x4 t = v[i]; if (ks) t = t * ks[k0 + kk]; LAS float* d = scr + kk * 65 + lc; d[0] = t[0]; d[1] = t[1]; d[2] = t[2]; d[3] = t[3]; }
    asm volatile("s_waitcnt lgkmcnt(0)" ::: "memory");
    const int c = lane & 7;
#pragma unroll
    for (int j = 0; j < 8; ++j) { const int n = (lane >> 3) + 8 * j; const LAS float* s = scr + (8 * c) * 65 + n; const float csn = cs ? cs[n0 + n] : 1.f;
        u32x4 o; o.x = cvt_pk_bf16(s[0 * 65] * csn, s[1 * 65] * csn); o.y = cvt_pk_bf16(s[2 * 65] * csn, s[3 * 65] * csn); o.z = cvt_pk_bf16(s[4 * 65] * csn, s[5 * 65] * csn); o.w = cvt_pk_bf16(s[6 * 65] * csn, s[7 * 65] * csn);
        *(u32x4*)(WT + (size_t)map_row(mode, n0 + n) * K + k0 + 8 * c) = o; }
    asm volatile("s_waitcnt lgkmcnt(0)" ::: "memory");
}

__global__ void __launch_bounds__(512, 2) yoco_fwd(Args a) {
    extern __shared__ __attribute__((aligned(16))) unsigned char lds[];
    cg::grid_group grid = cg::this_grid();
    const int tid = threadIdx.x, lane = tid & 63, wave = __builtin_amdgcn_readfirstlane(tid >> 6);
    const int G = gridDim.x, bx = blockIdx.x, vcu = (G % 8 == 0) ? (bx % 8) * (G / 8) + bx / 8 : bx;
    const int gw = vcu * 8 + wave, NGW = G * 8;
    unsigned char* ws = a.ws;
    const float* x = a.in[0]; const int* positions = (const int*)a.in[1];
    float* out = a.out;
    float* rstd0 = (float*)(ws + WS_RSTD0); float* ssq = (float*)(ws + WS_SSQ); float* sskv = (float*)(ws + WS_SSKV); float* ss = (float*)(ws + WS_SS); float* cs = (float*)(ws + WS_CS);
    bf16_t* Wpool = (bf16_t*)(ws + WS_WPOOL); bf16_t* Wa = (bf16_t*)(ws + WS_WA); bf16_t* Wqb = (bf16_t*)(ws + WS_WQB); bf16_t* Wkvb = (bf16_t*)(ws + WS_WKVB); bf16_t* Wo = (bf16_t*)(ws + WS_WO);
    bf16_t* B0 = (bf16_t*)(ws + WS_B0); bf16_t* B1 = (bf16_t*)(ws + WS_B1); bf16_t* QA = (bf16_t*)(ws + WS_QA); bf16_t* KVA = (bf16_t*)(ws + WS_KVA);
    bf16_t* Qb = (bf16_t*)(ws + WS_Q); bf16_t* Kb = (bf16_t*)(ws + WS_K); bf16_t* Vb = (bf16_t*)(ws + WS_V); bf16_t* MID = (bf16_t*)(ws + WS_MID);
    LAS unsigned char* ldsl = (LAS unsigned char*)lds;
    const int lo = a.ph_lo, hi = a.ph_hi;
    volatile LAS unsigned* bst = (volatile LAS unsigned*)(ldsl + LDS_BYTES - 64);
    if (tid == 0) { bst[0] = 0u; bst[1] = 0u; }
    __syncthreads();
    XcdBarrier xbar = xcd_barrier_post((unsigned*)(ws + WS_BAR), bst);
#define IN(k) (lo <= (k) && (k) < hi)
#define SEAM(k) do { if (IN(k) && IN((k) + 1)) { if ((k) == 0) grid.sync(); else xcd_barrier(xbar); } } while (0)

    if (PH_ON(0) && IN(0)) {
        LAS float* scr = (LAS float*)(ldsl + wave * 16640);
        constexpr int I_POOL = 8 * 8, I_GU = 32 * 88, I_DN = 88 * 32, I_QA = 32 * 8, I_KVA = 32 * 9, I_QB = 8 * 48, I_KVB = 8 * 64, I_WO = 32 * 32;
        constexpr int NITEMS = 4 * I_POOL + 2 * (2 * I_GU + I_DN) + I_QA + I_KVA + I_QB + I_KVB + I_WO;
        for (int it = gw; it < NITEMS; it += NGW) {
            int r = it;
#define JOB(cnt, W_, K_, N_, dst_, mode_, ks_, cs_) if (r < (cnt)) { transpose_item(W_, K_, N_, dst_, mode_, ks_, cs_, scr, r, lane); continue; } r -= (cnt);
            JOB(I_POOL, a.in[3] + 0 * 262144, 512, 512, Wpool + 0 * 262144, 0, a.in[2] + 0, a.in[4] + 0)
            JOB(I_POOL, a.in[3] + 1 * 262144, 512, 512, Wpool + 1 * 262144, 0, a.in[2] + 512, a.in[4] + 512)
            JOB(I_POOL, a.in[3] + 2 * 262144, 512, 512, Wpool + 2 * 262144, 0, a.in[2] + 1024, a.in[4] + 1024)
            JOB(I_POOL, a.in[3] + 3 * 262144, 512, 512, Wpool + 3 * 262144, 0, a.in[2] + 1536, a.in[4] + 1536)
            JOB(I_GU, a.in[15], DM, DFF, (bf16_t*)(ws + WS_WGU0), 1, a.in[14], nullptr)
            JOB(I_GU, a.in[16], DM, DFF, (bf16_t*)(ws + WS_WGU0), 2, a.in[14], nullptr)
            JOB(I_DN, a.in[17], DFF, DM, (bf16_t*)(ws + WS_WDN0), 0, nullptr, nullptr)
            JOB(I_GU, a.in[15] + (size_t)DM * DFF, DM, DFF, (bf16_t*)(ws + WS_WGU1), 1, a.in[14] + DM, nullptr)
            JOB(I_GU, a.in[16] + (size_t)DM * DFF, DM, DFF, (bf16_t*)(ws + WS_WGU1), 2, a.in[14] + DM, nullptr)
            JOB(I_DN, a.in[17] + (size_t)DM * DFF, DFF, DM, (bf16_t*)(ws + WS_WDN1), 0, nullptr, nullptr)
            JOB(I_QA, a.in[10], DM, 512, Wa, 0, a.in[9], nullptr)
            JOB(I_KVA, a.in[6], DM, 576, Wa, 3, a.in[5], nullptr)
            JOB(I_QB, a.in[12], 512, 3072, Wqb, 4, a.in[11], nullptr)
            JOB(I_KVB, a.in[8], 512, 4096, Wkvb, 5, a.in[7], nullptr)
            JOB(I_WO, a.in[13], DM, DM, Wo, 0, nullptr, nullptr)
#undef JOB
        }
        for (int m = gw; m < T; m += NGW) {
            const f32x4* xr = (const f32x4*)(x + (size_t)m * DM) + lane; float s = 0.f;
#pragma unroll
            for (int j = 0; j < 8; ++j) s += sq4(xr[64 * j]);
            s = wave_sum(s);
            if (lane == 0) rstd0[m] = __builtin_amdgcn_rsqf(s * (1.f / DM) + EPS);
            if (lane < 32) {
                const float invf = (float)exp2(-(double)lane * (13.287712379549449 / 32.0));
                const float ang = (float)positions[m] * invf;
                double rev = (double)ang * 0.15915494309189535; rev -= rint(rev);
                const float rf = (float)rev;
                *(f32x2*)(cs + ((size_t)m * 32 + lane) * 2) = (f32x2){__builtin_amdgcn_cosf(rf), __builtin_amdgcn_sinf(rf)};
            }
        }
    }
    SEAM(0);
    if (PH_ON(1) && IN(1)) {
        for (int item = gw; item < (T / 64) * 8; item += NGW) {
            const int slab = item & 7, chunk = item >> 3, t0 = chunk * 64, c0 = slab * 256 + lane * 4, w = 2 << (slab >> 1), tin0 = t0 & (SEQ - 1);
            const float* xc = x + c0; f32x4 s = {0.f, 0.f, 0.f, 0.f};
            for (int j = 1; j < w; ++j) if (tin0 - j >= 0) s += *(const f32x4*)(xc + (size_t)(t0 - j) * DM) * rstd0[t0 - j];
#pragma unroll 4
            for (int i = 0; i < 64; ++i) { const int t = t0 + i, tin = tin0 + i;
                const f32x4 h = *(const f32x4*)(xc + (size_t)t * DM) * rstd0[t]; s += h;
                const int cnt = tin + 1 < w ? tin + 1 : w; const f32x4 d = s * (1.f / (float)cnt) - h;
                u32x2 o; o.x = cvt_pk_bf16(d[0], d[1]); o.y = cvt_pk_bf16(d[2], d[3]); *(u32x2*)(B0 + (size_t)t * DM + c0) = o;
                if (tin - w + 1 >= 0) s -= *(const f32x4*)(xc + (size_t)(t - w + 1) * DM) * rstd0[t - w + 1]; }
        }
    }
    SEAM(1);
    if (PH_ON(2) && IN(2)) {
        pg8::Gemm g{B0, Wpool, DM, 512, 512, 512, 262144}; pg8::Order S; S.init(T, 512, 4, G, bx);
        pg8::EpiResid E{x, nullptr, B1, ss, 512};
        pg8::gemm_phase(ldsl, g, S, E);
    }
    SEAM(2);
    if (PH_ON(3) && IN(3)) {
        pg8::Gemm g{B1, (const bf16_t*)(ws + WS_WGU0), DM, DM, DM, 0, 0}; pg8::Order S; S.init(T, 2 * DFF, 1, G, bx);
        pg8::EpiSwiGLU E{MID, ss};
#ifndef REP3
#define REP3 1
#endif
        for (int rep3 = 0; rep3 < REP3; ++rep3) pg8::gemm_phase(ldsl, g, S, E);
    }
    SEAM(3);
    if (PH_ON(4) && IN(4)) {
        pg8::Gemm g{MID, (const bf16_t*)(ws + WS_WDN0), DFF, DFF, DFF, 0, 0}; pg8::Order S; S.init(T, DM, 1, G, bx);
        pg8::EpiResid E{nullptr, B1, B0, ss, 0};
        pg8::gemm_phase(ldsl, g, S, E);
    }
    SEAM(4);
    if (PH_ON(5) && IN(5)) {
        pg8::Gemm g{B0, Wa, DM, DM, DM, 0, 0}; pg8::Order S; S.init(T, 1280, 1, G, bx);
        pg8::EpiA E{ss, QA, KVA, ssq, sskv, Kb, cs};
        pg8::gemm_phase(ldsl, g, S, E);
    }
    SEAM(5);
    if (PH_ON(6) && IN(6)) {
        { pg8::Gemm g{QA, Wqb, 512, 512, 512, 0, 0}; pg8::Order S; S.init(T, 3072, 1, G, bx);
          pg8::EpiQ E{ssq, Qb, cs}; pg8::gemm_phase(ldsl, g, S, E); }
        { pg8::Gemm g{KVA, Wkvb, 512, 512, 512, 0, 0}; pg8::Order S; S.init(T, 4096, 1, G, bx);
          pg8::EpiKV E{sskv, Kb, Vb}; pg8::gemm_phase(ldsl, g, S, E); }
    }
    SEAM(6);
    if (PH_ON(7) && IN(7)) {
#ifndef REP7
#define REP7 1
#endif
        for (int rep7 = 0; rep7 < REP7; ++rep7)
        for (int sid = vcu; sid < 256; sid += G) att::attn_stream(Qb, Kb, Vb, B1, sid, (char*)lds);
    }
    SEAM(7);
    if (PH_ON(8) && IN(8)) {
        pg8::Gemm g{B1, Wo, DM, DM, DM, 0, 0}; pg8::Order S; S.init(T, DM, 1, G, bx);
        pg8::EpiResid E{nullptr, B0, B0, ss, 0};
        pg8::gemm_phase(ldsl, g, S, E);
    }
    SEAM(8);
    if (PH_ON(9) && IN(9)) {
        pg8::Gemm g{B0, (const bf16_t*)(ws + WS_WGU1), DM, DM, DM, 0, 0}; pg8::Order S; S.init(T, 2 * DFF, 1, G, bx);
        pg8::EpiSwiGLU E{MID, ss};
        pg8::gemm_phase(ldsl, g, S, E);
    }
    SEAM(9);
    if (PH_ON(10) && IN(10)) {
        pg8::Gemm g{MID, (const bf16_t*)(ws + WS_WDN1), DFF, DFF, DFF, 0, 0}; pg8::Order S; S.init(T, DM, 1, G, bx);
        pg8::EpiResid E{nullptr, B0, B0, ss, 0};
        pg8::gemm_phase(ldsl, g, S, E);
    }
    SEAM(10);
    if (PH_ON(11) && IN(11)) {
        const float* fg = a.in[18];
        for (int m = gw; m < T; m += NGW) {
            float s = lane < 32 ? ss[(size_t)m * 32 + lane] : 0.f; s = wave_sum(s);
            const float r = __builtin_amdgcn_rsqf(s * (1.f / DM) + EPS);
            const u32x4* xr = (const u32x4*)(B0 + (size_t)m * DM) + lane; f32x4* orow = (f32x4*)(out + (size_t)m * DM) + 2 * lane; const f32x4* gr = (const f32x4*)fg + 2 * lane;
#pragma unroll
            for (int j = 0; j < 4; ++j) { const u32x4 w = xr[64 * j];
                const f32x4 v0 = {__uint_as_float(w.x << 16), __uint_as_float(w.x & 0xffff0000u), __uint_as_float(w.y << 16), __uint_as_float(w.y & 0xffff0000u)};
                const f32x4 v1 = {__uint_as_float(w.z << 16), __uint_as_float(w.z & 0xffff0000u), __uint_as_float(w.w << 16), __uint_as_float(w.w & 0xffff0000u)};
                orow[128 * j] = v0 * r * gr[128 * j]; orow[128 * j + 1] = v1 * r * gr[128 * j + 1]; }
        }
    }
#undef IN
#undef SEAM
}

extern "C" void kernel_launch(void* const* d_in, const int* in_sizes, int n_in, void* d_out, int out_size, void* d_ws, size_t ws_size, hipStream_t stream) {
    static int grid = 0;
    if (grid == 0) {
        if (n_in != 19 || in_sizes[0] != T * DM || out_size != T * DM || ws_size < WS_END) { fprintf(stderr, "kernel_launch: shape/workspace mismatch (n_in %d, in0 %d, out %d, ws %zu < %zu)\n", n_in, n_in > 0 ? in_sizes[0] : -1, out_size, ws_size, (size_t)WS_END); grid = -1; return; }
        int dev = 0, cus = 0, per_cu = 0;
        (void)hipGetDevice(&dev); (void)hipDeviceGetAttribute(&cus, hipDeviceAttributeMultiprocessorCount, dev);
        if (hipFuncSetAttribute((const void*)yoco_fwd, hipFuncAttributeMaxDynamicSharedMemorySize, LDS_BYTES) != hipSuccess) { fprintf(stderr, "kernel_launch: hipFuncSetAttribute failed\n"); grid = -1; return; }
        if (hipOccupancyMaxActiveBlocksPerMultiprocessor(&per_cu, (const void*)yoco_fwd, 512, LDS_BYTES) != hipSuccess || per_cu < 1) { fprintf(stderr, "kernel_launch: occupancy query says %d\n", per_cu); per_cu = 1; }
        (void)hipGetLastError();
        grid = cus * per_cu;
        if (grid <= 0) grid = 256;
    }
    if (grid < 0) return;
    if (hipMemsetAsync((char*)d_ws + WS_BAR, 0, XCD_BAR_WORDS * 4, stream) != hipSuccess) { fprintf(stderr, "kernel_launch: memset of the barrier words failed\n"); return; }
    Args a{};
    for (int i = 0; i < 19; ++i) a.in[i] = (const float*)d_in[i];
    a.out = (float*)d_out; a.ws = (unsigned char*)d_ws; a.ph_lo = 0; a.ph_hi = 12;
    void* args[] = {&a};
    hipError_t e = hipLaunchCooperativeKernel((const void*)yoco_fwd, dim3(grid), dim3(512), args, LDS_BYTES, stream);
    if (e != hipSuccess) fprintf(stderr, "cooperative launch failed: %s (grid %d)\n", hipGetErrorString(e), grid);
}
```

```cpp
#include <hip/hip_runtime.h>
#include <hip/hip_cooperative_groups.h>
#include <cstdio>
#include <cstdint>
namespace cg = cooperative_groups;

#define LAS __attribute__((address_space(3)))
typedef unsigned short bf16_t;
typedef short bf16x8 __attribute__((ext_vector_type(8)));
typedef short s16x4 __attribute__((ext_vector_type(4)));
typedef float f32x2 __attribute__((ext_vector_type(2)));
typedef float f32x4 __attribute__((ext_vector_type(4)));
typedef float f32x16 __attribute__((ext_vector_type(16)));
typedef unsigned u32x2 __attribute__((ext_vector_type(2)));
typedef unsigned u32x4 __attribute__((ext_vector_type(4)));

constexpr int DM = 2048, NB = 4, SEQ = 8192, T = NB * SEQ, DFF = 5632, NH = 16;
constexpr float EPS = 1e-6f;
constexpr float C2Q = 0.07216878364870322f * 1.4426950408889634f;

__device__ __forceinline__ unsigned cvt_pk_bf16(float lo, float hi) { unsigned r; asm volatile("v_cvt_pk_bf16_f32 %0, %1, %2" : "=v"(r) : "v"(lo), "v"(hi)); return r; }
__device__ __forceinline__ u32x4 pack8(f32x4 a, f32x4 b) { u32x4 w; w.x = cvt_pk_bf16(a[0], a[1]); w.y = cvt_pk_bf16(a[2], a[3]); w.z = cvt_pk_bf16(b[0], b[1]); w.w = cvt_pk_bf16(b[2], b[3]); return w; }
__device__ __forceinline__ float sq4(f32x4 v) { return (v[0] * v[0] + v[1] * v[1]) + (v[2] * v[2] + v[3] * v[3]); }

namespace pg8 {
constexpr int BM = 256, BK = 64, HALF = 128, HTB = HALF * BK * 2, STAGE_BYTES = 8 * HTB, NXCD = 8, WGM = 8;
__host__ __device__ __forceinline__ int lds_byte(int r, int c) { const int st = (r >> 4) * 2 + (c >> 5), rr = r & 15, cc = c & 31, ob = rr * 64 + cc * 2; return st * 1024 + (ob ^ (((ob >> 9) & 1) << 5)); }
__host__ __device__ __forceinline__ void stage_rc(int b, int& R, int& C) { const int st = b / 1024, sb = b % 1024, swz = sb ^ (((sb >> 9) & 1) << 5); R = (st >> 1) * 16 + swz / 64; C = (st & 1) * 32 + (swz % 64) / 2; }
__host__ __device__ __forceinline__ int perm32(int rho) { const int n = rho >> 4, i = rho & 15; return 8 * (i >> 2) + 4 * n + (i & 3); }

struct Unit { int pm, pn, grp; };
struct Gemm { const bf16_t* A; const bf16_t* Bt; int lda, ldb, K; long grpA, grpB; };

struct Order {
    int nM, nN, nwg, nG, G, c;
    __device__ void init(int M, int N, int nG_, int G_, int c_) { nM = M / BM; nN = N / BM; nwg = nM * nN; nG = nG_; G = G_; c = c_; }
    __device__ bool next(int i, Unit& u) const {
        const long L = (long)i * G + c; if (L >= (long)nwg * nG) return false;
        u.grp = (int)(L / nwg); int wgid = (int)(L % nwg);
        { const int q = nwg / NXCD, r = nwg % NXCD, xcd = wgid % NXCD, off = wgid / NXCD; wgid = (xcd < r ? xcd * (q + 1) : r * (q + 1) + (xcd - r) * q) + off; }
        const int nig = WGM * nN, gid = wgid / nig, fm = gid * WGM, gsz = (nM - fm) < WGM ? (nM - fm) : WGM;
        u.pm = fm + ((wgid % nig) % gsz); u.pn = (wgid % nig) / gsz; return true;
    }
};

template <class Epi>
__device__ __forceinline__ void gemm_phase(LAS unsigned char* lds, const Gemm g, const Order& S, const Epi& E) {
    const int tid = threadIdx.x, wid = __builtin_amdgcn_readfirstlane(tid >> 6), lane = tid & 63, wr = wid >> 2, wc = wid & 3, fr = lane & 15, fq = lane >> 4;
    const int K = g.K, nt = K / BK;
    unsigned voffA[2], voffB[2];
#pragma unroll
    for (int i = 0; i < 2; ++i) { int R, C; stage_rc(tid * 16 + i * 8192, R, C); const int Rb = (R & ~31) + perm32(R & 31);
        voffA[i] = (unsigned)(R * g.lda + C) * 2u; voffB[i] = (unsigned)(Rb * g.ldb + C) * 2u; }
    const size_t kstep = (size_t)(BK * 2);
    const size_t hstepA = (size_t)HALF * g.lda * 2, hstepB = (size_t)HALF * g.ldb * 2;
    const size_t tstepA = 2 * hstepA, tstepB = 2 * hstepB;
    const unsigned ldsw = (unsigned)wid * 1024u;
    const int aoff = lds_byte(wr * 64 + fr, fq * 8), boff = lds_byte(wc * 32 + fr, fq * 8);
#define PG8_SA(b, h) (((b) * 2 + (h)) * HTB)
#define PG8_SB(b, h) ((4 + (b) * 2 + (h)) * HTB)
#define PG8_STAGE(bufoff, gbase, voff) do { _Pragma("unroll") for (int _i = 0; _i < 2; ++_i) \
        __builtin_amdgcn_global_load_lds((const unsigned*)((const char*)(gbase) + (voff)[_i]), (LAS unsigned*)(lds + (bufoff) + ldsw + _i * 8192), 16, 0, 0); } while (0)
#define PG8_LDA(dst, b, h) do { _Pragma("unroll") for (int m = 0; m < 4; ++m) _Pragma("unroll") for (int k = 0; k < 2; ++k) dst[m][k] = *(const LAS bf16x8*)(lds + PG8_SA(b, h) + aoff + m * 2048 + k * 1024); } while (0)
#define PG8_LDB(dst, b, h) do { _Pragma("unroll") for (int n = 0; n < 2; ++n) _Pragma("unroll") for (int k = 0; k < 2; ++k) dst[n][k] = *(const LAS bf16x8*)(lds + PG8_SB(b, h) + boff + n * 2048 + k * 1024); } while (0)
#define PG8_MMA(ai, bj, At, Bt) do { __builtin_amdgcn_s_setprio(1); _Pragma("unroll") for (int m = 0; m < 4; ++m) _Pragma("unroll") for (int n = 0; n < 2; ++n) _Pragma("unroll") for (int k = 0; k < 2; ++k) \
        acc[ai][bj][m][n] = __builtin_amdgcn_mfma_f32_16x16x32_bf16(Bt[n][k], At[m][k], acc[ai][bj][m][n], 0, 0, 0); __builtin_amdgcn_s_setprio(0); } while (0)
#define PG8_WAIT_V(n) asm volatile("s_waitcnt vmcnt(" #n ")" ::: "memory")
#define PG8_WAIT_L(n) asm volatile("s_waitcnt lgkmcnt(" #n ")" ::: "memory")
#define PG8_BAR __builtin_amdgcn_s_barrier()
#define PG8_SCHED __builtin_amdgcn_sched_barrier(0)
    Unit cur, nxt; int ui = 0;
    if (!S.next(0, cur)) return;
    f32x4 acc[2][2][4][2];
#pragma unroll
    for (int a = 0; a < 2; ++a)
#pragma unroll
        for (int b = 0; b < 2; ++b)
#pragma unroll
            for (int m = 0; m < 4; ++m)
#pragma unroll
                for (int n = 0; n < 2; ++n) acc[a][b][m][n] = (f32x4){0.f, 0.f, 0.f, 0.f};
    bf16x8 At[4][2], B0[2][2], B1[2][2];
    const char* cA = (const char*)(g.A + (size_t)cur.grp * g.grpA) + (size_t)cur.pm * tstepA;
    const char* cB = (const char*)(g.Bt + (size_t)cur.grp * g.grpB) + (size_t)cur.pn * tstepB;
    PG8_STAGE(PG8_SB(0, 0), cB, voffB); PG8_STAGE(PG8_SB(0, 1), cB + hstepB, voffB); PG8_STAGE(PG8_SA(0, 0), cA, voffA); PG8_STAGE(PG8_SA(0, 1), cA + hstepA, voffA);
    if (wr == 1) PG8_BAR;
    PG8_WAIT_V(2); PG8_BAR;
    PG8_STAGE(PG8_SB(1, 0), cB + kstep, voffB); PG8_STAGE(PG8_SA(1, 0), cA + kstep, voffA); PG8_STAGE(PG8_SB(1, 1), cB + hstepB + kstep, voffB);
    PG8_WAIT_V(6); PG8_BAR;
    for (;;) {
        const bool has_next = S.next(ui + 1, nxt);
        const char* nA = has_next ? (const char*)(g.A + (size_t)nxt.grp * g.grpA) + (size_t)nxt.pm * tstepA : cA;
        const char* nB = has_next ? (const char*)(g.Bt + (size_t)nxt.grp * g.grpB) + (size_t)nxt.pn * tstepB : cB;
        for (int t = 0; t < nt; t += 2) {
            const bool last = (t == nt - 2);
            const char* a1 = cA + (size_t)(t + 1) * kstep;
            const char* a2 = last ? nA : cA + (size_t)(t + 2) * kstep; const char* b2 = last ? nB : cB + (size_t)(t + 2) * kstep;
            const char* a3 = a2 + kstep; const char* b3 = b2 + kstep;
            PG8_LDB(B0, 0, 0); PG8_LDB(B1, 0, 1); PG8_SCHED; PG8_LDA(At, 0, 0); PG8_STAGE(PG8_SA(1, 1), a1 + hstepA, voffA);
            PG8_WAIT_V(8); PG8_WAIT_L(0); PG8_BAR; PG8_MMA(0, 0, At, B0); PG8_MMA(0, 1, At, B1); PG8_BAR; PG8_SCHED;
            PG8_LDA(At, 0, 1); PG8_STAGE(PG8_SB(0, 0), b2, voffB); PG8_STAGE(PG8_SB(0, 1), b2 + hstepB, voffB); PG8_STAGE(PG8_SA(0, 0), a2, voffA);
            PG8_WAIT_V(8); PG8_WAIT_L(0); PG8_BAR; PG8_MMA(1, 0, At, B0); PG8_MMA(1, 1, At, B1); PG8_BAR; PG8_SCHED;
            PG8_LDB(B0, 1, 0); PG8_LDB(B1, 1, 1); PG8_SCHED; PG8_LDA(At, 1, 0); PG8_STAGE(PG8_SA(0, 1), a2 + hstepA, voffA);
            PG8_WAIT_V(8); PG8_WAIT_L(0); PG8_BAR; PG8_MMA(0, 0, At, B0); PG8_MMA(0, 1, At, B1); PG8_BAR; PG8_SCHED;
            PG8_LDA(At, 1, 1); PG8_STAGE(PG8_SB(1, 0), b3, voffB); PG8_STAGE(PG8_SB(1, 1), b3 + hstepB, voffB); PG8_STAGE(PG8_SA(1, 0), a3, voffA);
            PG8_WAIT_V(8); PG8_WAIT_L(0); PG8_BAR; PG8_MMA(1, 0, At, B0); PG8_MMA(1, 1, At, B1); PG8_BAR; PG8_SCHED;
        }
        if (wr == 0) PG8_BAR;
        E(acc, cur, wr, wc, fr, fq);
        if (!has_next) break;
#pragma unroll
        for (int a = 0; a < 2; ++a)
#pragma unroll
            for (int b = 0; b < 2; ++b)
#pragma unroll
                for (int m = 0; m < 4; ++m)
#pragma unroll
                    for (int n = 0; n < 2; ++n) acc[a][b][m][n] = (f32x4){0.f, 0.f, 0.f, 0.f};
        cur = nxt; cA = nA; cB = nB; ++ui;
        if (wr == 1) PG8_BAR;
    }
    PG8_WAIT_V(0);
    PG8_BAR;
#undef PG8_SA
#undef PG8_SB
#undef PG8_STAGE
#undef PG8_LDA
#undef PG8_LDB
#undef PG8_MMA
#undef PG8_WAIT_V
#undef PG8_WAIT_L
#undef PG8_BAR
#undef PG8_SCHED
}

template <int NP> __device__ __forceinline__ float row_rstd(const float* ss, int row, int fq, float invn) {
    const float* p = ss + (size_t)row * NP + fq * (NP / 4); float s;
    if constexpr (NP == 32) { const f32x4 a = *(const f32x4*)p, b = *(const f32x4*)(p + 4); s = ((a[0] + a[1]) + (a[2] + a[3])) + ((b[0] + b[1]) + (b[2] + b[3])); }
    else { const f32x2 a = *(const f32x2*)p; s = a[0] + a[1]; }
    s += __shfl_xor(s, 16); s += __shfl_xor(s, 32);
    return __builtin_amdgcn_rsqf(s * invn + EPS);
}
__device__ __forceinline__ float rowsum4(float q) { q += __shfl_xor(q, 16); q += __shfl_xor(q, 32); return q; }

struct EpiResid {
    const float* basf; const bf16_t* basb; bf16_t* xb; float* ss; int colgrp;
    __device__ __forceinline__ void operator()(const f32x4 (&acc)[2][2][4][2], const Unit& u, int wr, int wc, int fr, int fq) const {
        const int row0 = u.pm * BM + wr * 64 + fr, colb = u.grp * colgrp + u.pn * BM, col0 = colb + wc * 32 + 8 * fq, pidx = (colb >> 6) + wc;
        f32x4 pre[3][4];
#define RB_LOAD(it, P) do { const size_t off_ = (size_t)(row0 + ((it) >> 2) * HALF + ((it) & 3) * 16) * DM + col0; \
        if (basf) { P[0] = *(const f32x4*)(basf + off_); P[1] = *(const f32x4*)(basf + off_ + 4); P[2] = *(const f32x4*)(basf + off_ + HALF); P[3] = *(const f32x4*)(basf + off_ + HALF + 4); } \
        else { const u32x4 w0_ = *(const u32x4*)(basb + off_), w1_ = *(const u32x4*)(basb + off_ + HALF); \
               P[0] = (f32x4){__uint_as_float(w0_.x << 16), __uint_as_float(w0_.x & 0xffff0000u), __uint_as_float(w0_.y << 16), __uint_as_float(w0_.y & 0xffff0000u)}; \
               P[1] = (f32x4){__uint_as_float(w0_.z << 16), __uint_as_float(w0_.z & 0xffff0000u), __uint_as_float(w0_.w << 16), __uint_as_float(w0_.w & 0xffff0000u)}; \
               P[2] = (f32x4){__uint_as_float(w1_.x << 16), __uint_as_float(w1_.x & 0xffff0000u), __uint_as_float(w1_.y << 16), __uint_as_float(w1_.y & 0xffff0000u)}; \
               P[3] = (f32x4){__uint_as_float(w1_.z << 16), __uint_as_float(w1_.z & 0xffff0000u), __uint_as_float(w1_.w << 16), __uint_as_float(w1_.w & 0xffff0000u)}; } } while (0)
        RB_LOAD(0, pre[0]); RB_LOAD(1, pre[1]);
#pragma unroll
        for (int it = 0; it < 8; ++it) { const int ai = it >> 2, m = it & 3, row = row0 + ai * HALF + m * 16; const size_t off = (size_t)row * DM + col0; float q = 0.f;
            if (it + 2 < 8) RB_LOAD(it + 2, pre[(it + 2) % 3]);
#pragma unroll
            for (int bj = 0; bj < 2; ++bj) {
                const f32x4 v0 = acc[ai][bj][m][0] + pre[it % 3][2 * bj], v1 = acc[ai][bj][m][1] + pre[it % 3][2 * bj + 1];
                *(u32x4*)(xb + off + bj * HALF) = pack8(v0, v1);
                q += sq4(v0) + sq4(v1); }
            q = rowsum4(q); if (fq == 0) ss[(size_t)row * 32 + pidx] = q; }
#undef RB_LOAD
    }
};
struct EpiSwiGLU {
    bf16_t* mid; const float* ss;
    __device__ __forceinline__ void operator()(const f32x4 (&acc)[2][2][4][2], const Unit& u, int wr, int wc, int fr, int fq) const {
        const int row0 = u.pm * BM + wr * 64 + fr, col0 = u.pn * HALF + wc * 32 + 8 * fq;
#pragma unroll
        for (int ai = 0; ai < 2; ++ai)
#pragma unroll
            for (int m = 0; m < 4; ++m) { const int row = row0 + ai * HALF + m * 16; const float s = row_rstd<32>(ss, row, fq, 1.f / DM);
                const float sneg = -1.4426950408889634f * s, s2 = s * s; unsigned w[4];
#pragma unroll
                for (int n = 0; n < 2; ++n)
#pragma unroll
                    for (int e = 0; e < 2; ++e) { const f32x2 gg = {acc[ai][0][m][n][2 * e], acc[ai][0][m][n][2 * e + 1]}, uu = {acc[ai][1][m][n][2 * e], acc[ai][1][m][n][2 * e + 1]};
                        const f32x2 t = gg * sneg; f32x2 d; d.x = __builtin_amdgcn_exp2f(t.x); d.y = __builtin_amdgcn_exp2f(t.y); d = d + 1.0f;
                        f32x2 r; r.x = __builtin_amdgcn_rcpf(d.x); r.y = __builtin_amdgcn_rcpf(d.y);
                        const f32x2 h = (gg * uu) * (r * s2); w[2 * n + e] = cvt_pk_bf16(h.x, h.y); }
                *(u32x4*)(mid + (size_t)row * DFF + col0) = (u32x4){w[0], w[1], w[2], w[3]}; }
    }
};
__device__ __forceinline__ void rope8(f32x4& v0, f32x4& v1, const float* cs  ) {
    const f32x4 c0 = *(const f32x4*)cs, c1 = *(const f32x4*)(cs + 4);
    const f32x4 a = v0, b = v1;
    v0 = (f32x4){a[0] * c0[0] - a[1] * c0[1], a[1] * c0[0] + a[0] * c0[1], a[2] * c0[2] - a[3] * c0[3], a[3] * c0[2] + a[2] * c0[3]};
    v1 = (f32x4){b[0] * c1[0] - b[1] * c1[1], b[1] * c1[0] + b[0] * c1[1], b[2] * c1[2] - b[3] * c1[3], b[3] * c1[2] + b[2] * c1[3]};
}
struct EpiA {
    const float* ss; bf16_t* qa; bf16_t* kva; float* ssq; float* sskv; bf16_t* Kb; const float* cs;
    __device__ __forceinline__ void operator()(const f32x4 (&acc)[2][2][4][2], const Unit& u, int wr, int wc, int fr, int fq) const {
        const int row0 = u.pm * BM + wr * 64 + fr;
        if (u.pn < 4) {
            bf16_t* dst = u.pn < 2 ? qa : kva; float* sso = u.pn < 2 ? ssq : sskv; const int colb = (u.pn & 1) * BM, col0 = colb + wc * 32 + 8 * fq, pidx = (u.pn & 1) * 4 + wc;
#pragma unroll
            for (int ai = 0; ai < 2; ++ai)
#pragma unroll
                for (int m = 0; m < 4; ++m) { const int row = row0 + ai * HALF + m * 16; const float s = row_rstd<32>(ss, row, fq, 1.f / DM); float q = 0.f;
#pragma unroll
                    for (int bj = 0; bj < 2; ++bj) { const f32x4 v0 = acc[ai][bj][m][0] * s, v1 = acc[ai][bj][m][1] * s;
                        *(u32x4*)(dst + (size_t)row * 512 + col0 + bj * HALF) = pack8(v0, v1); q += sq4(v0) + sq4(v1); }
                    q = rowsum4(q); if (fq == 0) sso[(size_t)row * 8 + pidx] = q; }
        } else {
            const int p0 = wc * 32 + 8 * fq;
#pragma unroll
            for (int ai = 0; ai < 2; ++ai)
#pragma unroll
                for (int m = 0; m < 4; ++m) { const int row = row0 + ai * HALF + m * 16; const float s = row_rstd<32>(ss, row, fq, 1.f / DM);
                    if (wc < 2) { f32x4 v0 = acc[ai][0][m][0] * s, v1 = acc[ai][0][m][1] * s; rope8(v0, v1, cs + ((size_t)row * 32 + (p0 >> 1)) * 2);
                        const u32x4 w = pack8(v0, v1); bf16_t* kp = Kb + (size_t)row * 3072 + 128 + p0;
#pragma unroll
                        for (int h = 0; h < NH; ++h) *(u32x4*)(kp + h * 192) = w; } }
        }
    }
};
struct EpiQ {
    const float* ssq; bf16_t* Q; const float* cs;
    __device__ __forceinline__ void operator()(const f32x4 (&acc)[2][2][4][2], const Unit& u, int wr, int wc, int fr, int fq) const {
        const int row0 = u.pm * BM + wr * 64 + fr;
#pragma unroll
        for (int ai = 0; ai < 2; ++ai)
#pragma unroll
            for (int m = 0; m < 4; ++m) { const int row = row0 + ai * HALF + m * 16; const float s = row_rstd<8>(ssq, row, fq, 1.f / 512.f) * C2Q;
#pragma unroll
                for (int bj = 0; bj < 2; ++bj) { f32x4 v0 = acc[ai][bj][m][0] * s, v1 = acc[ai][bj][m][1] * s;
                    if (u.pn < 8) { *(u32x4*)(Q + (size_t)row * 3072 + (2 * u.pn + bj) * 192 + wc * 32 + 8 * fq) = pack8(v0, v1); }
                    else { const int head = 4 * (u.pn - 8) + 2 * bj + (wc >> 1), p0 = 32 * (wc & 1) + 8 * fq; rope8(v0, v1, cs + ((size_t)row * 32 + (p0 >> 1)) * 2);
                        *(u32x4*)(Q + (size_t)row * 3072 + head * 192 + 128 + p0) = pack8(v0, v1); } } }
    }
};
struct EpiKV {
    const float* sskv; bf16_t* Kb; bf16_t* Vb;
    __device__ __forceinline__ void operator()(const f32x4 (&acc)[2][2][4][2], const Unit& u, int wr, int wc, int fr, int fq) const {
        const int row0 = u.pm * BM + wr * 64 + fr;
#pragma unroll
        for (int ai = 0; ai < 2; ++ai)
#pragma unroll
            for (int m = 0; m < 4; ++m) { const int row = row0 + ai * HALF + m * 16; const float s = row_rstd<8>(sskv, row, fq, 1.f / 512.f);
#pragma unroll
                for (int bj = 0; bj < 2; ++bj) { const f32x4 v0 = acc[ai][bj][m][0] * s, v1 = acc[ai][bj][m][1] * s;
                    bf16_t* d = u.pn < 8 ? Kb + (size_t)row * 3072 + (2 * u.pn + bj) * 192 + wc * 32 + 8 * fq : Vb + (size_t)row * 2048 + (2 * (u.pn - 8) + bj) * 128 + wc * 32 + 8 * fq;
                    *(u32x4*)d = pack8(v0, v1); } }
    }
};
}

namespace att {
constexpr int NW = 8, QBLK = 32, KVBLK = 64, QB = 256;
constexpr int LDQ = 3072, LDK = 3072, LDV = 2048, LDO = 2048;
constexpr int KROWB = 400;
constexpr int SHM_K = KVBLK * KROWB, SHM_V = KVBLK * 128 * 2;
constexpr int NQR = 12;
constexpr int LDS_K0 = 3 * SHM_V, LDS_WS = LDS_K0 + 2 * SHM_K, LDS_QS = LDS_WS + NW * 64 * 4, LDS_TOTAL = LDS_QS + NW * (12 - NQR) * 1024;
constexpr float THR = 8.f;
#define SBAR() __builtin_amdgcn_sched_barrier(0)
__device__ __forceinline__ int v_st(int k, int c) { const int kk = (k & ~0xC) | ((k & 4) << 1) | ((k & 8) >> 1); return ((kk >> 3) * 4 + (c >> 5)) * 512 + ((kk & 7) * 32 + (c & 31)) * 2; }
__device__ __forceinline__ int v_rd_base(int lane) { return ((lane & 3) << 3) | (((lane >> 2) & 3) << 6) | (((lane >> 4) & 1) << 5) | (((lane >> 5) & 1) << 8); }
constexpr int v_rd_off(int d0, int ks, int half) { return d0 * 512 + ks * 4096 + half * 2048; }
__device__ __forceinline__ int crow(int r, int hi) { return (r & 3) + 8 * (r >> 2) + 4 * hi; }
__device__ __forceinline__ bf16x8 ldg8(const bf16_t* base, unsigned off) { return *reinterpret_cast<const bf16x8*>(base + off); }
__device__ __forceinline__ void mask_tile(f32x16& p0, f32x16& p1, int dq) {
    const float NEG = -__builtin_inff();
#pragma unroll
    for (int r = 0; r < 16; ++r) { const int c = (r & 3) + 8 * (r >> 2); if (dq - c < 0) p0[r] = NEG; if (dq - c - 32 < 0) p1[r] = NEG; }
}
__device__ __forceinline__ void qkt(f32x16& p0, f32x16& p1, const char* a, const char* qs, const bf16x8* qr, float negm) {
#pragma unroll
    for (int r = 0; r < 16; ++r) { p0[r] = negm; p1[r] = negm; }
    bf16x8 kA[3], kB[3], qv[3];
#define KL(d) do { kA[(d) % 3] = *reinterpret_cast<const bf16x8*>(a + (d) * 32); kB[(d) % 3] = *reinterpret_cast<const bf16x8*>(a + (d) * 32 + 32 * KROWB); \
        if ((d) >= NQR) qv[(d) % 3] = *reinterpret_cast<const bf16x8*>(qs + ((d) - NQR) * 1024); } while (0)
    KL(0); KL(1);
#pragma unroll
    for (int d0 = 0; d0 < 12; ++d0) {
        if (d0 + 2 < 12) KL(d0 + 2);
        SBAR();
        const bf16x8 q = d0 < NQR ? qr[d0 < NQR ? d0 : 0] : qv[d0 % 3];
        p0 = __builtin_amdgcn_mfma_f32_32x32x16_bf16(kA[d0 % 3], q, p0, 0, 0, 0);
        p1 = __builtin_amdgcn_mfma_f32_32x32x16_bf16(kB[d0 % 3], q, p1, 0, 0, 0);
        SBAR(); }
#undef KL
}
__device__ __forceinline__ void softmax_tile(f32x16& p0, f32x16& p1, float& m_reg, float& l_reg, float& alpha, bf16x8& pa0, bf16x8& pa1, bf16x8& pa2, bf16x8& pa3) {
    float pmax = fmaxf(p0[0], p1[0]);
#pragma unroll
    for (int r = 1; r < 16; ++r) pmax = fmaxf(fmaxf(pmax, p0[r]), p1[r]);
    { auto rr = __builtin_amdgcn_permlane32_swap(__float_as_uint(pmax), __float_as_uint(pmax), false, false); pmax = fmaxf(__uint_as_float(rr[0]), __uint_as_float(rr[1])); }
    alpha = 1.f;
    if (__builtin_expect(!__all(pmax <= THR), 0)) { const float dl = fmaxf(pmax, 0.f); m_reg += dl; alpha = __builtin_amdgcn_exp2f(-dl);
#pragma unroll
        for (int r = 0; r < 16; ++r) { p0[r] -= dl; p1[r] -= dl; } }
#pragma unroll
    for (int r = 0; r < 16; ++r) { p0[r] = __builtin_amdgcn_exp2f(p0[r]); p1[r] = __builtin_amdgcn_exp2f(p1[r]); }
    float ps = 0.f;
#pragma unroll
    for (int r = 0; r < 16; ++r) ps += p0[r] + p1[r];
    { auto rr = __builtin_amdgcn_permlane32_swap(__float_as_uint(ps), __float_as_uint(ps), false, false); ps = __uint_as_float(rr[0]) + __uint_as_float(rr[1]); }
    l_reg = l_reg * alpha + ps;
#define PK4(P, B_, OUT) do { unsigned a0 = cvt_pk_bf16(P[B_+0], P[B_+1]), a1 = cvt_pk_bf16(P[B_+2], P[B_+3]); \
        unsigned b0 = cvt_pk_bf16(P[B_+4], P[B_+5]), b1 = cvt_pk_bf16(P[B_+6], P[B_+7]); \
        auto r0 = __builtin_amdgcn_permlane32_swap(a0, b0, false, false); auto r1 = __builtin_amdgcn_permlane32_swap(a1, b1, false, false); \
        u32x4 w = {r0[0], r1[0], r0[1], r1[1]}; OUT = *reinterpret_cast<bf16x8*>(&w); } while (0)
    PK4(p0, 0, pa0); PK4(p0, 8, pa1); PK4(p1, 0, pa2); PK4(p1, 8, pa3);
#undef PK4
}
__device__ __forceinline__ void pv_tile(f32x16* o, int vb, bf16x8 pa0, bf16x8 pa1, bf16x8 pa2, bf16x8 pa3) {
#define TRRD(dst, off) asm volatile("ds_read_b64_tr_b16 %0, %1 offset:%2" : "=&v"(dst) : "v"(vb), "i"(off) : "memory")
#define TR8(S, d0) do { constexpr int b_ = v_rd_off(d0, 0, 0); TRRD(S##l0, b_); TRRD(S##h0, b_ + 2048); TRRD(S##l1, b_ + 4096); TRRD(S##h1, b_ + 6144); \
        TRRD(S##l2, b_ + 8192); TRRD(S##h2, b_ + 10240); TRRD(S##l3, b_ + 12288); TRRD(S##h3, b_ + 14336); } while (0)
#define MM4(S, d0) do { \
        o[d0] = __builtin_amdgcn_mfma_f32_32x32x16_bf16(pa0, (bf16x8){S##l0[0], S##l0[1], S##l0[2], S##l0[3], S##h0[0], S##h0[1], S##h0[2], S##h0[3]}, o[d0], 0, 0, 0); \
        o[d0] = __builtin_amdgcn_mfma_f32_32x32x16_bf16(pa1, (bf16x8){S##l1[0], S##l1[1], S##l1[2], S##l1[3], S##h1[0], S##h1[1], S##h1[2], S##h1[3]}, o[d0], 0, 0, 0); \
        o[d0] = __builtin_amdgcn_mfma_f32_32x32x16_bf16(pa2, (bf16x8){S##l2[0], S##l2[1], S##l2[2], S##l2[3], S##h2[0], S##h2[1], S##h2[2], S##h2[3]}, o[d0], 0, 0, 0); \
        o[d0] = __builtin_amdgcn_mfma_f32_32x32x16_bf16(pa3, (bf16x8){S##l3[0], S##l3[1], S##l3[2], S##l3[3], S##h3[0], S##h3[1], S##h3[2], S##h3[3]}, o[d0], 0, 0, 0); } while (0)
    s16x4 Al0, Al1, Al2, Al3, Ah0, Ah1, Ah2, Ah3, Bl0, Bl1, Bl2, Bl3, Bh0, Bh1, Bh2, Bh3;
    TR8(A, 0); TR8(B, 1);
    asm volatile("s_waitcnt lgkmcnt(8)" ::: "memory"); SBAR(); MM4(A, 0); SBAR();
    TR8(A, 2);
    asm volatile("s_waitcnt lgkmcnt(8)" ::: "memory"); SBAR(); MM4(B, 1); SBAR();
    TR8(B, 3);
    asm volatile("s_waitcnt lgkmcnt(8)" ::: "memory"); SBAR(); MM4(A, 2); SBAR();
    asm volatile("s_waitcnt lgkmcnt(0)" ::: "memory"); SBAR(); MM4(B, 3);
#undef MM4
#undef TR8
#undef TRRD
}
#define VMW() asm volatile("s_waitcnt vmcnt(0)" ::: "memory")
#define SLOAD(Kp, Vp) do { const bf16_t* vp_ = (Vp); st_v0 = ldg8(vp_, voff); st_v1 = ldg8(vp_ + 32 * LDV, voff); \
        const bf16_t* kp_ = (Kp); st_k0 = ldg8(kp_, koff); st_k1 = ldg8(kp_ + 64, koff); st_k2 = ldg8(kp_ + 128, koff); } while (0)
#define SWRITE(kb_, vb_) do { char* d_ = K_lds + (kb_) * SHM_K + kws; *(bf16x8*)d_ = st_k0; *(bf16x8*)(d_ + 128) = st_k1; *(bf16x8*)(d_ + 256) = st_k2; \
        *(bf16x8*)(V_lds + (vb_) * SHM_V + vst0) = st_v0; *(bf16x8*)(V_lds + (vb_) * SHM_V + vst1) = st_v1; } while (0)
#define BLK_BH(ii) (xcd * 8 + (ii))
#define BLK_QB(ii) (((ii) & 1) ? 31 - j : j)
#define TILEPTR(ii, nn, Kp, Vp) do { const int bh_ = BLK_BH(ii), qb_ = BLK_QB(ii), tl_ = ((ii) & 1) ? 4 * qb_ + 3 - (nn) : (nn); \
        const size_t row_ = (size_t)(bh_ >> 4) * SEQ + (size_t)tl_ * KVBLK; Kp = Kall + row_ * LDK + (bh_ & 15) * 192; Vp = Vall + row_ * LDV + (bh_ & 15) * 128; } while (0)
__device__ __forceinline__ void attn_stream(const bf16_t* Qall, const bf16_t* Kall, const bf16_t* Vall, bf16_t* Oall, int sid, char* lds) {
    const int xcd = sid >> 5, j = sid & 31;
    const int tid = threadIdx.x, wid = __builtin_amdgcn_readfirstlane(tid >> 6), lane = tid & 63, r32 = lane & 31, hi = lane >> 5;
    const int sr = tid >> 4, sc = (tid & 15) * 8, kr = tid >> 3;
    const unsigned voff = (unsigned)(sr * LDV + sc), koff = (unsigned)(kr * LDK + (tid & 7) * 8), qoff = (unsigned)((wid * QBLK + r32) * LDQ + hi * 8);
    const int kws = kr * KROWB + (tid & 7) * 16, vst0 = v_st(sr, sc), vst1 = v_st(32 + sr, sc);
    char* V_lds = lds; char* K_lds = lds + LDS_K0; char* qs = lds + LDS_QS + wid * ((12 - NQR) * 1024) + lane * 16;
    float* ws = (float*)(lds + LDS_WS) + wid * 64; float* li_l = ws, * al_l = ws + 32;
    const char* ka0 = K_lds + r32 * KROWB + hi * 16;
    const int vrb = (int)(uintptr_t)V_lds + v_rd_base(lane);
    const bool grpB = wid >= 4;
    if (wid >= 4) __builtin_amdgcn_s_setprio(1);
    bf16x8 st_v0, st_v1, st_k0, st_k1, st_k2;
    bf16x8 qr[NQR];
    f32x16 o[4], p0, p1; float m_reg, l_reg, al; bf16x8 pa0, pa1, pa2, pa3;
    const bf16_t* kp; const bf16_t* vp;
    { const int bh0 = BLK_BH(0); const bf16_t* Q0 = Qall + ((size_t)(bh0 >> 4) * SEQ + (size_t)BLK_QB(0) * QB) * LDQ + (bh0 & 15) * 192;
#pragma unroll
      for (int d0 = 0; d0 < NQR; ++d0) qr[d0] = ldg8(Q0 + d0 * 16, qoff);
#pragma unroll
      for (int d0 = NQR; d0 < 12; ++d0) *(bf16x8*)(qs + (d0 - NQR) * 1024) = ldg8(Q0 + d0 * 16, qoff);
#pragma unroll
      for (int d0 = 0; d0 < NQR; ++d0) asm volatile("" : "+v"(qr[d0]));
      TILEPTR(0, 0, kp, vp); SLOAD(kp, vp); VMW(); SWRITE(0, 0); }
    __syncthreads();
    if (grpB) { TILEPTR(0, 1, kp, vp); SLOAD(kp, vp); }
    int kb = 0, vb = 0;
    for (int i = 0; i < 8; ++i) {
        const int bh = BLK_BH(i), qb = BLK_QB(i), NT = 4 * qb + 4, qlo = qb * QB + wid * QBLK, qm = qlo + r32 - 4 * hi;
        const bool more = i < 7, desc = i & 1;
        m_reg = 0.f; l_reg = 0.f;
#pragma unroll
        for (int d = 0; d < 4; ++d) o[d] = f32x16{};
#define STEP(ACT) do { \
            const int t = desc ? NT - 1 - n : n; \
            const bool v1 = (n + 1 < NT) || more; bool v2 = true; if (n + 2 >= NT) v2 = more; \
            const int kb1 = kb ^ 1, vb1 = vb == 2 ? 0 : vb + 1; \
            if (!grpB && v1) { if (n + 1 < NT) TILEPTR(i, n + 1, kp, vp); else TILEPTR(i + 1, 0, kp, vp); SLOAD(kp, vp); } \
            if (ACT) { SBAR(); qkt(p0, p1, ka0 + kb * SHM_K, qs, qr, -m_reg); SBAR(); } \
            if (grpB) { if (v1) { VMW(); SWRITE(kb1, vb1); } __syncthreads(); \
                        if (v2) { if (n + 2 < NT) TILEPTR(i, n + 2, kp, vp); else TILEPTR(i + 1, n + 2 - NT, kp, vp); SLOAD(kp, vp); } } \
            if (ACT) { SBAR(); \
                { const int kb_ = t * KVBLK; if (kb_ + KVBLK - 1 > qlo) mask_tile(p0, p1, qm - kb_); } \
                softmax_tile(p0, p1, m_reg, l_reg, al, pa0, pa1, pa2, pa3); \
                if (__any(al < 1.f)) { if (hi == 0) al_l[r32] = al; asm volatile("s_waitcnt lgkmcnt(0)" ::: "memory"); \
                    _Pragma("unroll") for (int d_ = 0; d_ < 4; ++d_) _Pragma("unroll") for (int r = 0; r < 16; ++r) o[d_][r] *= al_l[crow(r, hi)]; } \
                SBAR(); pv_tile(o, vrb + vb * SHM_V, pa0, pa1, pa2, pa3); SBAR(); } \
            if (!grpB) { if (v1) { VMW(); SWRITE(kb1, vb1); } __syncthreads(); } \
            kb = kb1; vb = vb1; } while (0)
        const int NTa = 4 * qb + (wid >> 1) + 1;
        const int n0 = desc ? NT - NTa : 0, n1 = n0 + NTa;
        int n = 0;
        for (; n < n0; ++n) STEP(0);
        for (; n < n1; ++n) STEP(1);
        for (; n < NT; ++n) STEP(0);
#undef STEP
        {
            if (hi == 0) li_l[r32] = l_reg; asm volatile("s_waitcnt lgkmcnt(0)" ::: "memory");
            bf16_t* Ow = Oall + ((size_t)(bh >> 4) * SEQ + (size_t)qb * QB) * LDO + (bh & 15) * 128; unsigned ooff = (unsigned)((wid * QBLK + 4 * hi) * LDO + r32); asm volatile("" : "+v"(ooff));
#pragma unroll
            for (int r = 0; r < 16; ++r) { const int orow = (r & 3) + 8 * (r >> 2); const float rl = __builtin_amdgcn_rcpf(li_l[crow(r, hi)]);
#pragma unroll
                for (int d0 = 0; d0 < 4; ++d0) { const float v = o[d0][r] * rl; const float vn = __shfl_xor(v, 1);
                    if ((r32 & 1) == 0) *(unsigned*)(Ow + orow * LDO + d0 * 32 + ooff) = cvt_pk_bf16(v, vn); } }
            if (more) {
                const int bhn = BLK_BH(i + 1); const bf16_t* Qn = Qall + ((size_t)(bhn >> 4) * SEQ + (size_t)BLK_QB(i + 1) * QB) * LDQ + (bhn & 15) * 192;
#pragma unroll
                for (int d0 = 0; d0 < NQR; ++d0) qr[d0] = ldg8(Qn + d0 * 16, qoff);
#pragma unroll
                for (int d0 = NQR; d0 < 12; ++d0) *(bf16x8*)(qs + (d0 - NQR) * 1024) = ldg8(Qn + d0 * 16, qoff);
#pragma unroll
                for (int d0 = 0; d0 < NQR; ++d0) asm volatile("" : "+v"(qr[d0])); } }
    }
    __builtin_amdgcn_s_setprio(0);
    asm volatile("s_waitcnt vmcnt(0)" ::: "memory"); __syncthreads();
}
#undef BLK_BH
#undef BLK_QB
#undef TILEPTR
#undef VMW
#undef SLOAD
#undef SWRITE
#undef SBAR
}

constexpr size_t MiB = 1u << 20;
constexpr size_t WS_BAR = 7 * MiB, WS_RSTD0 = 0, WS_SSQ = 1 * MiB, WS_SSKV = 2 * MiB, WS_SS = 3 * MiB, WS_CS = 8 * MiB;
constexpr size_t WS_WPOOL = 16 * MiB, WS_WA = 18 * MiB, WS_WQB = 23 * MiB, WS_WKVB = 26 * MiB, WS_WO = 30 * MiB;
constexpr size_t WS_WGU0 = 38 * MiB, WS_WDN0 = 82 * MiB, WS_WGU1 = 104 * MiB, WS_WDN1 = 148 * MiB;
constexpr size_t WS_B0 = 170 * MiB, WS_B1 = 298 * MiB, WS_QA = 426 * MiB, WS_KVA = 458 * MiB;
constexpr size_t WS_Q = 490 * MiB, WS_K = 682 * MiB, WS_V = 874 * MiB, WS_MID = 490 * MiB, WS_END = 1002 * MiB;
constexpr int LDS_BYTES = 155648;
static_assert(att::LDS_TOTAL <= LDS_BYTES && pg8::STAGE_BYTES <= LDS_BYTES, "LDS map");

#define XB_TMO      128
#define XB_XCNT(j)  (256  + 64 * (j))
#define XB_XSUB(j)  (1280 + 64 * (j))
#define XB_XGEN(j)  (2304 + 64 * (j))
#define XB_TOP      3328
#define XB_TOPGEN   3392
#define XCD_BAR_WORDS 3456
#define XB_SPIN_CAP (1u << 18)
__device__ __forceinline__ unsigned xb_ld(unsigned* p)              { return __hip_atomic_load(p, __ATOMIC_RELAXED, __HIP_MEMORY_SCOPE_AGENT); }
__device__ __forceinline__ unsigned xb_add(unsigned* p, unsigned v) { return __hip_atomic_fetch_add(p, v, __ATOMIC_RELAXED, __HIP_MEMORY_SCOPE_AGENT); }
__device__ __forceinline__ unsigned xb_xcc_id() { return (unsigned)__builtin_amdgcn_s_getreg((3 << 11) | 20) & 0xFu; }
#define XB_SPIN(cond, bar) do { unsigned _sp = 0; while (cond) { __builtin_amdgcn_s_sleep(1); \
    if ((++_sp & 255u) == 0u) { if (xb_ld(&(bar)[XB_TMO])) break; if (_sp > XB_SPIN_CAP) { atomicAdd(&(bar)[XB_TMO], 1u); break; } } } } while (0)
struct XcdBarrier { unsigned* bar; unsigned x; volatile LAS unsigned* st; };
__device__ __forceinline__ XcdBarrier xcd_barrier_post(unsigned* bar, volatile LAS unsigned* st) {
    XcdBarrier b; b.bar = bar; b.x = xb_xcc_id(); b.st = st;
    if (threadIdx.x == 0) (void)xb_add(&bar[XB_XCNT(b.x)], 1u);
    return b;
}
__device__ __forceinline__ void xcd_barrier_complete(unsigned* bar, unsigned x, unsigned& nloc, unsigned& nx) {
    const unsigned G = gridDim.x * gridDim.y * gridDim.z;
    unsigned sum, cnt, mine, sp = 0u;
    for (;;) {
        sum = 0u; cnt = 0u; mine = 0u;
#pragma unroll
        for (unsigned j = 0; j < 16; ++j) { const unsigned c = xb_ld(&bar[XB_XCNT(j)]); sum += c; cnt += (c > 0u) ? 1u : 0u; mine = (j == x) ? c : mine; }
        if (sum == G) break;
        __builtin_amdgcn_s_sleep(1);
        if ((++sp & 255u) == 0u) { if (xb_ld(&bar[XB_TMO])) break; if (sp > XB_SPIN_CAP) { atomicAdd(&bar[XB_TMO], 1u); break; } }
    }
    nloc = mine > 0u ? mine : 1u; nx = cnt > 0u ? cnt : 1u;
}
__device__ __forceinline__ void xcd_barrier(const XcdBarrier& b) {
    asm volatile("s_waitcnt vmcnt(0)" ::: "memory");
    __syncthreads();
    if (threadIdx.x == 0) {
        unsigned* bar = b.bar;
        __builtin_amdgcn_s_waitcnt(0);
        unsigned nloc = b.st[0], nx = b.st[1];
        if (nloc == 0u) { xcd_barrier_complete(bar, b.x, nloc, nx); b.st[0] = nloc; b.st[1] = nx; }
        const unsigned old = xb_add(&bar[XB_XSUB(b.x)], 1u);
        const unsigned gen = old / nloc;
        if (old + 1u == (gen + 1u) * nloc) {
            __builtin_amdgcn_fence(__ATOMIC_RELEASE, "agent");
            asm volatile("s_waitcnt vmcnt(0)" ::: "memory");
            const unsigned og = xb_add(&bar[XB_TOP], 1u);
            const unsigned tg = og / nx;
            if (og + 1u == (tg + 1u) * nx) xb_add(&bar[XB_TOPGEN], 1u);
            else XB_SPIN(xb_ld(&bar[XB_TOPGEN]) == tg, bar);
            __builtin_amdgcn_fence(__ATOMIC_ACQUIRE, "agent");
            xb_add(&bar[XB_XGEN(b.x)], 1u);
            asm volatile("s_waitcnt vmcnt(0)" ::: "memory");
        } else {
            XB_SPIN(xb_ld(&bar[XB_XGEN(b.x)]) == gen, bar);
            __builtin_amdgcn_fence(__ATOMIC_ACQUIRE, "agent");
            asm volatile("s_waitcnt vmcnt(0)" ::: "memory");
        }
    }
    __syncthreads();
}

#ifndef PH_MASK
#define PH_MASK 0xFFF
#endif
#define PH_ON(k) (((PH_MASK) >> (k)) & 1)
struct Args { const float* in[19]; float* out; unsigned char* ws; int ph_lo, ph_hi; };

__device__ __forceinline__ float wave_sum(float v) {
#pragma unroll
    for (int o = 1; o < 64; o <<= 1) v += __shfl_xor(v, o);
    return v;
}
__device__ __forceinline__ int map_row(int mode, int n) {
    switch (mode) {
        case 1: return (n >> 7) * 256 + (n & 127);
        case 2: return (n >> 7) * 256 + 128 + (n & 127);
        case 3: { if (n < 512) return 512 + n; const int j = n - 512; return 1024 + 2 * (j & 31) + (j >> 5); }
        case 4: { const int h = n / 192, d = n % 192; if (d < 128) return h * 128 + d; const int j = d - 128; return 2048 + h * 64 + 2 * (j & 31) + (j >> 5); }
        case 5: { const int h = n >> 8, d = n & 255; return d < 128 ? h * 128 + d : 2048 + h * 128 + (d - 128); }
        default: return n;
    }
}
__device__ __forceinline__ void transpose_item(const float* W, int K, int N, bf16_t* WT, int mode, const float* ks, const float* cs, LAS float* scr, int item, int lane) {
    const int nblk = N / 64, kb = item / nblk, nb = item % nblk, k0 = 64 * kb, n0 = 64 * nb;
    const int lr = lane >> 4, lc = (lane & 15) * 4;
    f32x4 v[16];
#pragma unroll
    for (int i = 0; i < 16; ++i) v[i] = *(const f32x4*)(W + (size_t)(k0 + 4 * i + lr) * N + n0 + lc);
#pragma unroll
    for (int i = 0; i < 16; ++i) { const int kk = 4 * i + lr; f32x4 t = v[i]; if (ks) t = t * ks[k0 + kk]; LAS float* d = scr + kk * 65 + lc; d[0] = t[0]; d[1] = t[1]; d[2] = t[2]; d[3] = t[3]; }
    asm volatile("s_waitcnt lgkmcnt(0)" ::: "memory");
    const int c = lane & 7;
#pragma unroll
    for (int j = 0; j < 8; ++j) { const int n = (lane >> 3) + 8 * j; const LAS float* s = scr + (8 * c) * 65 + n; const float csn = cs ? cs[n0 + n] : 1.f;
        u32x4 o; o.x = cvt_pk_bf16(s[0 * 65] * csn, s[1 * 65] * csn); o.y = cvt_pk_bf16(s[2 * 65] * csn, s[3 * 65] * csn); o.z = cvt_pk_bf16(s[4 * 65] * csn, s[5 * 65] * csn); o.w = cvt_pk_bf16(s[6 * 65] * csn, s[7 * 65] * csn);
        *(u32x4*)(WT + (size_t)map_row(mode, n0 + n) * K + k0 + 8 * c) = o; }
    asm volatile("s_waitcnt lgkmcnt(0)" ::: "memory");
}

__global__ void __launch_bounds__(512, 2) yoco_fwd(Args a) {
    extern __shared__ __attribute__((aligned(16))) unsigned char lds[];
    cg::grid_group grid = cg::this_grid();
    const int tid = threadIdx.x, lane = tid & 63, wave = __builtin_amdgcn_readfirstlane(tid >> 6);
    const int G = gridDim.x, bx = blockIdx.x, vcu = (G % 8 == 0) ? (bx % 8) * (G / 8) + bx / 8 : bx;
    const int gw = vcu * 8 + wave, NGW = G * 8;
    unsigned char* ws = a.ws;
    const float* x = a.in[0]; const int* positions = (const int*)a.in[1];
    float* out = a.out;
    float* rstd0 = (float*)(ws + WS_RSTD0); float* ssq = (float*)(ws + WS_SSQ); float* sskv = (float*)(ws + WS_SSKV); float* ss = (float*)(ws + WS_SS); float* cs = (float*)(ws + WS_CS);
    bf16_t* Wpool = (bf16_t*)(ws + WS_WPOOL); bf16_t* Wa = (bf16_t*)(ws + WS_WA); bf16_t* Wqb = (bf16_t*)(ws + WS_WQB); bf16_t* Wkvb = (bf16_t*)(ws + WS_WKVB); bf16_t* Wo = (bf16_t*)(ws + WS_WO);
    bf16_t* B0 = (bf16_t*)(ws + WS_B0); bf16_t* B1 = (bf16_t*)(ws + WS_B1); bf16_t* QA = (bf16_t*)(ws + WS_QA); bf16_t* KVA = (bf16_t*)(ws + WS_KVA);
    bf16_t* Qb = (bf16_t*)(ws + WS_Q); bf16_t* Kb = (bf16_t*)(ws + WS_K); bf16_t* Vb = (bf16_t*)(ws + WS_V); bf16_t* MID = (bf16_t*)(ws + WS_MID);
    LAS unsigned char* ldsl = (LAS unsigned char*)lds;
    const int lo = a.ph_lo, hi = a.ph_hi;
    volatile LAS unsigned* bst = (volatile LAS unsigned*)(ldsl + LDS_BYTES - 64);
    if (tid == 0) { bst[0] = 0u; bst[1] = 0u; }
    __syncthreads();
    XcdBarrier xbar = xcd_barrier_post((unsigned*)(ws + WS_BAR), bst);
#define IN(k) (lo <= (k) && (k) < hi)
#define SEAM(k) do { if (IN(k) && IN((k) + 1)) { if ((k) == 1) grid.sync(); else xcd_barrier(xbar); } } while (0)

    if (PH_ON(0) && IN(0)) {
        LAS float* scr = (LAS float*)(ldsl + wave * 16640);
        constexpr int I_POOL = 8 * 8, I_GU = 32 * 88, I_DN = 88 * 32, I_QA = 32 * 8, I_KVA = 32 * 9, I_QB = 8 * 48, I_KVB = 8 * 64, I_WO = 32 * 32;
        constexpr int NITEMS = 4 * I_POOL + 2 * (2 * I_GU + I_DN) + I_QA + I_KVA + I_QB + I_KVB + I_WO;
        for (int it = gw; it < NITEMS; it += NGW) {
            int r = it;
#define JOB(cnt, W_, K_, N_, dst_, mode_, ks_, cs_) if (r < (cnt)) { transpose_item(W_, K_, N_, dst_, mode_, ks_, cs_, scr, r, lane); continue; } r -= (cnt);
            JOB(I_POOL, a.in[3] + 0 * 262144, 512, 512, Wpool + 0 * 262144, 0, a.in[2] + 0, a.in[4] + 0)
            JOB(I_POOL, a.in[3] + 1 * 262144, 512, 512, Wpool + 1 * 262144, 0, a.in[2] + 512, a.in[4] + 512)
            JOB(I_POOL, a.in[3] + 2 * 262144, 512, 512, Wpool + 2 * 262144, 0, a.in[2] + 1024, a.in[4] + 1024)
            JOB(I_POOL, a.in[3] + 3 * 262144, 512, 512, Wpool + 3 * 262144, 0, a.in[2] + 1536, a.in[4] + 1536)
            JOB(I_GU, a.in[15], DM, DFF, (bf16_t*)(ws + WS_WGU0), 1, a.in[14], nullptr)
            JOB(I_GU, a.in[16], DM, DFF, (bf16_t*)(ws + WS_WGU0), 2, a.in[14], nullptr)
            JOB(I_DN, a.in[17], DFF, DM, (bf16_t*)(ws + WS_WDN0), 0, nullptr, nullptr)
            JOB(I_GU, a.in[15] + (size_t)DM * DFF, DM, DFF, (bf16_t*)(ws + WS_WGU1), 1, a.in[14] + DM, nullptr)
            JOB(I_GU, a.in[16] + (size_t)DM * DFF, DM, DFF, (bf16_t*)(ws + WS_WGU1), 2, a.in[14] + DM, nullptr)
            JOB(I_DN, a.in[17] + (size_t)DM * DFF, DFF, DM, (bf16_t*)(ws + WS_WDN1), 0, nullptr, nullptr)
            JOB(I_QA, a.in[10], DM, 512, Wa, 0, a.in[9], nullptr)
            JOB(I_KVA, a.in[6], DM, 576, Wa, 3, a.in[5], nullptr)
            JOB(I_QB, a.in[12], 512, 3072, Wqb, 4, a.in[11], nullptr)
            JOB(I_KVB, a.in[8], 512, 4096, Wkvb, 5, a.in[7], nullptr)
            JOB(I_WO, a.in[13], DM, DM, Wo, 0, nullptr, nullptr)
#undef JOB
        }
        for (int m = gw * 2 + (lane >> 5); m < T; m += NGW * 2) {
            const int i = lane & 31;
            const float invf = (float)exp2(-(double)i * (13.287712379549449 / 32.0));
            const float ang = (float)positions[m] * invf;
            double rev = (double)ang * 0.15915494309189535; rev -= rint(rev);
            const float rf = (float)rev;
            *(f32x2*)(cs + ((size_t)m * 32 + i) * 2) = (f32x2){__builtin_amdgcn_cosf(rf), __builtin_amdgcn_sinf(rf)};
        }
    }
    if (PH_ON(1) && IN(1)) {
        LAS float* rs_l = (LAS float*)(ldsl + 140000);
        for (int chunk = vcu; chunk < T / 64; chunk += G) {
            const int t0 = chunk * 64, tin0 = t0 & (SEQ - 1), nh = tin0 ? 15 : 0;
            for (int r = wave; r < 64 + nh; r += 8) { const int row = t0 - nh + r;
                const f32x4* xr = (const f32x4*)(x + (size_t)row * DM) + lane; float sq = 0.f;
#pragma unroll
                for (int j = 0; j < 8; ++j) sq += sq4(xr[64 * j]);
                sq = wave_sum(sq);
                if (lane == 0) rs_l[r + 15 - nh] = __builtin_amdgcn_rsqf(sq * (1.f / DM) + EPS); }
            __syncthreads();
            { const int slab = wave, c0 = slab * 256 + lane * 4, w = 2 << (slab >> 1);
              const float* xc = x + c0; f32x4 s = {0.f, 0.f, 0.f, 0.f};
              for (int j = 1; j < w; ++j) if (tin0 - j >= 0) s += *(const f32x4*)(xc + (size_t)(t0 - j) * DM) * rs_l[15 - j];
#pragma unroll 4
              for (int i = 0; i < 64; ++i) { const int t = t0 + i, tin = tin0 + i;
                  const f32x4 h = *(const f32x4*)(xc + (size_t)t * DM) * rs_l[15 + i]; s += h;
                  const int cnt = tin + 1 < w ? tin + 1 : w; const f32x4 d = s * (1.f / (float)cnt) - h;
                  u32x2 o; o.x = cvt_pk_bf16(d[0], d[1]); o.y = cvt_pk_bf16(d[2], d[3]); *(u32x2*)(B0 + (size_t)t * DM + c0) = o;
                  if (tin - w + 1 >= 0) s -= *(const f32x4*)(xc + (size_t)(t - w + 1) * DM) * rs_l[15 + i - w + 1]; } }
            __syncthreads();
        }
    }
    SEAM(1);
    if (PH_ON(2) && IN(2)) {
        pg8::Gemm g{B0, Wpool, DM, 512, 512, 512, 262144}; pg8::Order S; S.init(T, 512, 4, G, bx);
        pg8::EpiResid E{x, nullptr, B1, ss, 512};
        pg8::gemm_phase(ldsl, g, S, E);
    }
    SEAM(2);
    if (PH_ON(3) && IN(3)) {
        pg8::Gemm g{B1, (const bf16_t*)(ws + WS_WGU0), DM, DM, DM, 0, 0}; pg8::Order S; S.init(T, 2 * DFF, 1, G, bx);
        pg8::EpiSwiGLU E{MID, ss};
#ifndef REP3
#define REP3 1
#endif
        for (int rep3 = 0; rep3 < REP3; ++rep3) pg8::gemm_phase(ldsl, g, S, E);
    }
    SEAM(3);
    if (PH_ON(4) && IN(4)) {
        pg8::Gemm g{MID, (const bf16_t*)(ws + WS_WDN0), DFF, DFF, DFF, 0, 0}; pg8::Order S; S.init(T, DM, 1, G, bx);
        pg8::EpiResid E{nullptr, B1, B0, ss, 0};
        pg8::gemm_phase(ldsl, g, S, E);
    }
    SEAM(4);
    if (PH_ON(5) && IN(5)) {
        pg8::Gemm g{B0, Wa, DM, DM, DM, 0, 0}; pg8::Order S; S.init(T, 1280, 1, G, bx);
        pg8::EpiA E{ss, QA, KVA, ssq, sskv, Kb, cs};
        pg8::gemm_phase(ldsl, g, S, E);
    }
    SEAM(5);
    if (PH_ON(6) && IN(6)) {
        { pg8::Gemm g{QA, Wqb, 512, 512, 512, 0, 0}; pg8::Order S; S.init(T, 3072, 1, G, bx);
          pg8::EpiQ E{ssq, Qb, cs}; pg8::gemm_phase(ldsl, g, S, E); }
        { pg8::Gemm g{KVA, Wkvb, 512, 512, 512, 0, 0}; pg8::Order S; S.init(T, 4096, 1, G, bx);
          pg8::EpiKV E{sskv, Kb, Vb}; pg8::gemm_phase(ldsl, g, S, E); }
    }
    SEAM(6);
    if (PH_ON(7) && IN(7)) {
#ifndef REP7
#define REP7 1
#endif
        for (int rep7 = 0; rep7 < REP7; ++rep7)
        for (int sid = vcu; sid < 256; sid += G) att::attn_stream(Qb, Kb, Vb, B1, sid, (char*)lds);
    }
    SEAM(7);
    if (PH_ON(8) && IN(8)) {
        pg8::Gemm g{B1, Wo, DM, DM, DM, 0, 0}; pg8::Order S; S.init(T, DM, 1, G, bx);
        pg8::EpiResid E{nullptr, B0, B0, ss, 0};
        pg8::gemm_phase(ldsl, g, S, E);
    }
    SEAM(8);
    if (PH_ON(9) && IN(9)) {
        pg8::Gemm g{B0, (const bf16_t*)(ws + WS_WGU1), DM, DM, DM, 0, 0}; pg8::Order S; S.init(T, 2 * DFF, 1, G, bx);
        pg8::EpiSwiGLU E{MID, ss};
        pg8::gemm_phase(ldsl, g, S, E);
    }
    SEAM(9);
    if (PH_ON(10) && IN(10)) {
        pg8::Gemm g{MID, (const bf16_t*)(ws + WS_WDN1), DFF, DFF, DFF, 0, 0}; pg8::Order S; S.init(T, DM, 1, G, bx);
        pg8::EpiResid E{nullptr, B0, B0, ss, 0};
        pg8::gemm_phase(ldsl, g, S, E);
    }
    SEAM(10);
    if (PH_ON(11) && IN(11)) {
        const float* fg = a.in[18];
        for (int m = gw; m < T; m += NGW) {
            float s = lane < 32 ? ss[(size_t)m * 32 + lane] : 0.f; s = wave_sum(s);
            const float r = __builtin_amdgcn_rsqf(s * (1.f / DM) + EPS);
            const u32x4* xr = (const u32x4*)(B0 + (size_t)m * DM) + lane; f32x4* orow = (f32x4*)(out + (size_t)m * DM) + 2 * lane; const f32x4* gr = (const f32x4*)fg + 2 * lane;
#pragma unroll
            for (int j = 0; j < 4; ++j) { const u32x4 w = xr[64 * j];
                const f32x4 v0 = {__uint_as_float(w.x << 16), __uint_as_float(w.x & 0xffff0000u), __uint_as_float(w.y << 16), __uint_as_float(w.y & 0xffff0000u)};
                const f32x4 v1 = {__uint_as_float(w.z << 16), __uint_as_float(w.z & 0xffff0000u), __uint_as_float(w.w << 16), __uint_as_float(w.w & 0xffff0000u)};
                orow[128 * j] = v0 * r * gr[128 * j]; orow[128 * j + 1] = v1 * r * gr[128 * j + 1]; }
        }
    }
#undef IN
#undef SEAM
}

extern "C" void kernel_launch(void* const* d_in, const int* in_sizes, int n_in, void* d_out, int out_size, void* d_ws, size_t ws_size, hipStream_t stream) {
    static int grid = 0;
    if (grid == 0) {
        if (n_in != 19 || in_sizes[0] != T * DM || out_size != T * DM || ws_size < WS_END) { fprintf(stderr, "kernel_launch: shape/workspace mismatch (n_in %d, in0 %d, out %d, ws %zu < %zu)\n", n_in, n_in > 0 ? in_sizes[0] : -1, out_size, ws_size, (size_t)WS_END); grid = -1; return; }
        int dev = 0, cus = 0, per_cu = 0;
        (void)hipGetDevice(&dev); (void)hipDeviceGetAttribute(&cus, hipDeviceAttributeMultiprocessorCount, dev);
        if (hipFuncSetAttribute((const void*)yoco_fwd, hipFuncAttributeMaxDynamicSharedMemorySize, LDS_BYTES) != hipSuccess) { fprintf(stderr, "kernel_launch: hipFuncSetAttribute failed\n"); grid = -1; return; }
        if (hipOccupancyMaxActiveBlocksPerMultiprocessor(&per_cu, (const void*)yoco_fwd, 512, LDS_BYTES) != hipSuccess || per_cu < 1) { fprintf(stderr, "kernel_launch: occupancy query says %d\n", per_cu); per_cu = 1; }
        (void)hipGetLastError();
        grid = cus * per_cu;
        if (grid <= 0) grid = 256;
    }
    if (grid < 0) return;
    if (hipMemsetAsync((char*)d_ws + WS_BAR, 0, XCD_BAR_WORDS * 4, stream) != hipSuccess) { fprintf(stderr, "kernel_launch: memset of the barrier words failed\n"); return; }
    Args a{};
    for (int i = 0; i < 19; ++i) a.in[i] = (const float*)d_in[i];
    a.out = (float*)d_out; a.ws = (unsigned char*)d_ws; a.ph_lo = 0; a.ph_hi = 12;
    void* args[] = {&a};
    hipError_t e = hipLaunchCooperativeKernel((const void*)yoco_fwd, dim3(grid), dim3(512), args, LDS_BYTES, stream);
    if (e != hipSuccess) fprintf(stderr, "cooperative launch failed: %s (grid %d)\n", hipGetErrorString(e), grid);
}
```

```cpp
#include <hip/hip_runtime.h>
#include <hip/hip_cooperative_groups.h>
#include <cstdio>
#include <cstdint>
namespace cg = cooperative_groups;

#define LAS __attribute__((address_space(3)))
typedef unsigned short bf16_t;
typedef short bf16x8 __attribute__((ext_vector_type(8)));
typedef short s16x4 __attribute__((ext_vector_type(4)));
typedef float f32x2 __attribute__((ext_vector_type(2)));
typedef float f32x4 __attribute__((ext_vector_type(4)));
typedef float f32x16 __attribute__((ext_vector_type(16)));
typedef unsigned u32x2 __attribute__((ext_vector_type(2)));
typedef unsigned u32x4 __attribute__((ext_vector_type(4)));

constexpr int DM = 2048, NB = 4, SEQ = 8192, T = NB * SEQ, DFF = 5632, NH = 16;
constexpr float EPS = 1e-6f;
constexpr float C2Q = 0.07216878364870322f * 1.4426950408889634f;

__device__ __forceinline__ unsigned cvt_pk_bf16(float lo, float hi) { unsigned r; asm volatile("v_cvt_pk_bf16_f32 %0, %1, %2" : "=v"(r) : "v"(lo), "v"(hi)); return r; }
__device__ __forceinline__ u32x4 pack8(f32x4 a, f32x4 b) { u32x4 w; w.x = cvt_pk_bf16(a[0], a[1]); w.y = cvt_pk_bf16(a[2], a[3]); w.z = cvt_pk_bf16(b[0], b[1]); w.w = cvt_pk_bf16(b[2], b[3]); return w; }
__device__ __forceinline__ float sq4(f32x4 v) { return (v[0] * v[0] + v[1] * v[1]) + (v[2] * v[2] + v[3] * v[3]); }

namespace pg8 {
constexpr int BM = 256, BK = 64, HALF = 128, HTB = HALF * BK * 2, STAGE_BYTES = 8 * HTB, NXCD = 8, WGM = 8;
__host__ __device__ __forceinline__ int lds_byte(int r, int c) { const int st = (r >> 4) * 2 + (c >> 5), rr = r & 15, cc = c & 31, ob = rr * 64 + cc * 2; return st * 1024 + (ob ^ (((ob >> 9) & 1) << 5)); }
__host__ __device__ __forceinline__ void stage_rc(int b, int& R, int& C) { const int st = b / 1024, sb = b % 1024, swz = sb ^ (((sb >> 9) & 1) << 5); R = (st >> 1) * 16 + swz / 64; C = (st & 1) * 32 + (swz % 64) / 2; }
__host__ __device__ __forceinline__ int perm32(int rho) { const int n = rho >> 4, i = rho & 15; return 8 * (i >> 2) + 4 * n + (i & 3); }

struct Unit { int pm, pn, grp; };
struct Gemm { const bf16_t* A; const bf16_t* Bt; int lda, ldb, K; long grpA, grpB; };

struct Order {
    int nM, nN, nwg, nG, G, c;
    __device__ void init(int M, int N, int nG_, int G_, int c_) { nM = M / BM; nN = N / BM; nwg = nM * nN; nG = nG_; G = G_; c = c_; }
    __device__ bool next(int i, Unit& u) const {
        const long L = (long)i * G + c; if (L >= (long)nwg * nG) return false;
        u.grp = (int)(L / nwg); int wgid = (int)(L % nwg);
        { const int q = nwg / NXCD, r = nwg % NXCD, xcd = wgid % NXCD, off = wgid / NXCD; wgid = (xcd < r ? xcd * (q + 1) : r * (q + 1) + (xcd - r) * q) + off; }
        const int nig = WGM * nN, gid = wgid / nig, fm = gid * WGM, gsz = (nM - fm) < WGM ? (nM - fm) : WGM;
        u.pm = fm + ((wgid % nig) % gsz); u.pn = (wgid % nig) / gsz; return true;
    }
};

template <class Epi>
__device__ __forceinline__ void gemm_phase(LAS unsigned char* lds, const Gemm g, const Order& S, const Epi& E) {
    const int tid = threadIdx.x, wid = __builtin_amdgcn_readfirstlane(tid >> 6), lane = tid & 63, wr = wid >> 2, wc = wid & 3, fr = lane & 15, fq = lane >> 4;
    const int K = g.K, nt = K / BK;
    unsigned voffA[2], voffB[2];
#pragma unroll
    for (int i = 0; i < 2; ++i) { int R, C; stage_rc(tid * 16 + i * 8192, R, C); const int Rb = (R & ~31) + perm32(R & 31);
        voffA[i] = (unsigned)(R * g.lda + C) * 2u; voffB[i] = (unsigned)(Rb * g.ldb + C) * 2u; }
    const size_t kstep = (size_t)(BK * 2);
    const size_t hstepA = (size_t)HALF * g.lda * 2, hstepB = (size_t)HALF * g.ldb * 2;
    const size_t tstepA = 2 * hstepA, tstepB = 2 * hstepB;
    const unsigned ldsw = (unsigned)wid * 1024u;
    const int aoff = lds_byte(wr * 64 + fr, fq * 8), boff = lds_byte(wc * 32 + fr, fq * 8);
#define PG8_SA(b, h) (((b) * 2 + (h)) * HTB)
#define PG8_SB(b, h) ((4 + (b) * 2 + (h)) * HTB)
#define PG8_STAGE(bufoff, gbase, voff) do { _Pragma("unroll") for (int _i = 0; _i < 2; ++_i) \
        __builtin_amdgcn_global_load_lds((const unsigned*)((const char*)(gbase) + (voff)[_i]), (LAS unsigned*)(lds + (bufoff) + ldsw + _i * 8192), 16, 0, 0); } while (0)
#define PG8_LDA(dst, b, h) do { _Pragma("unroll") for (int m = 0; m < 4; ++m) _Pragma("unroll") for (int k = 0; k < 2; ++k) dst[m][k] = *(const LAS bf16x8*)(lds + PG8_SA(b, h) + aoff + m * 2048 + k * 1024); } while (0)
#define PG8_LDB(dst, b, h) do { _Pragma("unroll") for (int n = 0; n < 2; ++n) _Pragma("unroll") for (int k = 0; k < 2; ++k) dst[n][k] = *(const LAS bf16x8*)(lds + PG8_SB(b, h) + boff + n * 2048 + k * 1024); } while (0)
#define PG8_MMA(ai, bj, At, Bt) do { __builtin_amdgcn_s_setprio(1); _Pragma("unroll") for (int m = 0; m < 4; ++m) _Pragma("unroll") for (int n = 0; n < 2; ++n) _Pragma("unroll") for (int k = 0; k < 2; ++k) \
        acc[ai][bj][m][n] = __builtin_amdgcn_mfma_f32_16x16x32_bf16(Bt[n][k], At[m][k], acc[ai][bj][m][n], 0, 0, 0); __builtin_amdgcn_s_setprio(0); } while (0)
#define PG8_WAIT_V(n) asm volatile("s_waitcnt vmcnt(" #n ")" ::: "memory")
#define PG8_WAIT_L(n) asm volatile("s_waitcnt lgkmcnt(" #n ")" ::: "memory")
#define PG8_BAR __builtin_amdgcn_s_barrier()
#define PG8_SCHED __builtin_amdgcn_sched_barrier(0)
    Unit cur, nxt; int ui = 0;
    if (!S.next(0, cur)) return;
    f32x4 acc[2][2][4][2];
#pragma unroll
    for (int a = 0; a < 2; ++a)
#pragma unroll
        for (int b = 0; b < 2; ++b)
#pragma unroll
            for (int m = 0; m < 4; ++m)
#pragma unroll
                for (int n = 0; n < 2; ++n) acc[a][b][m][n] = (f32x4){0.f, 0.f, 0.f, 0.f};
    bf16x8 At[4][2], B0[2][2], B1[2][2];
    const char* cA = (const char*)(g.A + (size_t)cur.grp * g.grpA) + (size_t)cur.pm * tstepA;
    const char* cB = (const char*)(g.Bt + (size_t)cur.grp * g.grpB) + (size_t)cur.pn * tstepB;
    PG8_STAGE(PG8_SB(0, 0), cB, voffB); PG8_STAGE(PG8_SB(0, 1), cB + hstepB, voffB); PG8_STAGE(PG8_SA(0, 0), cA, voffA); PG8_STAGE(PG8_SA(0, 1), cA + hstepA, voffA);
    if (wr == 1) PG8_BAR;
    PG8_WAIT_V(2); PG8_BAR;
    PG8_STAGE(PG8_SB(1, 0), cB + kstep, voffB); PG8_STAGE(PG8_SA(1, 0), cA + kstep, voffA); PG8_STAGE(PG8_SB(1, 1), cB + hstepB + kstep, voffB);
    PG8_WAIT_V(6); PG8_BAR;
    for (;;) {
        const bool has_next = S.next(ui + 1, nxt);
        const char* nA = has_next ? (const char*)(g.A + (size_t)nxt.grp * g.grpA) + (size_t)nxt.pm * tstepA : cA;
        const char* nB = has_next ? (const char*)(g.Bt + (size_t)nxt.grp * g.grpB) + (size_t)nxt.pn * tstepB : cB;
        for (int t = 0; t < nt; t += 2) {
            const bool last = (t == nt - 2);
            const char* a1 = cA + (size_t)(t + 1) * kstep;
            const char* a2 = last ? nA : cA + (size_t)(t + 2) * kstep; const char* b2 = last ? nB : cB + (size_t)(t + 2) * kstep;
            const char* a3 = a2 + kstep; const char* b3 = b2 + kstep;
            PG8_LDB(B0, 0, 0); PG8_LDB(B1, 0, 1); PG8_SCHED; PG8_LDA(At, 0, 0); PG8_STAGE(PG8_SA(1, 1), a1 + hstepA, voffA);
            PG8_WAIT_V(8); PG8_WAIT_L(0); PG8_BAR; PG8_MMA(0, 0, At, B0); PG8_MMA(0, 1, At, B1); PG8_BAR; PG8_SCHED;
            PG8_LDA(At, 0, 1); PG8_STAGE(PG8_SB(0, 0), b2, voffB); PG8_STAGE(PG8_SB(0, 1), b2 + hstepB, voffB); PG8_STAGE(PG8_SA(0, 0), a2, voffA);
            PG8_WAIT_V(8); PG8_WAIT_L(0); PG8_BAR; PG8_MMA(1, 0, At, B0); PG8_MMA(1, 1, At, B1); PG8_BAR; PG8_SCHED;
            PG8_LDB(B0, 1, 0); PG8_LDB(B1, 1, 1); PG8_SCHED; PG8_LDA(At, 1, 0); PG8_STAGE(PG8_SA(0, 1), a2 + hstepA, voffA);
            PG8_WAIT_V(8); PG8_WAIT_L(0); PG8_BAR; PG8_MMA(0, 0, At, B0); PG8_MMA(0, 1, At, B1); PG8_BAR; PG8_SCHED;
            PG8_LDA(At, 1, 1); PG8_STAGE(PG8_SB(1, 0), b3, voffB); PG8_STAGE(PG8_SB(1, 1), b3 + hstepB, voffB); PG8_STAGE(PG8_SA(1, 0), a3, voffA);
            PG8_WAIT_V(8); PG8_WAIT_L(0); PG8_BAR; PG8_MMA(1, 0, At, B0); PG8_MMA(1, 1, At, B1); PG8_BAR; PG8_SCHED;
        }
        if (wr == 0) PG8_BAR;
        E(acc, cur, wr, wc, fr, fq);
        if (!has_next) break;
#pragma unroll
        for (int a = 0; a < 2; ++a)
#pragma unroll
            for (int b = 0; b < 2; ++b)
#pragma unroll
                for (int m = 0; m < 4; ++m)
#pragma unroll
                    for (int n = 0; n < 2; ++n) acc[a][b][m][n] = (f32x4){0.f, 0.f, 0.f, 0.f};
        cur = nxt; cA = nA; cB = nB; ++ui;
        if (wr == 1) PG8_BAR;
    }
    PG8_WAIT_V(0);
    PG8_BAR;
#undef PG8_SA
#undef PG8_SB
#undef PG8_STAGE
#undef PG8_LDA
#undef PG8_LDB
#undef PG8_MMA
#undef PG8_WAIT_V
#undef PG8_WAIT_L
#undef PG8_BAR
#undef PG8_SCHED
}

template <int NP> __device__ __forceinline__ float row_rstd(const float* ss, int row, int fq, float invn) {
    const float* p = ss + (size_t)row * NP + fq * (NP / 4); float s;
    if constexpr (NP == 32) { const f32x4 a = *(const f32x4*)p, b = *(const f32x4*)(p + 4); s = ((a[0] + a[1]) + (a[2] + a[3])) + ((b[0] + b[1]) + (b[2] + b[3])); }
    else { const f32x2 a = *(const f32x2*)p; s = a[0] + a[1]; }
    s += __shfl_xor(s, 16); s += __shfl_xor(s, 32);
    return __builtin_amdgcn_rsqf(s * invn + EPS);
}
__device__ __forceinline__ float rowsum4(float q) { q += __shfl_xor(q, 16); q += __shfl_xor(q, 32); return q; }

struct EpiResid {
    const float* basf; const bf16_t* basb; bf16_t* xb; float* ss; int colgrp;
    __device__ __forceinline__ void operator()(const f32x4 (&acc)[2][2][4][2], const Unit& u, int wr, int wc, int fr, int fq) const {
        const int row0 = u.pm * BM + wr * 64 + fr, colb = u.grp * colgrp + u.pn * BM, col0 = colb + wc * 32 + 8 * fq, pidx = (colb >> 6) + wc;
        f32x4 pre[3][4];
#define RB_LOAD(it, P) do { const size_t off_ = (size_t)(row0 + ((it) >> 2) * HALF + ((it) & 3) * 16) * DM + col0; \
        if (basf) { P[0] = *(const f32x4*)(basf + off_); P[1] = *(const f32x4*)(basf + off_ + 4); P[2] = *(const f32x4*)(basf + off_ + HALF); P[3] = *(const f32x4*)(basf + off_ + HALF + 4); } \
        else { const u32x4 w0_ = *(const u32x4*)(basb + off_), w1_ = *(const u32x4*)(basb + off_ + HALF); \
               P[0] = (f32x4){__uint_as_float(w0_.x << 16), __uint_as_float(w0_.x & 0xffff0000u), __uint_as_float(w0_.y << 16), __uint_as_float(w0_.y & 0xffff0000u)}; \
               P[1] = (f32x4){__uint_as_float(w0_.z << 16), __uint_as_float(w0_.z & 0xffff0000u), __uint_as_float(w0_.w << 16), __uint_as_float(w0_.w & 0xffff0000u)}; \
               P[2] = (f32x4){__uint_as_float(w1_.x << 16), __uint_as_float(w1_.x & 0xffff0000u), __uint_as_float(w1_.y << 16), __uint_as_float(w1_.y & 0xffff0000u)}; \
               P[3] = (f32x4){__uint_as_float(w1_.z << 16), __uint_as_float(w1_.z & 0xffff0000u), __uint_as_float(w1_.w << 16), __uint_as_float(w1_.w & 0xffff0000u)}; } } while (0)
        RB_LOAD(0, pre[0]); RB_LOAD(1, pre[1]);
#pragma unroll
        for (int it = 0; it < 8; ++it) { const int ai = it >> 2, m = it & 3, row = row0 + ai * HALF + m * 16; const size_t off = (size_t)row * DM + col0; float q = 0.f;
            if (it + 2 < 8) RB_LOAD(it + 2, pre[(it + 2) % 3]);
#pragma unroll
            for (int bj = 0; bj < 2; ++bj) {
                const f32x4 v0 = acc[ai][bj][m][0] + pre[it % 3][2 * bj], v1 = acc[ai][bj][m][1] + pre[it % 3][2 * bj + 1];
                *(u32x4*)(xb + off + bj * HALF) = pack8(v0, v1);
                q += sq4(v0) + sq4(v1); }
            q = rowsum4(q); if (fq == 0) ss[(size_t)row * 32 + pidx] = q; }
#undef RB_LOAD
    }
};
struct EpiSwiGLU {
    bf16_t* mid; const float* ss;
    __device__ __forceinline__ void operator()(const f32x4 (&acc)[2][2][4][2], const Unit& u, int wr, int wc, int fr, int fq) const {
        const int row0 = u.pm * BM + wr * 64 + fr, col0 = u.pn * HALF + wc * 32 + 8 * fq;
#pragma unroll
        for (int ai = 0; ai < 2; ++ai)
#pragma unroll
            for (int m = 0; m < 4; ++m) { const int row = row0 + ai * HALF + m * 16; const float s = row_rstd<32>(ss, row, fq, 1.f / DM);
                const float sneg = -1.4426950408889634f * s, s2 = s * s; unsigned w[4];
#pragma unroll
                for (int n = 0; n < 2; ++n)
#pragma unroll
                    for (int e = 0; e < 2; ++e) { const f32x2 gg = {acc[ai][0][m][n][2 * e], acc[ai][0][m][n][2 * e + 1]}, uu = {acc[ai][1][m][n][2 * e], acc[ai][1][m][n][2 * e + 1]};
                        const f32x2 t = gg * sneg; f32x2 d; d.x = __builtin_amdgcn_exp2f(t.x); d.y = __builtin_amdgcn_exp2f(t.y); d = d + 1.0f;
                        f32x2 r; r.x = __builtin_amdgcn_rcpf(d.x); r.y = __builtin_amdgcn_rcpf(d.y);
                        const f32x2 h = (gg * uu) * (r * s2); w[2 * n + e] = cvt_pk_bf16(h.x, h.y); }
                *(u32x4*)(mid + (size_t)row * DFF + col0) = (u32x4){w[0], w[1], w[2], w[3]}; }
    }
};
__device__ __forceinline__ void rope8(f32x4& v0, f32x4& v1, const float* cs  ) {
    const f32x4 c0 = *(const f32x4*)cs, c1 = *(const f32x4*)(cs + 4);
    const f32x4 a = v0, b = v1;
    v0 = (f32x4){a[0] * c0[0] - a[1] * c0[1], a[1] * c0[0] + a[0] * c0[1], a[2] * c0[2] - a[3] * c0[3], a[3] * c0[2] + a[2] * c0[3]};
    v1 = (f32x4){b[0] * c1[0] - b[1] * c1[1], b[1] * c1[0] + b[0] * c1[1], b[2] * c1[2] - b[3] * c1[3], b[3] * c1[2] + b[2] * c1[3]};
}
struct EpiA {
    const float* ss; bf16_t* qa; bf16_t* kva; float* ssq; float* sskv; bf16_t* Kb; const float* cs;
    __device__ __forceinline__ void operator()(const f32x4 (&acc)[2][2][4][2], const Unit& u, int wr, int wc, int fr, int fq) const {
        const int row0 = u.pm * BM + wr * 64 + fr;
        if (u.pn < 4) {
            bf16_t* dst = u.pn < 2 ? qa : kva; float* sso = u.pn < 2 ? ssq : sskv; const int colb = (u.pn & 1) * BM, col0 = colb + wc * 32 + 8 * fq, pidx = (u.pn & 1) * 4 + wc;
#pragma unroll
            for (int ai = 0; ai < 2; ++ai)
#pragma unroll
                for (int m = 0; m < 4; ++m) { const int row = row0 + ai * HALF + m * 16; const float s = row_rstd<32>(ss, row, fq, 1.f / DM); float q = 0.f;
#pragma unroll
                    for (int bj = 0; bj < 2; ++bj) { const f32x4 v0 = acc[ai][bj][m][0] * s, v1 = acc[ai][bj][m][1] * s;
                        *(u32x4*)(dst + (size_t)row * 512 + col0 + bj * HALF) = pack8(v0, v1); q += sq4(v0) + sq4(v1); }
                    q = rowsum4(q); if (fq == 0) sso[(size_t)row * 8 + pidx] = q; }
        } else {
            const int p0 = wc * 32 + 8 * fq;
#pragma unroll
            for (int ai = 0; ai < 2; ++ai)
#pragma unroll
                for (int m = 0; m < 4; ++m) { const int row = row0 + ai * HALF + m * 16; const float s = row_rstd<32>(ss, row, fq, 1.f / DM);
                    if (wc < 2) { f32x4 v0 = acc[ai][0][m][0] * s, v1 = acc[ai][0][m][1] * s; rope8(v0, v1, cs + ((size_t)row * 32 + (p0 >> 1)) * 2);
                        const u32x4 w = pack8(v0, v1); bf16_t* kp = Kb + (size_t)row * 3072 + 128 + p0;
#pragma unroll
                        for (int h = 0; h < NH; ++h) *(u32x4*)(kp + h * 192) = w; } }
        }
    }
};
struct EpiQ {
    const float* ssq; bf16_t* Q; const float* cs;
    __device__ __forceinline__ void operator()(const f32x4 (&acc)[2][2][4][2], const Unit& u, int wr, int wc, int fr, int fq) const {
        const int row0 = u.pm * BM + wr * 64 + fr;
#pragma unroll
        for (int ai = 0; ai < 2; ++ai)
#pragma unroll
            for (int m = 0; m < 4; ++m) { const int row = row0 + ai * HALF + m * 16; const float s = row_rstd<8>(ssq, row, fq, 1.f / 512.f) * C2Q;
#pragma unroll
                for (int bj = 0; bj < 2; ++bj) { f32x4 v0 = acc[ai][bj][m][0] * s, v1 = acc[ai][bj][m][1] * s;
                    if (u.pn < 8) { *(u32x4*)(Q + (size_t)row * 3072 + (2 * u.pn + bj) * 192 + wc * 32 + 8 * fq) = pack8(v0, v1); }
                    else { const int head = 4 * (u.pn - 8) + 2 * bj + (wc >> 1), p0 = 32 * (wc & 1) + 8 * fq; rope8(v0, v1, cs + ((size_t)row * 32 + (p0 >> 1)) * 2);
                        *(u32x4*)(Q + (size_t)row * 3072 + head * 192 + 128 + p0) = pack8(v0, v1); } } }
    }
};
struct EpiKV {
    const float* sskv; bf16_t* Kb; bf16_t* Vb;
    __device__ __forceinline__ void operator()(const f32x4 (&acc)[2][2][4][2], const Unit& u, int wr, int wc, int fr, int fq) const {
        const int row0 = u.pm * BM + wr * 64 + fr;
#pragma unroll
        for (int ai = 0; ai < 2; ++ai)
#pragma unroll
            for (int m = 0; m < 4; ++m) { const int row = row0 + ai * HALF + m * 16; const float s = row_rstd<8>(sskv, row, fq, 1.f / 512.f);
#pragma unroll
                for (int bj = 0; bj < 2; ++bj) { const f32x4 v0 = acc[ai][bj][m][0] * s, v1 = acc[ai][bj][m][1] * s;
                    bf16_t* d = u.pn < 8 ? Kb + (size_t)row * 3072 + (2 * u.pn + bj) * 192 + wc * 32 + 8 * fq : Vb + (size_t)row * 2048 + (2 * (u.pn - 8) + bj) * 128 + wc * 32 + 8 * fq;
                    *(u32x4*)d = pack8(v0, v1); } }
    }
};
}

namespace att {
constexpr int NW = 8, QBLK = 32, KVBLK = 64, QB = 256;
constexpr int LDQ = 3072, LDK = 3072, LDV = 2048, LDO = 2048;
constexpr int KROWB = 400;
constexpr int SHM_K = KVBLK * KROWB, SHM_V = KVBLK * 128 * 2;
constexpr int NQR = 12;
constexpr int LDS_K0 = 3 * SHM_V, LDS_WS = LDS_K0 + 2 * SHM_K, LDS_QS = LDS_WS + NW * 64 * 4, LDS_TOTAL = LDS_QS + NW * (12 - NQR) * 1024;
constexpr float THR = 8.f;
#define SBAR() __builtin_amdgcn_sched_barrier(0)
__device__ __forceinline__ int v_st(int k, int c) { const int kk = (k & ~0xC) | ((k & 4) << 1) | ((k & 8) >> 1); return ((kk >> 3) * 4 + (c >> 5)) * 512 + ((kk & 7) * 32 + (c & 31)) * 2; }
__device__ __forceinline__ int v_rd_base(int lane) { return ((lane & 3) << 3) | (((lane >> 2) & 3) << 6) | (((lane >> 4) & 1) << 5) | (((lane >> 5) & 1) << 8); }
constexpr int v_rd_off(int d0, int ks, int half) { return d0 * 512 + ks * 4096 + half * 2048; }
__device__ __forceinline__ int crow(int r, int hi) { return (r & 3) + 8 * (r >> 2) + 4 * hi; }
__device__ __forceinline__ bf16x8 ldg8(const bf16_t* base, unsigned off) { return *reinterpret_cast<const bf16x8*>(base + off); }
__device__ __forceinline__ void mask_tile(f32x16& p0, f32x16& p1, int dq) {
    const float NEG = -__builtin_inff();
#pragma unroll
    for (int r = 0; r < 16; ++r) { const int c = (r & 3) + 8 * (r >> 2); if (dq - c < 0) p0[r] = NEG; if (dq - c - 32 < 0) p1[r] = NEG; }
}
__device__ __forceinline__ void qkt(f32x16& p0, f32x16& p1, const char* a, const char* qs, const bf16x8* qr, float negm) {
#pragma unroll
    for (int r = 0; r < 16; ++r) { p0[r] = negm; p1[r] = negm; }
    bf16x8 kA[3], kB[3], qv[3];
#define KL(d) do { kA[(d) % 3] = *reinterpret_cast<const bf16x8*>(a + (d) * 32); kB[(d) % 3] = *reinterpret_cast<const bf16x8*>(a + (d) * 32 + 32 * KROWB); \
        if ((d) >= NQR) qv[(d) % 3] = *reinterpret_cast<const bf16x8*>(qs + ((d) - NQR) * 1024); } while (0)
    KL(0); KL(1);
#pragma unroll
    for (int d0 = 0; d0 < 12; ++d0) {
        if (d0 + 2 < 12) KL(d0 + 2);
        SBAR();
        const bf16x8 q = d0 < NQR ? qr[d0 < NQR ? d0 : 0] : qv[d0 % 3];
        p0 = __builtin_amdgcn_mfma_f32_32x32x16_bf16(kA[d0 % 3], q, p0, 0, 0, 0);
        p1 = __builtin_amdgcn_mfma_f32_32x32x16_bf16(kB[d0 % 3], q, p1, 0, 0, 0);
        SBAR(); }
#undef KL
}
__device__ __forceinline__ void softmax_tile(f32x16& p0, f32x16& p1, float& m_reg, float& l_reg, float& alpha, bf16x8& pa0, bf16x8& pa1, bf16x8& pa2, bf16x8& pa3) {
    float pmax = fmaxf(p0[0], p1[0]);
#pragma unroll
    for (int r = 1; r < 16; ++r) pmax = fmaxf(fmaxf(pmax, p0[r]), p1[r]);
    { auto rr = __builtin_amdgcn_permlane32_swap(__float_as_uint(pmax), __float_as_uint(pmax), false, false); pmax = fmaxf(__uint_as_float(rr[0]), __uint_as_float(rr[1])); }
    alpha = 1.f;
    if (__builtin_expect(!__all(pmax <= THR), 0)) { const float dl = fmaxf(pmax, 0.f); m_reg += dl; alpha = __builtin_amdgcn_exp2f(-dl);
#pragma unroll
        for (int r = 0; r < 16; ++r) { p0[r] -= dl; p1[r] -= dl; } }
#pragma unroll
    for (int r = 0; r < 16; ++r) { p0[r] = __builtin_amdgcn_exp2f(p0[r]); p1[r] = __builtin_amdgcn_exp2f(p1[r]); }
    float ps = 0.f;
#pragma unroll
    for (int r = 0; r < 16; ++r) ps += p0[r] + p1[r];
    { auto rr = __builtin_amdgcn_permlane32_swap(__float_as_uint(ps), __float_as_uint(ps), false, false); ps = __uint_as_float(rr[0]) + __uint_as_float(rr[1]); }
    l_reg = l_reg * alpha + ps;
#define PK4(P, B_, OUT) do { unsigned a0 = cvt_pk_bf16(P[B_+0], P[B_+1]), a1 = cvt_pk_bf16(P[B_+2], P[B_+3]); \
        unsigned b0 = cvt_pk_bf16(P[B_+4], P[B_+5]), b1 = cvt_pk_bf16(P[B_+6], P[B_+7]); \
        auto r0 = __builtin_amdgcn_permlane32_swap(a0, b0, false, false); auto r1 = __builtin_amdgcn_permlane32_swap(a1, b1, false, false); \
        u32x4 w = {r0[0], r1[0], r0[1], r1[1]}; OUT = *reinterpret_cast<bf16x8*>(&w); } while (0)
    PK4(p0, 0, pa0); PK4(p0, 8, pa1); PK4(p1, 0, pa2); PK4(p1, 8, pa3);
#undef PK4
}
__device__ __forceinline__ void pv_tile(f32x16* o, int vb, bf16x8 pa0, bf16x8 pa1, bf16x8 pa2, bf16x8 pa3) {
#define TRRD(dst, off) asm volatile("ds_read_b64_tr_b16 %0, %1 offset:%2" : "=&v"(dst) : "v"(vb), "i"(off) : "memory")
#define TR8(S, d0) do { constexpr int b_ = v_rd_off(d0, 0, 0); TRRD(S##l0, b_); TRRD(S##h0, b_ + 2048); TRRD(S##l1, b_ + 4096); TRRD(S##h1, b_ + 6144); \
        TRRD(S##l2, b_ + 8192); TRRD(S##h2, b_ + 10240); TRRD(S##l3, b_ + 12288); TRRD(S##h3, b_ + 14336); } while (0)
#define MM4(S, d0) do { \
        o[d0] = __builtin_amdgcn_mfma_f32_32x32x16_bf16(pa0, (bf16x8){S##l0[0], S##l0[1], S##l0[2], S##l0[3], S##h0[0], S##h0[1], S##h0[2], S##h0[3]}, o[d0], 0, 0, 0); \
        o[d0] = __builtin_amdgcn_mfma_f32_32x32x16_bf16(pa1, (bf16x8){S##l1[0], S##l1[1], S##l1[2], S##l1[3], S##h1[0], S##h1[1], S##h1[2], S##h1[3]}, o[d0], 0, 0, 0); \
        o[d0] = __builtin_amdgcn_mfma_f32_32x32x16_bf16(pa2, (bf16x8){S##l2[0], S##l2[1], S##l2[2], S##l2[3], S##h2[0], S##h2[1], S##h2[2], S##h2[3]}, o[d0], 0, 0, 0); \
        o[d0] = __builtin_amdgcn_mfma_f32_32x32x16_bf16(pa3, (bf16x8){S##l3[0], S##l3[1], S##l3[2], S##l3[3], S##h3[0], S##h3[1], S##h3[2], S##h3[3]}, o[d0], 0, 0, 0); } while (0)
    s16x4 Al0, Al1, Al2, Al3, Ah0, Ah1, Ah2, Ah3, Bl0, Bl1, Bl2, Bl3, Bh0, Bh1, Bh2, Bh3;
    TR8(A, 0); TR8(B, 1);
    asm volatile("s_waitcnt lgkmcnt(8)" ::: "memory"); SBAR(); MM4(A, 0); SBAR();
    TR8(A, 2);
    asm volatile("s_waitcnt lgkmcnt(8)" ::: "memory"); SBAR(); MM4(B, 1); SBAR();
    TR8(B, 3);
    asm volatile("s_waitcnt lgkmcnt(8)" ::: "memory"); SBAR(); MM4(A, 2); SBAR();
    asm volatile("s_waitcnt lgkmcnt(0)" ::: "memory"); SBAR(); MM4(B, 3);
#undef MM4
#undef TR8
#undef TRRD
}
#define VMW() asm volatile("s_waitcnt vmcnt(0)" ::: "memory")
#define SLOAD(Kp, Vp) do { const bf16_t* vp_ = (Vp); st_v0 = ldg8(vp_, voff); st_v1 = ldg8(vp_ + 32 * LDV, voff); \
        const bf16_t* kp_ = (Kp); st_k0 = ldg8(kp_, koff); st_k1 = ldg8(kp_ + 64, koff); st_k2 = ldg8(kp_ + 128, koff); } while (0)
#define SWRITE(kb_, vb_) do { char* d_ = K_lds + (kb_) * SHM_K + kws; *(bf16x8*)d_ = st_k0; *(bf16x8*)(d_ + 128) = st_k1; *(bf16x8*)(d_ + 256) = st_k2; \
        *(bf16x8*)(V_lds + (vb_) * SHM_V + vst0) = st_v0; *(bf16x8*)(V_lds + (vb_) * SHM_V + vst1) = st_v1; } while (0)
#define BLK_BH(ii) (xcd * 8 + (ii))
#define BLK_QB(ii) (((ii) & 1) ? 31 - j : j)
#define TILEPTR(ii, nn, Kp, Vp) do { const int bh_ = BLK_BH(ii), qb_ = BLK_QB(ii), tl_ = ((ii) & 1) ? 4 * qb_ + 3 - (nn) : (nn); \
        const size_t row_ = (size_t)(bh_ >> 4) * SEQ + (size_t)tl_ * KVBLK; Kp = Kall + row_ * LDK + (bh_ & 15) * 192; Vp = Vall + row_ * LDV + (bh_ & 15) * 128; } while (0)
__device__ __forceinline__ void attn_stream(const bf16_t* Qall, const bf16_t* Kall, const bf16_t* Vall, bf16_t* Oall, int sid, char* lds) {
    const int xcd = sid >> 5, j = sid & 31;
    const int tid = threadIdx.x, wid = __builtin_amdgcn_readfirstlane(tid >> 6), lane = tid & 63, r32 = lane & 31, hi = lane >> 5;
    const int sr = tid >> 4, sc = (tid & 15) * 8, kr = tid >> 3;
    const unsigned voff = (unsigned)(sr * LDV + sc), koff = (unsigned)(kr * LDK + (tid & 7) * 8), qoff = (unsigned)((wid * QBLK + r32) * LDQ + hi * 8);
    const int kws = kr * KROWB + (tid & 7) * 16, vst0 = v_st(sr, sc), vst1 = v_st(32 + sr, sc);
    char* V_lds = lds; char* K_lds = lds + LDS_K0; char* qs = lds + LDS_QS + wid * ((12 - NQR) * 1024) + lane * 16;
    float* ws = (float*)(lds + LDS_WS) + wid * 64; float* li_l = ws, * al_l = ws + 32;
    const char* ka0 = K_lds + r32 * KROWB + hi * 16;
    const int vrb = (int)(uintptr_t)V_lds + v_rd_base(lane);
    const bool grpB = wid >= 4;
    if (wid >= 4) __builtin_amdgcn_s_setprio(1);
    bf16x8 st_v0, st_v1, st_k0, st_k1, st_k2;
    bf16x8 qr[NQR];
    f32x16 o[4], p0, p1; float m_reg, l_reg, al; bf16x8 pa0, pa1, pa2, pa3;
    const bf16_t* kp; const bf16_t* vp;
    { const int bh0 = BLK_BH(0); const bf16_t* Q0 = Qall + ((size_t)(bh0 >> 4) * SEQ + (size_t)BLK_QB(0) * QB) * LDQ + (bh0 & 15) * 192;
#pragma unroll
      for (int d0 = 0; d0 < NQR; ++d0) qr[d0] = ldg8(Q0 + d0 * 16, qoff);
#pragma unroll
      for (int d0 = NQR; d0 < 12; ++d0) *(bf16x8*)(qs + (d0 - NQR) * 1024) = ldg8(Q0 + d0 * 16, qoff);
#pragma unroll
      for (int d0 = 0; d0 < NQR; ++d0) asm volatile("" : "+v"(qr[d0]));
      TILEPTR(0, 0, kp, vp); SLOAD(kp, vp); VMW(); SWRITE(0, 0); }
    __syncthreads();
    if (grpB) { TILEPTR(0, 1, kp, vp); SLOAD(kp, vp); }
    int kb = 0, vb = 0;
    for (int i = 0; i < 8; ++i) {
        const int bh = BLK_BH(i), qb = BLK_QB(i), NT = 4 * qb + 4, qlo = qb * QB + wid * QBLK, qm = qlo + r32 - 4 * hi;
        const bool more = i < 7, desc = i & 1;
        m_reg = 0.f; l_reg = 0.f;
#pragma unroll
        for (int d = 0; d < 4; ++d) o[d] = f32x16{};
#define STEP(ACT) do { \
            const int t = desc ? NT - 1 - n : n; \
            const bool v1 = (n + 1 < NT) || more; bool v2 = true; if (n + 2 >= NT) v2 = more; \
            const int kb1 = kb ^ 1, vb1 = vb == 2 ? 0 : vb + 1; \
            if (!grpB && v1) { if (n + 1 < NT) TILEPTR(i, n + 1, kp, vp); else TILEPTR(i + 1, 0, kp, vp); SLOAD(kp, vp); } \
            if (ACT) { SBAR(); qkt(p0, p1, ka0 + kb * SHM_K, qs, qr, -m_reg); SBAR(); } \
            if (grpB) { if (v1) { VMW(); SWRITE(kb1, vb1); } __syncthreads(); \
                        if (v2) { if (n + 2 < NT) TILEPTR(i, n + 2, kp, vp); else TILEPTR(i + 1, n + 2 - NT, kp, vp); SLOAD(kp, vp); } } \
            if (ACT) { SBAR(); \
                { const int kb_ = t * KVBLK; if (kb_ + KVBLK - 1 > qlo) mask_tile(p0, p1, qm - kb_); } \
                softmax_tile(p0, p1, m_reg, l_reg, al, pa0, pa1, pa2, pa3); \
                if (__any(al < 1.f)) { if (hi == 0) al_l[r32] = al; asm volatile("s_waitcnt lgkmcnt(0)" ::: "memory"); \
                    _Pragma("unroll") for (int d_ = 0; d_ < 4; ++d_) _Pragma("unroll") for (int r = 0; r < 16; ++r) o[d_][r] *= al_l[crow(r, hi)]; } \
                SBAR(); pv_tile(o, vrb + vb * SHM_V, pa0, pa1, pa2, pa3); SBAR(); } \
            if (!grpB) { if (v1) { VMW(); SWRITE(kb1, vb1); } __syncthreads(); } \
            kb = kb1; vb = vb1; } while (0)
        const int NTa = 4 * qb + (wid >> 1) + 1;
        const int n0 = desc ? NT - NTa : 0, n1 = n0 + NTa;
        int n = 0;
        for (; n < n0; ++n) STEP(0);
        for (; n < n1; ++n) STEP(1);
        for (; n < NT; ++n) STEP(0);
#undef STEP
        {
            if (hi == 0) li_l[r32] = l_reg; asm volatile("s_waitcnt lgkmcnt(0)" ::: "memory");
            bf16_t* Ow = Oall + ((size_t)(bh >> 4) * SEQ + (size_t)qb * QB) * LDO + (bh & 15) * 128; unsigned ooff = (unsigned)((wid * QBLK + 4 * hi) * LDO + r32); asm volatile("" : "+v"(ooff));
#pragma unroll
            for (int r = 0; r < 16; ++r) { const int orow = (r & 3) + 8 * (r >> 2); const float rl = __builtin_amdgcn_rcpf(li_l[crow(r, hi)]);
#pragma unroll
                for (int d0 = 0; d0 < 4; ++d0) { const float v = o[d0][r] * rl; const float vn = __shfl_xor(v, 1);
                    if ((r32 & 1) == 0) *(unsigned*)(Ow + orow * LDO + d0 * 32 + ooff) = cvt_pk_bf16(v, vn); } }
            if (more) {
                const int bhn = BLK_BH(i + 1); const bf16_t* Qn = Qall + ((size_t)(bhn >> 4) * SEQ + (size_t)BLK_QB(i + 1) * QB) * LDQ + (bhn & 15) * 192;
#pragma unroll
                for (int d0 = 0; d0 < NQR; ++d0) qr[d0] = ldg8(Qn + d0 * 16, qoff);
#pragma unroll
                for (int d0 = NQR; d0 < 12; ++d0) *(bf16x8*)(qs + (d0 - NQR) * 1024) = ldg8(Qn + d0 * 16, qoff);
#pragma unroll
                for (int d0 = 0; d0 < NQR; ++d0) asm volatile("" : "+v"(qr[d0])); } }
    }
    __builtin_amdgcn_s_setprio(0);
    asm volatile("s_waitcnt vmcnt(0)" ::: "memory"); __syncthreads();
}
#undef BLK_BH
#undef BLK_QB
#undef TILEPTR
#undef VMW
#undef SLOAD
#undef SWRITE
#undef SBAR
}

constexpr size_t MiB = 1u << 20;
constexpr size_t WS_BAR = 7 * MiB, WS_RSTD0 = 0, WS_SSQ = 1 * MiB, WS_SSKV = 2 * MiB, WS_SS = 3 * MiB, WS_CS = 8 * MiB;
constexpr size_t WS_WPOOL = 16 * MiB, WS_WA = 18 * MiB, WS_WQB = 23 * MiB, WS_WKVB = 26 * MiB, WS_WO = 30 * MiB;
constexpr size_t WS_WGU0 = 38 * MiB, WS_WDN0 = 82 * MiB, WS_WGU1 = 104 * MiB, WS_WDN1 = 148 * MiB;
constexpr size_t WS_B0 = 170 * MiB, WS_B1 = 298 * MiB, WS_QA = 426 * MiB, WS_KVA = 458 * MiB;
constexpr size_t WS_Q = 490 * MiB, WS_K = 682 * MiB, WS_V = 874 * MiB, WS_MID = 490 * MiB, WS_END = 1002 * MiB;
constexpr int LDS_BYTES = 155648;
static_assert(att::LDS_TOTAL <= LDS_BYTES && pg8::STAGE_BYTES <= LDS_BYTES, "LDS map");

#define XB_TMO      128
#define XB_XCNT(j)  (256  + 64 * (j))
#define XB_XSUB(j)  (1280 + 64 * (j))
#define XB_XGEN(j)  (2304 + 64 * (j))
#define XB_TOP      3328
#define XB_TOPGEN   3392
#define XCD_BAR_WORDS 3456
#define XB_SPIN_CAP (1u << 18)
__device__ __forceinline__ unsigned xb_ld(unsigned* p)              { return __hip_atomic_load(p, __ATOMIC_RELAXED, __HIP_MEMORY_SCOPE_AGENT); }
__device__ __forceinline__ unsigned xb_add(unsigned* p, unsigned v) { return __hip_atomic_fetch_add(p, v, __ATOMIC_RELAXED, __HIP_MEMORY_SCOPE_AGENT); }
__device__ __forceinline__ unsigned xb_xcc_id() { return (unsigned)__builtin_amdgcn_s_getreg((3 << 11) | 20) & 0xFu; }
#define XB_SPIN(cond, bar) do { unsigned _sp = 0; while (cond) { __builtin_amdgcn_s_sleep(1); \
    if ((++_sp & 255u) == 0u) { if (xb_ld(&(bar)[XB_TMO])) break; if (_sp > XB_SPIN_CAP) { atomicAdd(&(bar)[XB_TMO], 1u); break; } } } } while (0)
struct XcdBarrier { unsigned* bar; unsigned x; volatile LAS unsigned* st; };
__device__ __forceinline__ XcdBarrier xcd_barrier_post(unsigned* bar, volatile LAS unsigned* st) {
    XcdBarrier b; b.bar = bar; b.x = xb_xcc_id(); b.st = st;
    if (threadIdx.x == 0) (void)xb_add(&bar[XB_XCNT(b.x)], 1u);
    return b;
}
__device__ __forceinline__ void xcd_barrier_complete(unsigned* bar, unsigned x, unsigned& nloc, unsigned& nx) {
    const unsigned G = gridDim.x * gridDim.y * gridDim.z;
    unsigned sum, cnt, mine, sp = 0u;
    for (;;) {
        sum = 0u; cnt = 0u; mine = 0u;
#pragma unroll
        for (unsigned j = 0; j < 16; ++j) { const unsigned c = xb_ld(&bar[XB_XCNT(j)]); sum += c; cnt += (c > 0u) ? 1u : 0u; mine = (j == x) ? c : mine; }
        if (sum == G) break;
        __builtin_amdgcn_s_sleep(1);
        if ((++sp & 255u) == 0u) { if (xb_ld(&bar[XB_TMO])) break; if (sp > XB_SPIN_CAP) { atomicAdd(&bar[XB_TMO], 1u); break; } }
    }
    nloc = mine > 0u ? mine : 1u; nx = cnt > 0u ? cnt : 1u;
}
__device__ __forceinline__ void xcd_barrier(const XcdBarrier& b) {
    asm volatile("s_waitcnt vmcnt(0)" ::: "memory");
    __syncthreads();
    if (threadIdx.x == 0) {
        unsigned* bar = b.bar;
        __builtin_amdgcn_s_waitcnt(0);
        unsigned nloc = b.st[0], nx = b.st[1];
        if (nloc == 0u) { xcd_barrier_complete(bar, b.x, nloc, nx); b.st[0] = nloc; b.st[1] = nx; }
        const unsigned old = xb_add(&bar[XB_XSUB(b.x)], 1u);
        const unsigned gen = old / nloc;
        if (old + 1u == (gen + 1u) * nloc) {
            __builtin_amdgcn_fence(__ATOMIC_RELEASE, "agent");
            asm volatile("s_waitcnt vmcnt(0)" ::: "memory");
            const unsigned og = xb_add(&bar[XB_TOP], 1u);
            const unsigned tg = og / nx;
            if (og + 1u == (tg + 1u) * nx) xb_add(&bar[XB_TOPGEN], 1u);
            else XB_SPIN(xb_ld(&bar[XB_TOPGEN]) == tg, bar);
            __builtin_amdgcn_fence(__ATOMIC_ACQUIRE, "agent");
            xb_add(&bar[XB_XGEN(b.x)], 1u);
            asm volatile("s_waitcnt vmcnt(0)" ::: "memory");
        } else {
            XB_SPIN(xb_ld(&bar[XB_XGEN(b.x)]) == gen, bar);
            __builtin_amdgcn_fence(__ATOMIC_ACQUIRE, "agent");
            asm volatile("s_waitcnt vmcnt(0)" ::: "memory");
        }
    }
    __syncthreads();
}

#ifndef PH_MASK
#define PH_MASK 0xFFF
#endif
#define PH_ON(k) (((PH_MASK) >> (k)) & 1)
struct Args { const float* in[19]; float* out; unsigned char* ws; int ph_lo, ph_hi; };

__device__ __forceinline__ float wave_sum(float v) {
#pragma unroll
    for (int o = 1; o < 64; o <<= 1) v += __shfl_xor(v, o);
    return v;
}
__device__ __forceinline__ int map_row(int mode, int n) {
    switch (mode) {
        case 1: return (n >> 7) * 256 + (n & 127);
        case 2: return (n >> 7) * 256 + 128 + (n & 127);
        case 3: { if (n < 512) return 512 + n; const int j = n - 512; return 1024 + 2 * (j & 31) + (j >> 5); }
        case 4: { const int h = n / 192, d = n % 192; if (d < 128) return h * 128 + d; const int j = d - 128; return 2048 + h * 64 + 2 * (j & 31) + (j >> 5); }
        case 5: { const int h = n >> 8, d = n & 255; return d < 128 ? h * 128 + d : 2048 + h * 128 + (d - 128); }
        default: return n;
    }
}
__device__ __forceinline__ void transpose_item(const float* W, int K, int N, bf16_t* WT, int mode, const float* ks, const float* cs, LAS float* scr, int item, int lane) {
    const int nblk = N / 64, kb = item / nblk, nb = item % nblk, k0 = 64 * kb, n0 = 64 * nb;
    const int lr = lane >> 4, lc = (lane & 15) * 4;
    f32x4 v[16];
#pragma unroll
    for (int i = 0; i < 16; ++i) v[i] = *(const f32x4*)(W + (size_t)(k0 + 4 * i + lr) * N + n0 + lc);
#pragma unroll
    for (int i = 0; i < 16; ++i) { const int kk = 4 * i + lr; f32x4 t = v[i]; if (ks) t = t * ks[k0 + kk]; LAS float* d = scr + kk * 65 + lc; d[0] = t[0]; d[1] = t[1]; d[2] = t[2]; d[3] = t[3]; }
    asm volatile("s_waitcnt lgkmcnt(0)" ::: "memory");
    const int c = lane & 7;
#pragma unroll
    for (int j = 0; j < 8; ++j) { const int n = (lane >> 3) + 8 * j; const LAS float* s = scr + (8 * c) * 65 + n; const float csn = cs ? cs[n0 + n] : 1.f;
        u32x4 o; o.x = cvt_pk_bf16(s[0 * 65] * csn, s[1 * 65] * csn); o.y = cvt_pk_bf16(s[2 * 65] * csn, s[3 * 65] * csn); o.z = cvt_pk_bf16(s[4 * 65] * csn, s[5 * 65] * csn); o.w = cvt_pk_bf16(s[6 * 65] * csn, s[7 * 65] * csn);
        *(u32x4*)(WT + (size_t)map_row(mode, n0 + n) * K + k0 + 8 * c) = o; }
    asm volatile("s_waitcnt lgkmcnt(0)" ::: "memory");
}

template <int W>
__device__ __forceinline__ void pool_chunk(const float* x, bf16_t* B0, int t0, int tin0, int wave, int lane, LAS float* part) {
    const int c0 = wave * 256 + lane * 4; const float* xc = x + c0;
    f32x4 ring[16], s = {0.f, 0.f, 0.f, 0.f};
#pragma unroll
    for (int k = 0; k < 16; ++k) ring[k] = (f32x4){0.f, 0.f, 0.f, 0.f};
    int pb = 0;
#pragma unroll 1
    for (int g2 = (tin0 ? -1 : 0); g2 < 8; ++g2) {
#pragma unroll
        for (int half = 0; half < 2; ++half) { const int tb = t0 + 16 * g2 + 8 * half;
            f32x4 xv[8];
#pragma unroll
            for (int k = 0; k < 8; ++k) xv[k] = *(const f32x4*)(xc + (size_t)(tb + k) * DM);
            float sq[8];
#pragma unroll
            for (int k = 0; k < 8; ++k) sq[k] = wave_sum(sq4(xv[k]));
            if (lane == 0) {
#pragma unroll
                for (int k = 0; k < 8; ++k) part[pb * 64 + k * 8 + wave] = sq[k]; }
            __syncthreads();
            float rs[8];
#pragma unroll
            for (int k = 0; k < 8; ++k) { const f32x4 pa = *(const LAS f32x4*)(part + pb * 64 + k * 8), pc = *(const LAS f32x4*)(part + pb * 64 + k * 8 + 4);
                rs[k] = __builtin_amdgcn_rsqf((((pa[0] + pa[1]) + (pa[2] + pa[3])) + ((pc[0] + pc[1]) + (pc[2] + pc[3]))) * (1.f / DM) + EPS); }
            pb ^= 1;
#pragma unroll
            for (int k = 0; k < 8; ++k) { const int p = 8 * half + k; const f32x4 h = xv[k] * rs[k]; ring[p] = h; s += h;
                if (g2 >= 0) { const int tin = tin0 + 16 * g2 + p, cnt = tin + 1 < W ? tin + 1 : W; const f32x4 d = s * __builtin_amdgcn_rcpf((float)cnt) - h;
                    u32x2 o; o.x = cvt_pk_bf16(d[0], d[1]); o.y = cvt_pk_bf16(d[2], d[3]); *(u32x2*)(B0 + (size_t)(t0 + 16 * g2 + p) * DM + c0) = o; }
                s -= ring[(p - W + 1) & 15]; }
        }
    }
}

__global__ void __launch_bounds__(512, 2) yoco_fwd(Args a) {
    extern __shared__ __attribute__((aligned(16))) unsigned char lds[];
    cg::grid_group grid = cg::this_grid();
    const int tid = threadIdx.x, lane = tid & 63, wave = __builtin_amdgcn_readfirstlane(tid >> 6);
    const int G = gridDim.x, bx = blockIdx.x, vcu = (G % 8 == 0) ? (bx % 8) * (G / 8) + bx / 8 : bx;
    const int gw = vcu * 8 + wave, NGW = G * 8;
    unsigned char* ws = a.ws;
    const float* x = a.in[0]; const int* positions = (const int*)a.in[1];
    float* out = a.out;
    float* rstd0 = (float*)(ws + WS_RSTD0); float* ssq = (float*)(ws + WS_SSQ); float* sskv = (float*)(ws + WS_SSKV); float* ss = (float*)(ws + WS_SS); float* cs = (float*)(ws + WS_CS);
    bf16_t* Wpool = (bf16_t*)(ws + WS_WPOOL); bf16_t* Wa = (bf16_t*)(ws + WS_WA); bf16_t* Wqb = (bf16_t*)(ws + WS_WQB); bf16_t* Wkvb = (bf16_t*)(ws + WS_WKVB); bf16_t* Wo = (bf16_t*)(ws + WS_WO);
    bf16_t* B0 = (bf16_t*)(ws + WS_B0); bf16_t* B1 = (bf16_t*)(ws + WS_B1); bf16_t* QA = (bf16_t*)(ws + WS_QA); bf16_t* KVA = (bf16_t*)(ws + WS_KVA);
    bf16_t* Qb = (bf16_t*)(ws + WS_Q); bf16_t* Kb = (bf16_t*)(ws + WS_K); bf16_t* Vb = (bf16_t*)(ws + WS_V); bf16_t* MID = (bf16_t*)(ws + WS_MID);
    LAS unsigned char* ldsl = (LAS unsigned char*)lds;
    const int lo = a.ph_lo, hi = a.ph_hi;
    volatile LAS unsigned* bst = (volatile LAS unsigned*)(ldsl + LDS_BYTES - 64);
    if (tid == 0) { bst[0] = 0u; bst[1] = 0u; }
    __syncthreads();
    XcdBarrier xbar = xcd_barrier_post((unsigned*)(ws + WS_BAR), bst);
#define IN(k) (lo <= (k) && (k) < hi)
#define SEAM(k) do { if (IN(k) && IN((k) + 1)) { if ((k) == 1) grid.sync(); else xcd_barrier(xbar); } } while (0)

    if (PH_ON(0) && IN(0)) {
        LAS float* scr = (LAS float*)(ldsl + wave * 16640);
        constexpr int I_POOL = 8 * 8, I_GU = 32 * 88, I_DN = 88 * 32, I_QA = 32 * 8, I_KVA = 32 * 9, I_QB = 8 * 48, I_KVB = 8 * 64, I_WO = 32 * 32;
        constexpr int NITEMS = 4 * I_POOL + 2 * (2 * I_GU + I_DN) + I_QA + I_KVA + I_QB + I_KVB + I_WO;
        for (int it = gw; it < NITEMS; it += NGW) {
            int r = it;
#define JOB(cnt, W_, K_, N_, dst_, mode_, ks_, cs_) if (r < (cnt)) { transpose_item(W_, K_, N_, dst_, mode_, ks_, cs_, scr, r, lane); continue; } r -= (cnt);
            JOB(I_POOL, a.in[3] + 0 * 262144, 512, 512, Wpool + 0 * 262144, 0, a.in[2] + 0, a.in[4] + 0)
            JOB(I_POOL, a.in[3] + 1 * 262144, 512, 512, Wpool + 1 * 262144, 0, a.in[2] + 512, a.in[4] + 512)
            JOB(I_POOL, a.in[3] + 2 * 262144, 512, 512, Wpool + 2 * 262144, 0, a.in[2] + 1024, a.in[4] + 1024)
            JOB(I_POOL, a.in[3] + 3 * 262144, 512, 512, Wpool + 3 * 262144, 0, a.in[2] + 1536, a.in[4] + 1536)
            JOB(I_GU, a.in[15], DM, DFF, (bf16_t*)(ws + WS_WGU0), 1, a.in[14], nullptr)
            JOB(I_GU, a.in[16], DM, DFF, (bf16_t*)(ws + WS_WGU0), 2, a.in[14], nullptr)
            JOB(I_DN, a.in[17], DFF, DM, (bf16_t*)(ws + WS_WDN0), 0, nullptr, nullptr)
            JOB(I_GU, a.in[15] + (size_t)DM * DFF, DM, DFF, (bf16_t*)(ws + WS_WGU1), 1, a.in[14] + DM, nullptr)
            JOB(I_GU, a.in[16] + (size_t)DM * DFF, DM, DFF, (bf16_t*)(ws + WS_WGU1), 2, a.in[14] + DM, nullptr)
            JOB(I_DN, a.in[17] + (size_t)DM * DFF, DFF, DM, (bf16_t*)(ws + WS_WDN1), 0, nullptr, nullptr)
            JOB(I_QA, a.in[10], DM, 512, Wa, 0, a.in[9], nullptr)
            JOB(I_KVA, a.in[6], DM, 576, Wa, 3, a.in[5], nullptr)
            JOB(I_QB, a.in[12], 512, 3072, Wqb, 4, a.in[11], nullptr)
            JOB(I_KVB, a.in[8], 512, 4096, Wkvb, 5, a.in[7], nullptr)
            JOB(I_WO, a.in[13], DM, DM, Wo, 0, nullptr, nullptr)
#undef JOB
        }
        for (int m = gw * 2 + (lane >> 5); m < T; m += NGW * 2) {
            const int i = lane & 31;
            const float invf = (float)exp2(-(double)i * (13.287712379549449 / 32.0));
            const float ang = (float)positions[m] * invf;
            double rev = (double)ang * 0.15915494309189535; rev -= rint(rev);
            const float rf = (float)rev;
            *(f32x2*)(cs + ((size_t)m * 32 + i) * 2) = (f32x2){__builtin_amdgcn_cosf(rf), __builtin_amdgcn_sinf(rf)};
        }
    }
    if (PH_ON(1) && IN(1)) {
        LAS float* part = (LAS float*)(ldsl + 140000);
        for (int chunk = vcu; chunk < T / 128; chunk += G) {
            const int t0 = chunk * 128, tin0 = t0 & (SEQ - 1);
            switch (wave >> 1) {
                case 0: pool_chunk<2>(x, B0, t0, tin0, wave, lane, part); break;
                case 1: pool_chunk<4>(x, B0, t0, tin0, wave, lane, part); break;
                case 2: pool_chunk<8>(x, B0, t0, tin0, wave, lane, part); break;
                default: pool_chunk<16>(x, B0, t0, tin0, wave, lane, part); break;
            }
            __syncthreads();
        }
    }
    SEAM(1);
    if (PH_ON(2) && IN(2)) {
        pg8::Gemm g{B0, Wpool, DM, 512, 512, 512, 262144}; pg8::Order S; S.init(T, 512, 4, G, bx);
        pg8::EpiResid E{x, nullptr, B1, ss, 512};
        pg8::gemm_phase(ldsl, g, S, E);
    }
    SEAM(2);
    if (PH_ON(3) && IN(3)) {
        pg8::Gemm g{B1, (const bf16_t*)(ws + WS_WGU0), DM, DM, DM, 0, 0}; pg8::Order S; S.init(T, 2 * DFF, 1, G, bx);
        pg8::EpiSwiGLU E{MID, ss};
#ifndef REP3
#define REP3 1
#endif
        for (int rep3 = 0; rep3 < REP3; ++rep3) pg8::gemm_phase(ldsl, g, S, E);
    }
    SEAM(3);
    if (PH_ON(4) && IN(4)) {
        pg8::Gemm g{MID, (const bf16_t*)(ws + WS_WDN0), DFF, DFF, DFF, 0, 0}; pg8::Order S; S.init(T, DM, 1, G, bx);
        pg8::EpiResid E{nullptr, B1, B0, ss, 0};
        pg8::gemm_phase(ldsl, g, S, E);
    }
    SEAM(4);
    if (PH_ON(5) && IN(5)) {
        pg8::Gemm g{B0, Wa, DM, DM, DM, 0, 0}; pg8::Order S; S.init(T, 1280, 1, G, bx);
        pg8::EpiA E{ss, QA, KVA, ssq, sskv, Kb, cs};
        pg8::gemm_phase(ldsl, g, S, E);
    }
    SEAM(5);
    if (PH_ON(6) && IN(6)) {
        { pg8::Gemm g{QA, Wqb, 512, 512, 512, 0, 0}; pg8::Order S; S.init(T, 3072, 1, G, bx);
          pg8::EpiQ E{ssq, Qb, cs}; pg8::gemm_phase(ldsl, g, S, E); }
        { pg8::Gemm g{KVA, Wkvb, 512, 512, 512, 0, 0}; pg8::Order S; S.init(T, 4096, 1, G, bx);
          pg8::EpiKV E{sskv, Kb, Vb}; pg8::gemm_phase(ldsl, g, S, E); }
    }
    SEAM(6);
    if (PH_ON(7) && IN(7)) {
#ifndef REP7
#define REP7 1
#endif
        for (int rep7 = 0; rep7 < REP7; ++rep7)
        for (int sid = vcu; sid < 256; sid += G) att::attn_stream(Qb, Kb, Vb, B1, sid, (char*)lds);
    }
    SEAM(7);
    if (PH_ON(8) && IN(8)) {
        pg8::Gemm g{B1, Wo, DM, DM, DM, 0, 0}; pg8::Order S; S.init(T, DM, 1, G, bx);
        pg8::EpiResid E{nullptr, B0, B0, ss, 0};
        pg8::gemm_phase(ldsl, g, S, E);
    }
    SEAM(8);
    if (PH_ON(9) && IN(9)) {
        pg8::Gemm g{B0, (const bf16_t*)(ws + WS_WGU1), DM, DM, DM, 0, 0}; pg8::Order S; S.init(T, 2 * DFF, 1, G, bx);
        pg8::EpiSwiGLU E{MID, ss};
        pg8::gemm_phase(ldsl, g, S, E);
    }
    SEAM(9);
    if (PH_ON(10) && IN(10)) {
        pg8::Gemm g{MID, (const bf16_t*)(ws + WS_WDN1), DFF, DFF, DFF, 0, 0}; pg8::Order S; S.init(T, DM, 1, G, bx);
        pg8::EpiResid E{nullptr, B0, B0, ss, 0};
        pg8::gemm_phase(ldsl, g, S, E);
    }
    SEAM(10);
    if (PH_ON(11) && IN(11)) {
        const float* fg = a.in[18];
        for (int m = gw; m < T; m += NGW) {
            float s = lane < 32 ? ss[(size_t)m * 32 + lane] : 0.f; s = wave_sum(s);
            const float r = __builtin_amdgcn_rsqf(s * (1.f / DM) + EPS);
            const u32x4* xr = (const u32x4*)(B0 + (size_t)m * DM) + lane; f32x4* orow = (f32x4*)(out + (size_t)m * DM) + 2 * lane; const f32x4* gr = (const f32x4*)fg + 2 * lane;
#pragma unroll
            for (int j = 0; j < 4; ++j) { const u32x4 w = xr[64 * j];
                const f32x4 v0 = {__uint_as_float(w.x << 16), __uint_as_float(w.x & 0xffff0000u), __uint_as_float(w.y << 16), __uint_as_float(w.y & 0xffff0000u)};
                const f32x4 v1 = {__uint_as_float(w.z << 16), __uint_as_float(w.z & 0xffff0000u), __uint_as_float(w.w << 16), __uint_as_float(w.w & 0xffff0000u)};
                orow[128 * j] = v0 * r * gr[128 * j]; orow[128 * j + 1] = v1 * r * gr[128 * j + 1]; }
        }
    }
#undef IN
#undef SEAM
}

extern "C" void kernel_launch(void* const* d_in, const int* in_sizes, int n_in, void* d_out, int out_size, void* d_ws, size_t ws_size, hipStream_t stream) {
    static int grid = 0;
    if (grid == 0) {
        if (n_in != 19 || in_sizes[0] != T * DM || out_size != T * DM || ws_size < WS_END) { fprintf(stderr, "kernel_launch: shape/workspace mismatch (n_in %d, in0 %d, out %d, ws %zu < %zu)\n", n_in, n_in > 0 ? in_sizes[0] : -1, out_size, ws_size, (size_t)WS_END); grid = -1; return; }
        int dev = 0, cus = 0, per_cu = 0;
        (void)hipGetDevice(&dev); (void)hipDeviceGetAttribute(&cus, hipDeviceAttributeMultiprocessorCount, dev);
        if (hipFuncSetAttribute((const void*)yoco_fwd, hipFuncAttributeMaxDynamicSharedMemorySize, LDS_BYTES) != hipSuccess) { fprintf(stderr, "kernel_launch: hipFuncSetAttribute failed\n"); grid = -1; return; }
        if (hipOccupancyMaxActiveBlocksPerMultiprocessor(&per_cu, (const void*)yoco_fwd, 512, LDS_BYTES) != hipSuccess || per_cu < 1) { fprintf(stderr, "kernel_launch: occupancy query says %d\n", per_cu); per_cu = 1; }
        (void)hipGetLastError();
        grid = cus * per_cu;
        if (grid <= 0) grid = 256;
    }
    if (grid < 0) return;
    if (hipMemsetAsync((char*)d_ws + WS_BAR, 0, XCD_BAR_WORDS * 4, stream) != hipSuccess) { fprintf(stderr, "kernel_launch: memset of the barrier words failed\n"); return; }
    Args a{};
    for (int i = 0; i < 19; ++i) a.in[i] = (const float*)d_in[i];
    a.out = (float*)d_out; a.ws = (unsigned char*)d_ws; a.ph_lo = 0; a.ph_hi = 12;
    void* args[] = {&a};
    hipError_t e = hipLaunchCooperativeKernel((const void*)yoco_fwd, dim3(grid), dim3(512), args, LDS_BYTES, stream);
    if (e != hipSuccess) fprintf(stderr, "cooperative launch failed: %s (grid %d)\n", hipGetErrorString(e), grid);
}
```

```cpp
#include <hip/hip_runtime.h>
#include <hip/hip_cooperative_groups.h>
#include <cstdio>
#include <cstdint>
namespace cg = cooperative_groups;

#define LAS __attribute__((address_space(3)))
typedef unsigned short bf16_t;
typedef short bf16x8 __attribute__((ext_vector_type(8)));
typedef short s16x4 __attribute__((ext_vector_type(4)));
typedef float f32x2 __attribute__((ext_vector_type(2)));
typedef float f32x4 __attribute__((ext_vector_type(4)));
typedef float f32x16 __attribute__((ext_vector_type(16)));
typedef unsigned u32x2 __attribute__((ext_vector_type(2)));
typedef unsigned u32x4 __attribute__((ext_vector_type(4)));

constexpr int DM = 2048, NB = 4, SEQ = 8192, T = NB * SEQ, DFF = 5632, NH = 16;
constexpr float EPS = 1e-6f;
constexpr float C2Q = 0.07216878364870322f * 1.4426950408889634f;

__device__ __forceinline__ unsigned cvt_pk_bf16(float lo, float hi) { unsigned r; asm volatile("v_cvt_pk_bf16_f32 %0, %1, %2" : "=v"(r) : "v"(lo), "v"(hi)); return r; }
__device__ __forceinline__ u32x4 pack8(f32x4 a, f32x4 b) { u32x4 w; w.x = cvt_pk_bf16(a[0], a[1]); w.y = cvt_pk_bf16(a[2], a[3]); w.z = cvt_pk_bf16(b[0], b[1]); w.w = cvt_pk_bf16(b[2], b[3]); return w; }
__device__ __forceinline__ float sq4(f32x4 v) { return (v[0] * v[0] + v[1] * v[1]) + (v[2] * v[2] + v[3] * v[3]); }

namespace pg8 {
constexpr int BM = 256, BK = 64, HALF = 128, HTB = HALF * BK * 2, STAGE_BYTES = 8 * HTB, NXCD = 8, WGM = 8;
__host__ __device__ __forceinline__ int lds_byte(int r, int c) { const int st = (r >> 4) * 2 + (c >> 5), rr = r & 15, cc = c & 31, ob = rr * 64 + cc * 2; return st * 1024 + (ob ^ (((ob >> 9) & 1) << 5)); }
__host__ __device__ __forceinline__ void stage_rc(int b, int& R, int& C) { const int st = b / 1024, sb = b % 1024, swz = sb ^ (((sb >> 9) & 1) << 5); R = (st >> 1) * 16 + swz / 64; C = (st & 1) * 32 + (swz % 64) / 2; }
__host__ __device__ __forceinline__ int perm32(int rho) { const int n = rho >> 4, i = rho & 15; return 8 * (i >> 2) + 4 * n + (i & 3); }

struct Unit { int pm, pn, grp; };
struct Gemm { const bf16_t* A; const bf16_t* Bt; int lda, ldb, K; long grpA, grpB; };

struct Order {
    int nM, nN, nwg, nG, G, c;
    __device__ void init(int M, int N, int nG_, int G_, int c_) { nM = M / BM; nN = N / BM; nwg = nM * nN; nG = nG_; G = G_; c = c_; }
    __device__ bool next(int i, Unit& u) const {
        const long L = (long)i * G + c; if (L >= (long)nwg * nG) return false;
        u.grp = (int)(L / nwg); int wgid = (int)(L % nwg);
        { const int q = nwg / NXCD, r = nwg % NXCD, xcd = wgid % NXCD, off = wgid / NXCD; wgid = (xcd < r ? xcd * (q + 1) : r * (q + 1) + (xcd - r) * q) + off; }
        const int nig = WGM * nN, gid = wgid / nig, fm = gid * WGM, gsz = (nM - fm) < WGM ? (nM - fm) : WGM;
        u.pm = fm + ((wgid % nig) % gsz); u.pn = (wgid % nig) / gsz; return true;
    }
};

template <class Epi>
__device__ __forceinline__ void gemm_phase(LAS unsigned char* lds, const Gemm g, const Order& S, const Epi& E) {
    const int tid = threadIdx.x, wid = __builtin_amdgcn_readfirstlane(tid >> 6), lane = tid & 63, wr = wid >> 2, wc = wid & 3, fr = lane & 15, fq = lane >> 4;
    const int K = g.K, nt = K / BK;
    unsigned voffA[2], voffB[2];
#pragma unroll
    for (int i = 0; i < 2; ++i) { int R, C; stage_rc(tid * 16 + i * 8192, R, C); const int Rb = (R & ~31) + perm32(R & 31);
        voffA[i] = (unsigned)(R * g.lda + C) * 2u; voffB[i] = (unsigned)(Rb * g.ldb + C) * 2u; }
    const size_t kstep = (size_t)(BK * 2);
    const size_t hstepA = (size_t)HALF * g.lda * 2, hstepB = (size_t)HALF * g.ldb * 2;
    const size_t tstepA = 2 * hstepA, tstepB = 2 * hstepB;
    const unsigned ldsw = (unsigned)wid * 1024u;
    const int aoff = lds_byte(wr * 64 + fr, fq * 8), boff = lds_byte(wc * 32 + fr, fq * 8);
#define PG8_SA(b, h) (((b) * 2 + (h)) * HTB)
#define PG8_SB(b, h) ((4 + (b) * 2 + (h)) * HTB)
#define PG8_STAGE(bufoff, gbase, voff) do { _Pragma("unroll") for (int _i = 0; _i < 2; ++_i) \
        __builtin_amdgcn_global_load_lds((const unsigned*)((const char*)(gbase) + (voff)[_i]), (LAS unsigned*)(lds + (bufoff) + ldsw + _i * 8192), 16, 0, 0); } while (0)
#define PG8_LDA(dst, b, h) do { _Pragma("unroll") for (int m = 0; m < 4; ++m) _Pragma("unroll") for (int k = 0; k < 2; ++k) dst[m][k] = *(const LAS bf16x8*)(lds + PG8_SA(b, h) + aoff + m * 2048 + k * 1024); } while (0)
#define PG8_LDB(dst, b, h) do { _Pragma("unroll") for (int n = 0; n < 2; ++n) _Pragma("unroll") for (int k = 0; k < 2; ++k) dst[n][k] = *(const LAS bf16x8*)(lds + PG8_SB(b, h) + boff + n * 2048 + k * 1024); } while (0)
#define PG8_MMA(ai, bj, At, Bt) do { __builtin_amdgcn_s_setprio(1); _Pragma("unroll") for (int m = 0; m < 4; ++m) _Pragma("unroll") for (int n = 0; n < 2; ++n) _Pragma("unroll") for (int k = 0; k < 2; ++k) \
        acc[ai][bj][m][n] = __builtin_amdgcn_mfma_f32_16x16x32_bf16(Bt[n][k], At[m][k], acc[ai][bj][m][n], 0, 0, 0); __builtin_amdgcn_s_setprio(0); } while (0)
#define PG8_WAIT_V(n) asm volatile("s_waitcnt vmcnt(" #n ")" ::: "memory")
#define PG8_WAIT_L(n) asm volatile("s_waitcnt lgkmcnt(" #n ")" ::: "memory")
#define PG8_BAR __builtin_amdgcn_s_barrier()
#define PG8_SCHED __builtin_amdgcn_sched_barrier(0)
    Unit cur, nxt; int ui = 0;
    if (!S.next(0, cur)) return;
    f32x4 acc[2][2][4][2];
#pragma unroll
    for (int a = 0; a < 2; ++a)
#pragma unroll
        for (int b = 0; b < 2; ++b)
#pragma unroll
            for (int m = 0; m < 4; ++m)
#pragma unroll
                for (int n = 0; n < 2; ++n) acc[a][b][m][n] = (f32x4){0.f, 0.f, 0.f, 0.f};
    bf16x8 At[4][2], B0[2][2], B1[2][2];
    const char* cA = (const char*)(g.A + (size_t)cur.grp * g.grpA) + (size_t)cur.pm * tstepA;
    const char* cB = (const char*)(g.Bt + (size_t)cur.grp * g.grpB) + (size_t)cur.pn * tstepB;
    PG8_STAGE(PG8_SB(0, 0), cB, voffB); PG8_STAGE(PG8_SB(0, 1), cB + hstepB, voffB); PG8_STAGE(PG8_SA(0, 0), cA, voffA); PG8_STAGE(PG8_SA(0, 1), cA + hstepA, voffA);
    if (wr == 1) PG8_BAR;
    PG8_WAIT_V(2); PG8_BAR;
    PG8_STAGE(PG8_SB(1, 0), cB + kstep, voffB); PG8_STAGE(PG8_SA(1, 0), cA + kstep, voffA); PG8_STAGE(PG8_SB(1, 1), cB + hstepB + kstep, voffB);
    PG8_WAIT_V(6); PG8_BAR;
    for (;;) {
        const bool has_next = S.next(ui + 1, nxt);
        const char* nA = has_next ? (const char*)(g.A + (size_t)nxt.grp * g.grpA) + (size_t)nxt.pm * tstepA : cA;
        const char* nB = has_next ? (const char*)(g.Bt + (size_t)nxt.grp * g.grpB) + (size_t)nxt.pn * tstepB : cB;
        for (int t = 0; t < nt; t += 2) {
            const bool last = (t == nt - 2);
            const char* a1 = cA + (size_t)(t + 1) * kstep;
            const char* a2 = last ? nA : cA + (size_t)(t + 2) * kstep; const char* b2 = last ? nB : cB + (size_t)(t + 2) * kstep;
            const char* a3 = a2 + kstep; const char* b3 = b2 + kstep;
            PG8_LDB(B0, 0, 0); PG8_LDB(B1, 0, 1); PG8_SCHED; PG8_LDA(At, 0, 0); PG8_STAGE(PG8_SA(1, 1), a1 + hstepA, voffA);
            PG8_WAIT_V(8); PG8_WAIT_L(0); PG8_BAR; PG8_MMA(0, 0, At, B0); PG8_MMA(0, 1, At, B1); PG8_BAR; PG8_SCHED;
            PG8_LDA(At, 0, 1); PG8_STAGE(PG8_SB(0, 0), b2, voffB); PG8_STAGE(PG8_SB(0, 1), b2 + hstepB, voffB); PG8_STAGE(PG8_SA(0, 0), a2, voffA);
            PG8_WAIT_V(8); PG8_WAIT_L(0); PG8_BAR; PG8_MMA(1, 0, At, B0); PG8_MMA(1, 1, At, B1); PG8_BAR; PG8_SCHED;
            PG8_LDB(B0, 1, 0); PG8_LDB(B1, 1, 1); PG8_SCHED; PG8_LDA(At, 1, 0); PG8_STAGE(PG8_SA(0, 1), a2 + hstepA, voffA);
            PG8_WAIT_V(8); PG8_WAIT_L(0); PG8_BAR; PG8_MMA(0, 0, At, B0); PG8_MMA(0, 1, At, B1); PG8_BAR; PG8_SCHED;
            PG8_LDA(At, 1, 1); PG8_STAGE(PG8_SB(1, 0), b3, voffB); PG8_STAGE(PG8_SB(1, 1), b3 + hstepB, voffB); PG8_STAGE(PG8_SA(1, 0), a3, voffA);
            PG8_WAIT_V(8); PG8_WAIT_L(0); PG8_BAR; PG8_MMA(1, 0, At, B0); PG8_MMA(1, 1, At, B1); PG8_BAR; PG8_SCHED;
        }
        if (wr == 0) PG8_BAR;
        E(acc, cur, wr, wc, fr, fq);
        if (!has_next) break;
#pragma unroll
        for (int a = 0; a < 2; ++a)
#pragma unroll
            for (int b = 0; b < 2; ++b)
#pragma unroll
                for (int m = 0; m < 4; ++m)
#pragma unroll
                    for (int n = 0; n < 2; ++n) acc[a][b][m][n] = (f32x4){0.f, 0.f, 0.f, 0.f};
        cur = nxt; cA = nA; cB = nB; ++ui;
        if (wr == 1) PG8_BAR;
    }
    PG8_WAIT_V(0);
    PG8_BAR;
#undef PG8_SA
#undef PG8_SB
#undef PG8_STAGE
#undef PG8_LDA
#undef PG8_LDB
#undef PG8_MMA
#undef PG8_WAIT_V
#undef PG8_WAIT_L
#undef PG8_BAR
#undef PG8_SCHED
}

template <int NP> __device__ __forceinline__ float row_rstd(const float* ss, int row, int fq, float invn) {
    const float* p = ss + (size_t)row * NP + fq * (NP / 4); float s;
    if constexpr (NP == 32) { const f32x4 a = *(const f32x4*)p, b = *(const f32x4*)(p + 4); s = ((a[0] + a[1]) + (a[2] + a[3])) + ((b[0] + b[1]) + (b[2] + b[3])); }
    else { const f32x2 a = *(const f32x2*)p; s = a[0] + a[1]; }
    s += __shfl_xor(s, 16); s += __shfl_xor(s, 32);
    return __builtin_amdgcn_rsqf(s * invn + EPS);
}
__device__ __forceinline__ float rowsum4(float q) { q += __shfl_xor(q, 16); q += __shfl_xor(q, 32); return q; }

struct EpiResid {
    const float* basf; const bf16_t* basb; bf16_t* xb; float* ss; int colgrp;
    __device__ __forceinline__ void operator()(const f32x4 (&acc)[2][2][4][2], const Unit& u, int wr, int wc, int fr, int fq) const {
        const int row0 = u.pm * BM + wr * 64 + fr, colb = u.grp * colgrp + u.pn * BM, col0 = colb + wc * 32 + 8 * fq, pidx = (colb >> 6) + wc;
        f32x4 pre[3][4];
#define RB_LOAD(it, P) do { const size_t off_ = (size_t)(row0 + ((it) >> 2) * HALF + ((it) & 3) * 16) * DM + col0; \
        if (basf) { P[0] = *(const f32x4*)(basf + off_); P[1] = *(const f32x4*)(basf + off_ + 4); P[2] = *(const f32x4*)(basf + off_ + HALF); P[3] = *(const f32x4*)(basf + off_ + HALF + 4); } \
        else { const u32x4 w0_ = *(const u32x4*)(basb + off_), w1_ = *(const u32x4*)(basb + off_ + HALF); \
               P[0] = (f32x4){__uint_as_float(w0_.x << 16), __uint_as_float(w0_.x & 0xffff0000u), __uint_as_float(w0_.y << 16), __uint_as_float(w0_.y & 0xffff0000u)}; \
               P[1] = (f32x4){__uint_as_float(w0_.z << 16), __uint_as_float(w0_.z & 0xffff0000u), __uint_as_float(w0_.w << 16), __uint_as_float(w0_.w & 0xffff0000u)}; \
               P[2] = (f32x4){__uint_as_float(w1_.x << 16), __uint_as_float(w1_.x & 0xffff0000u), __uint_as_float(w1_.y << 16), __uint_as_float(w1_.y & 0xffff0000u)}; \
               P[3] = (f32x4){__uint_as_float(w1_.z << 16), __uint_as_float(w1_.z & 0xffff0000u), __uint_as_float(w1_.w << 16), __uint_as_float(w1_.w & 0xffff0000u)}; } } while (0)
        RB_LOAD(0, pre[0]); RB_LOAD(1, pre[1]);
#pragma unroll
        for (int it = 0; it < 8; ++it) { const int ai = it >> 2, m = it & 3, row = row0 + ai * HALF + m * 16; const size_t off = (size_t)row * DM + col0; float q = 0.f;
            if (it + 2 < 8) RB_LOAD(it + 2, pre[(it + 2) % 3]);
#pragma unroll
            for (int bj = 0; bj < 2; ++bj) {
                const f32x4 v0 = acc[ai][bj][m][0] + pre[it % 3][2 * bj], v1 = acc[ai][bj][m][1] + pre[it % 3][2 * bj + 1];
                *(u32x4*)(xb + off + bj * HALF) = pack8(v0, v1);
                q += sq4(v0) + sq4(v1); }
            q = rowsum4(q); if (fq == 0) ss[(size_t)row * 32 + pidx] = q; }
#undef RB_LOAD
    }
};
struct EpiSwiGLU {
    bf16_t* mid; const float* ss;
    __device__ __forceinline__ void operator()(const f32x4 (&acc)[2][2][4][2], const Unit& u, int wr, int wc, int fr, int fq) const {
        const int row0 = u.pm * BM + wr * 64 + fr, col0 = u.pn * HALF + wc * 32 + 8 * fq;
#pragma unroll
        for (int ai = 0; ai < 2; ++ai)
#pragma unroll
            for (int m = 0; m < 4; ++m) { const int row = row0 + ai * HALF + m * 16; const float s = row_rstd<32>(ss, row, fq, 1.f / DM);
                const float sneg = -1.4426950408889634f * s, s2 = s * s; unsigned w[4];
#pragma unroll
                for (int n = 0; n < 2; ++n)
#pragma unroll
                    for (int e = 0; e < 2; ++e) { const f32x2 gg = {acc[ai][0][m][n][2 * e], acc[ai][0][m][n][2 * e + 1]}, uu = {acc[ai][1][m][n][2 * e], acc[ai][1][m][n][2 * e + 1]};
                        const f32x2 t = gg * sneg; f32x2 d; d.x = __builtin_amdgcn_exp2f(t.x); d.y = __builtin_amdgcn_exp2f(t.y); d = d + 1.0f;
                        f32x2 r; r.x = __builtin_amdgcn_rcpf(d.x); r.y = __builtin_amdgcn_rcpf(d.y);
                        const f32x2 h = (gg * uu) * (r * s2); w[2 * n + e] = cvt_pk_bf16(h.x, h.y); }
                *(u32x4*)(mid + (size_t)row * DFF + col0) = (u32x4){w[0], w[1], w[2], w[3]}; }
    }
};
__device__ __forceinline__ void rope8(f32x4& v0, f32x4& v1, const float* cs  ) {
    const f32x4 c0 = *(const f32x4*)cs, c1 = *(const f32x4*)(cs + 4);
    const f32x4 a = v0, b = v1;
    v0 = (f32x4){a[0] * c0[0] - a[1] * c0[1], a[1] * c0[0] + a[0] * c0[1], a[2] * c0[2] - a[3] * c0[3], a[3] * c0[2] + a[2] * c0[3]};
    v1 = (f32x4){b[0] * c1[0] - b[1] * c1[1], b[1] * c1[0] + b[0] * c1[1], b[2] * c1[2] - b[3] * c1[3], b[3] * c1[2] + b[2] * c1[3]};
}
struct EpiA {
    const float* ss; bf16_t* qa; bf16_t* kva; float* ssq; float* sskv; bf16_t* Kb; const float* cs;
    __device__ __forceinline__ void operator()(const f32x4 (&acc)[2][2][4][2], const Unit& u, int wr, int wc, int fr, int fq) const {
        const int row0 = u.pm * BM + wr * 64 + fr;
        if (u.pn < 4) {
            bf16_t* dst = u.pn < 2 ? qa : kva; float* sso = u.pn < 2 ? ssq : sskv; const int colb = (u.pn & 1) * BM, col0 = colb + wc * 32 + 8 * fq, pidx = (u.pn & 1) * 4 + wc;
#pragma unroll
            for (int ai = 0; ai < 2; ++ai)
#pragma unroll
                for (int m = 0; m < 4; ++m) { const int row = row0 + ai * HALF + m * 16; const float s = row_rstd<32>(ss, row, fq, 1.f / DM); float q = 0.f;
#pragma unroll
                    for (int bj = 0; bj < 2; ++bj) { const f32x4 v0 = acc[ai][bj][m][0] * s, v1 = acc[ai][bj][m][1] * s;
                        *(u32x4*)(dst + (size_t)row * 512 + col0 + bj * HALF) = pack8(v0, v1); q += sq4(v0) + sq4(v1); }
                    q = rowsum4(q); if (fq == 0) sso[(size_t)row * 8 + pidx] = q; }
        } else {
            const int p0 = wc * 32 + 8 * fq;
#pragma unroll
            for (int ai = 0; ai < 2; ++ai)
#pragma unroll
                for (int m = 0; m < 4; ++m) { const int row = row0 + ai * HALF + m * 16; const float s = row_rstd<32>(ss, row, fq, 1.f / DM);
                    if (wc < 2) { f32x4 v0 = acc[ai][0][m][0] * s, v1 = acc[ai][0][m][1] * s; rope8(v0, v1, cs + ((size_t)row * 32 + (p0 >> 1)) * 2);
                        const u32x4 w = pack8(v0, v1); bf16_t* kp = Kb + (size_t)row * 3072 + 128 + p0;
#pragma unroll
                        for (int h = 0; h < NH; ++h) *(u32x4*)(kp + h * 192) = w; } }
        }
    }
};
struct EpiQ {
    const float* ssq; bf16_t* Q; const float* cs;
    __device__ __forceinline__ void operator()(const f32x4 (&acc)[2][2][4][2], const Unit& u, int wr, int wc, int fr, int fq) const {
        const int row0 = u.pm * BM + wr * 64 + fr;
#pragma unroll
        for (int ai = 0; ai < 2; ++ai)
#pragma unroll
            for (int m = 0; m < 4; ++m) { const int row = row0 + ai * HALF + m * 16; const float s = row_rstd<8>(ssq, row, fq, 1.f / 512.f) * C2Q;
#pragma unroll
                for (int bj = 0; bj < 2; ++bj) { f32x4 v0 = acc[ai][bj][m][0] * s, v1 = acc[ai][bj][m][1] * s;
                    if (u.pn < 8) { *(u32x4*)(Q + (size_t)row * 3072 + (2 * u.pn + bj) * 192 + wc * 32 + 8 * fq) = pack8(v0, v1); }
                    else { const int head = 4 * (u.pn - 8) + 2 * bj + (wc >> 1), p0 = 32 * (wc & 1) + 8 * fq; rope8(v0, v1, cs + ((size_t)row * 32 + (p0 >> 1)) * 2);
                        *(u32x4*)(Q + (size_t)row * 3072 + head * 192 + 128 + p0) = pack8(v0, v1); } } }
    }
};
struct EpiKV {
    const float* sskv; bf16_t* Kb; bf16_t* Vb;
    __device__ __forceinline__ void operator()(const f32x4 (&acc)[2][2][4][2], const Unit& u, int wr, int wc, int fr, int fq) const {
        const int row0 = u.pm * BM + wr * 64 + fr;
#pragma unroll
        for (int ai = 0; ai < 2; ++ai)
#pragma unroll
            for (int m = 0; m < 4; ++m) { const int row = row0 + ai * HALF + m * 16; const float s = row_rstd<8>(sskv, row, fq, 1.f / 512.f);
#pragma unroll
                for (int bj = 0; bj < 2; ++bj) { const f32x4 v0 = acc[ai][bj][m][0] * s, v1 = acc[ai][bj][m][1] * s;
                    bf16_t* d = u.pn < 8 ? Kb + (size_t)row * 3072 + (2 * u.pn + bj) * 192 + wc * 32 + 8 * fq : Vb + (size_t)row * 2048 + (2 * (u.pn - 8) + bj) * 128 + wc * 32 + 8 * fq;
                    *(u32x4*)d = pack8(v0, v1); } }
    }
};
}

namespace att {
constexpr int NW = 8, QBLK = 32, KVBLK = 64, QB = 256;
constexpr int LDQ = 3072, LDK = 3072, LDV = 2048, LDO = 2048;
constexpr int KROWB = 400;
constexpr int SHM_K = KVBLK * KROWB, SHM_V = KVBLK * 128 * 2;
constexpr int NQR = 12;
constexpr int LDS_K0 = 3 * SHM_V, LDS_WS = LDS_K0 + 2 * SHM_K, LDS_QS = LDS_WS + NW * 64 * 4, LDS_TOTAL = LDS_QS + NW * (12 - NQR) * 1024;
constexpr float THR = 8.f;
#define SBAR() __builtin_amdgcn_sched_barrier(0)
__device__ __forceinline__ int v_st(int k, int c) { const int kk = (k & ~0xC) | ((k & 4) << 1) | ((k & 8) >> 1); return ((kk >> 3) * 4 + (c >> 5)) * 512 + ((kk & 7) * 32 + (c & 31)) * 2; }
__device__ __forceinline__ int v_rd_base(int lane) { return ((lane & 3) << 3) | (((lane >> 2) & 3) << 6) | (((lane >> 4) & 1) << 5) | (((lane >> 5) & 1) << 8); }
constexpr int v_rd_off(int d0, int ks, int half) { return d0 * 512 + ks * 4096 + half * 2048; }
__device__ __forceinline__ int crow(int r, int hi) { return (r & 3) + 8 * (r >> 2) + 4 * hi; }
__device__ __forceinline__ bf16x8 ldg8(const bf16_t* base, unsigned off) { return *reinterpret_cast<const bf16x8*>(base + off); }
__device__ __forceinline__ void mask_tile(f32x16& p0, f32x16& p1, int dq) {
    const float NEG = -__builtin_inff();
#pragma unroll
    for (int r = 0; r < 16; ++r) { const int c = (r & 3) + 8 * (r >> 2); if (dq - c < 0) p0[r] = NEG; if (dq - c - 32 < 0) p1[r] = NEG; }
}
__device__ __forceinline__ void qkt(f32x16& p0, f32x16& p1, const char* a, const char* qs, const bf16x8* qr, float negm) {
#pragma unroll
    for (int r = 0; r < 16; ++r) { p0[r] = negm; p1[r] = negm; }
    bf16x8 kA[3], kB[3], qv[3];
#define KL(d) do { kA[(d) % 3] = *reinterpret_cast<const bf16x8*>(a + (d) * 32); kB[(d) % 3] = *reinterpret_cast<const bf16x8*>(a + (d) * 32 + 32 * KROWB); \
        if ((d) >= NQR) qv[(d) % 3] = *reinterpret_cast<const bf16x8*>(qs + ((d) - NQR) * 1024); } while (0)
    KL(0); KL(1);
#pragma unroll
    for (int d0 = 0; d0 < 12; ++d0) {
        if (d0 + 2 < 12) KL(d0 + 2);
        SBAR();
        const bf16x8 q = d0 < NQR ? qr[d0 < NQR ? d0 : 0] : qv[d0 % 3];
        p0 = __builtin_amdgcn_mfma_f32_32x32x16_bf16(kA[d0 % 3], q, p0, 0, 0, 0);
        p1 = __builtin_amdgcn_mfma_f32_32x32x16_bf16(kB[d0 % 3], q, p1, 0, 0, 0);
        SBAR(); }
#undef KL
}
__device__ __forceinline__ void softmax_tile(f32x16& p0, f32x16& p1, float& m_reg, float& l_reg, float& alpha, bf16x8& pa0, bf16x8& pa1, bf16x8& pa2, bf16x8& pa3) {
    float pmax = fmaxf(p0[0], p1[0]);
#pragma unroll
    for (int r = 1; r < 16; ++r) pmax = fmaxf(fmaxf(pmax, p0[r]), p1[r]);
    { auto rr = __builtin_amdgcn_permlane32_swap(__float_as_uint(pmax), __float_as_uint(pmax), false, false); pmax = fmaxf(__uint_as_float(rr[0]), __uint_as_float(rr[1])); }
    alpha = 1.f;
    if (__builtin_expect(!__all(pmax <= THR), 0)) { const float dl = fmaxf(pmax, 0.f); m_reg += dl; alpha = __builtin_amdgcn_exp2f(-dl);
#pragma unroll
        for (int r = 0; r < 16; ++r) { p0[r] -= dl; p1[r] -= dl; } }
#pragma unroll
    for (int r = 0; r < 16; ++r) { p0[r] = __builtin_amdgcn_exp2f(p0[r]); p1[r] = __builtin_amdgcn_exp2f(p1[r]); }
    float ps = 0.f;
#pragma unroll
    for (int r = 0; r < 16; ++r) ps += p0[r] + p1[r];
    { auto rr = __builtin_amdgcn_permlane32_swap(__float_as_uint(ps), __float_as_uint(ps), false, false); ps = __uint_as_float(rr[0]) + __uint_as_float(rr[1]); }
    l_reg = l_reg * alpha + ps;
#define PK4(P, B_, OUT) do { unsigned a0 = cvt_pk_bf16(P[B_+0], P[B_+1]), a1 = cvt_pk_bf16(P[B_+2], P[B_+3]); \
        unsigned b0 = cvt_pk_bf16(P[B_+4], P[B_+5]), b1 = cvt_pk_bf16(P[B_+6], P[B_+7]); \
        auto r0 = __builtin_amdgcn_permlane32_swap(a0, b0, false, false); auto r1 = __builtin_amdgcn_permlane32_swap(a1, b1, false, false); \
        u32x4 w = {r0[0], r1[0], r0[1], r1[1]}; OUT = *reinterpret_cast<bf16x8*>(&w); } while (0)
    PK4(p0, 0, pa0); PK4(p0, 8, pa1); PK4(p1, 0, pa2); PK4(p1, 8, pa3);
#undef PK4
}
__device__ __forceinline__ void pv_tile(f32x16* o, int vb, bf16x8 pa0, bf16x8 pa1, bf16x8 pa2, bf16x8 pa3) {
#define TRRD(dst, off) asm volatile("ds_read_b64_tr_b16 %0, %1 offset:%2" : "=&v"(dst) : "v"(vb), "i"(off) : "memory")
#define TR8(S, d0) do { constexpr int b_ = v_rd_off(d0, 0, 0); TRRD(S##l0, b_); TRRD(S##h0, b_ + 2048); TRRD(S##l1, b_ + 4096); TRRD(S##h1, b_ + 6144); \
        TRRD(S##l2, b_ + 8192); TRRD(S##h2, b_ + 10240); TRRD(S##l3, b_ + 12288); TRRD(S##h3, b_ + 14336); } while (0)
#define MM4(S, d0) do { \
        o[d0] = __builtin_amdgcn_mfma_f32_32x32x16_bf16(pa0, (bf16x8){S##l0[0], S##l0[1], S##l0[2], S##l0[3], S##h0[0], S##h0[1], S##h0[2], S##h0[3]}, o[d0], 0, 0, 0); \
        o[d0] = __builtin_amdgcn_mfma_f32_32x32x16_bf16(pa1, (bf16x8){S##l1[0], S##l1[1], S##l1[2], S##l1[3], S##h1[0], S##h1[1], S##h1[2], S##h1[3]}, o[d0], 0, 0, 0); \
        o[d0] = __builtin_amdgcn_mfma_f32_32x32x16_bf16(pa2, (bf16x8){S##l2[0], S##l2[1], S##l2[2], S##l2[3], S##h2[0], S##h2[1], S##h2[2], S##h2[3]}, o[d0], 0, 0, 0); \
        o[d0] = __builtin_amdgcn_mfma_f32_32x32x16_bf16(pa3, (bf16x8){S##l3[0], S##l3[1], S##l3[2], S##l3[3], S##h3[0], S##h3[1], S##h3[2], S##h3[3]}, o[d0], 0, 0, 0); } while (0)
    s16x4 Al0, Al1, Al2, Al3, Ah0, Ah1, Ah2, Ah3, Bl0, Bl1, Bl2, Bl3, Bh0, Bh1, Bh2, Bh3;
    TR8(A, 0); TR8(B, 1);
    asm volatile("s_waitcnt lgkmcnt(8)" ::: "memory"); SBAR(); MM4(A, 0); SBAR();
    TR8(A, 2);
    asm volatile("s_waitcnt lgkmcnt(8)" ::: "memory"); SBAR(); MM4(B, 1); SBAR();
    TR8(B, 3);
    asm volatile("s_waitcnt lgkmcnt(8)" ::: "memory"); SBAR(); MM4(A, 2); SBAR();
    asm volatile("s_waitcnt lgkmcnt(0)" ::: "memory"); SBAR(); MM4(B, 3);
#undef MM4
#undef TR8
#undef TRRD
}
#define VMW() asm volatile("s_waitcnt vmcnt(0)" ::: "memory")
#define SLOAD(Kp, Vp) do { const bf16_t* vp_ = (Vp); st_v0 = ldg8(vp_, voff); st_v1 = ldg8(vp_ + 32 * LDV, voff); \
        const bf16_t* kp_ = (Kp); st_k0 = ldg8(kp_, koff); st_k1 = ldg8(kp_ + 64, koff); st_k2 = ldg8(kp_ + 128, koff); } while (0)
#define SWRITE(kb_, vb_) do { char* d_ = K_lds + (kb_) * SHM_K + kws; *(bf16x8*)d_ = st_k0; *(bf16x8*)(d_ + 128) = st_k1; *(bf16x8*)(d_ + 256) = st_k2; \
        *(bf16x8*)(V_lds + (vb_) * SHM_V + vst0) = st_v0; *(bf16x8*)(V_lds + (vb_) * SHM_V + vst1) = st_v1; } while (0)
#define BLK_BH(ii) (xcd * 8 + (ii))
#define BLK_QB(ii) (((ii) & 1) ? 31 - j : j)
#define TILEPTR(ii, nn, Kp, Vp) do { const int bh_ = BLK_BH(ii), qb_ = BLK_QB(ii), tl_ = ((ii) & 1) ? 4 * qb_ + 3 - (nn) : (nn); \
        const size_t row_ = (size_t)(bh_ >> 4) * SEQ + (size_t)tl_ * KVBLK; Kp = Kall + row_ * LDK + (bh_ & 15) * 192; Vp = Vall + row_ * LDV + (bh_ & 15) * 128; } while (0)
__device__ __forceinline__ void attn_stream(const bf16_t* Qall, const bf16_t* Kall, const bf16_t* Vall, bf16_t* Oall, int sid, char* lds) {
    const int xcd = sid >> 5, j = sid & 31;
    const int tid = threadIdx.x, wid = __builtin_amdgcn_readfirstlane(tid >> 6), lane = tid & 63, r32 = lane & 31, hi = lane >> 5;
    const int sr = tid >> 4, sc = (tid & 15) * 8, kr = tid >> 3;
    const unsigned voff = (unsigned)(sr * LDV + sc), koff = (unsigned)(kr * LDK + (tid & 7) * 8), qoff = (unsigned)((wid * QBLK + r32) * LDQ + hi * 8);
    const int kws = kr * KROWB + (tid & 7) * 16, vst0 = v_st(sr, sc), vst1 = v_st(32 + sr, sc);
    char* V_lds = lds; char* K_lds = lds + LDS_K0; char* qs = lds + LDS_QS + wid * ((12 - NQR) * 1024) + lane * 16;
    float* ws = (float*)(lds + LDS_WS) + wid * 64; float* li_l = ws, * al_l = ws + 32;
    const char* ka0 = K_lds + r32 * KROWB + hi * 16;
    const int vrb = (int)(uintptr_t)V_lds + v_rd_base(lane);
    const bool grpB = wid >= 4;
    if (wid >= 4) __builtin_amdgcn_s_setprio(1);
    bf16x8 st_v0, st_v1, st_k0, st_k1, st_k2;
    bf16x8 qr[NQR];
    f32x16 o[4], p0, p1; float m_reg, l_reg, al; bf16x8 pa0, pa1, pa2, pa3;
    const bf16_t* kp; const bf16_t* vp;
    { const int bh0 = BLK_BH(0); const bf16_t* Q0 = Qall + ((size_t)(bh0 >> 4) * SEQ + (size_t)BLK_QB(0) * QB) * LDQ + (bh0 & 15) * 192;
#pragma unroll
      for (int d0 = 0; d0 < NQR; ++d0) qr[d0] = ldg8(Q0 + d0 * 16, qoff);
#pragma unroll
      for (int d0 = NQR; d0 < 12; ++d0) *(bf16x8*)(qs + (d0 - NQR) * 1024) = ldg8(Q0 + d0 * 16, qoff);
#pragma unroll
      for (int d0 = 0; d0 < NQR; ++d0) asm volatile("" : "+v"(qr[d0]));
      TILEPTR(0, 0, kp, vp); SLOAD(kp, vp); VMW(); SWRITE(0, 0); }
    __syncthreads();
    if (grpB) { TILEPTR(0, 1, kp, vp); SLOAD(kp, vp); }
    int kb = 0, vb = 0;
    for (int i = 0; i < 8; ++i) {
        const int bh = BLK_BH(i), qb = BLK_QB(i), NT = 4 * qb + 4, qlo = qb * QB + wid * QBLK, qm = qlo + r32 - 4 * hi;
        const bool more = i < 7, desc = i & 1;
        m_reg = 0.f; l_reg = 0.f;
#pragma unroll
        for (int d = 0; d < 4; ++d) o[d] = f32x16{};
#define STEP(ACT) do { \
            const int t = desc ? NT - 1 - n : n; \
            const bool v1 = (n + 1 < NT) || more; bool v2 = true; if (n + 2 >= NT) v2 = more; \
            const int kb1 = kb ^ 1, vb1 = vb == 2 ? 0 : vb + 1; \
            if (!grpB && v1) { if (n + 1 < NT) TILEPTR(i, n + 1, kp, vp); else TILEPTR(i + 1, 0, kp, vp); SLOAD(kp, vp); } \
            if (ACT) { SBAR(); qkt(p0, p1, ka0 + kb * SHM_K, qs, qr, -m_reg); SBAR(); } \
            if (grpB) { if (v1) { VMW(); SWRITE(kb1, vb1); } __syncthreads(); \
                        if (v2) { if (n + 2 < NT) TILEPTR(i, n + 2, kp, vp); else TILEPTR(i + 1, n + 2 - NT, kp, vp); SLOAD(kp, vp); } } \
            if (ACT) { SBAR(); \
                { const int kb_ = t * KVBLK; if (kb_ + KVBLK - 1 > qlo) mask_tile(p0, p1, qm - kb_); } \
                softmax_tile(p0, p1, m_reg, l_reg, al, pa0, pa1, pa2, pa3); \
                if (__any(al < 1.f)) { if (hi == 0) al_l[r32] = al; asm volatile("s_waitcnt lgkmcnt(0)" ::: "memory"); \
                    _Pragma("unroll") for (int d_ = 0; d_ < 4; ++d_) _Pragma("unroll") for (int r = 0; r < 16; ++r) o[d_][r] *= al_l[crow(r, hi)]; } \
                SBAR(); pv_tile(o, vrb + vb * SHM_V, pa0, pa1, pa2, pa3); SBAR(); } \
            if (!grpB) { if (v1) { VMW(); SWRITE(kb1, vb1); } __syncthreads(); } \
            kb = kb1; vb = vb1; } while (0)
        const int NTa = 4 * qb + (wid >> 1) + 1;
        const int n0 = desc ? NT - NTa : 0, n1 = n0 + NTa;
        int n = 0;
        for (; n < n0; ++n) STEP(0);
        for (; n < n1; ++n) STEP(1);
        for (; n < NT; ++n) STEP(0);
#undef STEP
        {
            if (hi == 0) li_l[r32] = l_reg; asm volatile("s_waitcnt lgkmcnt(0)" ::: "memory");
            bf16_t* Ow = Oall + ((size_t)(bh >> 4) * SEQ + (size_t)qb * QB) * LDO + (bh & 15) * 128; unsigned ooff = (unsigned)((wid * QBLK + 4 * hi) * LDO + r32); asm volatile("" : "+v"(ooff));
#pragma unroll
            for (int r = 0; r < 16; ++r) { const int orow = (r & 3) + 8 * (r >> 2); const float rl = __builtin_amdgcn_rcpf(li_l[crow(r, hi)]);
#pragma unroll
                for (int d0 = 0; d0 < 4; ++d0) { const float v = o[d0][r] * rl; const float vn = __shfl_xor(v, 1);
                    if ((r32 & 1) == 0) *(unsigned*)(Ow + orow * LDO + d0 * 32 + ooff) = cvt_pk_bf16(v, vn); } }
            if (more) {
                const int bhn = BLK_BH(i + 1); const bf16_t* Qn = Qall + ((size_t)(bhn >> 4) * SEQ + (size_t)BLK_QB(i + 1) * QB) * LDQ + (bhn & 15) * 192;
#pragma unroll
                for (int d0 = 0; d0 < NQR; ++d0) qr[d0] = ldg8(Qn + d0 * 16, qoff);
#pragma unroll
                for (int d0 = NQR; d0 < 12; ++d0) *(bf16x8*)(qs + (d0 - NQR) * 1024) = ldg8(Qn + d0 * 16, qoff);
#pragma unroll
                for (int d0 = 0; d0 < NQR; ++d0) asm volatile("" : "+v"(qr[d0])); } }
    }
    __builtin_amdgcn_s_setprio(0);
    asm volatile("s_waitcnt vmcnt(0)" ::: "memory"); __syncthreads();
}
#undef BLK_BH
#undef BLK_QB
#undef TILEPTR
#undef VMW
#undef SLOAD
#undef SWRITE
#undef SBAR
}

constexpr size_t MiB = 1u << 20;
constexpr size_t WS_BAR = 7 * MiB, WS_RSTD0 = 0, WS_SSQ = 1 * MiB, WS_SSKV = 2 * MiB, WS_SS = 3 * MiB, WS_CS = 8 * MiB;
constexpr size_t WS_WPOOL = 16 * MiB, WS_WA = 18 * MiB, WS_WQB = 23 * MiB, WS_WKVB = 26 * MiB, WS_WO = 30 * MiB;
constexpr size_t WS_WGU0 = 38 * MiB, WS_WDN0 = 82 * MiB, WS_WGU1 = 104 * MiB, WS_WDN1 = 148 * MiB;
constexpr size_t WS_B0 = 170 * MiB, WS_B1 = 298 * MiB, WS_QA = 426 * MiB, WS_KVA = 458 * MiB;
constexpr size_t WS_Q = 490 * MiB, WS_K = 682 * MiB, WS_V = 874 * MiB, WS_MID = 490 * MiB, WS_END = 1002 * MiB;
constexpr int LDS_BYTES = 155648;
static_assert(att::LDS_TOTAL <= LDS_BYTES && pg8::STAGE_BYTES <= LDS_BYTES, "LDS map");

#define XB_TMO      128
#define XB_XCNT(j)  (256  + 64 * (j))
#define XB_XSUB(j)  (1280 + 64 * (j))
#define XB_XGEN(j)  (2304 + 64 * (j))
#define XB_TOP      3328
#define XB_TOPGEN   3392
#define XCD_BAR_WORDS 3456
#define XB_SPIN_CAP (1u << 18)
__device__ __forceinline__ unsigned xb_ld(unsigned* p)              { return __hip_atomic_load(p, __ATOMIC_RELAXED, __HIP_MEMORY_SCOPE_AGENT); }
__device__ __forceinline__ unsigned xb_add(unsigned* p, unsigned v) { return __hip_atomic_fetch_add(p, v, __ATOMIC_RELAXED, __HIP_MEMORY_SCOPE_AGENT); }
__device__ __forceinline__ unsigned xb_xcc_id() { return (unsigned)__builtin_amdgcn_s_getreg((3 << 11) | 20) & 0xFu; }
#define XB_SPIN(cond, bar) do { unsigned _sp = 0; while (cond) { __builtin_amdgcn_s_sleep(1); \
    if ((++_sp & 255u) == 0u) { if (xb_ld(&(bar)[XB_TMO])) break; if (_sp > XB_SPIN_CAP) { atomicAdd(&(bar)[XB_TMO], 1u); break; } } } } while (0)
struct XcdBarrier { unsigned* bar; unsigned x; volatile LAS unsigned* st; };
__device__ __forceinline__ XcdBarrier xcd_barrier_post(unsigned* bar, volatile LAS unsigned* st) {
    XcdBarrier b; b.bar = bar; b.x = xb_xcc_id(); b.st = st;
    if (threadIdx.x == 0) (void)xb_add(&bar[XB_XCNT(b.x)], 1u);
    return b;
}
__device__ __forceinline__ void xcd_barrier_complete(unsigned* bar, unsigned x, unsigned& nloc, unsigned& nx) {
    const unsigned G = gridDim.x * gridDim.y * gridDim.z;
    unsigned sum, cnt, mine, sp = 0u;
    for (;;) {
        sum = 0u; cnt = 0u; mine = 0u;
#pragma unroll
        for (unsigned j = 0; j < 16; ++j) { const unsigned c = xb_ld(&bar[XB_XCNT(j)]); sum += c; cnt += (c > 0u) ? 1u : 0u; mine = (j == x) ? c : mine; }
        if (sum == G) break;
        __builtin_amdgcn_s_sleep(1);
        if ((++sp & 255u) == 0u) { if (xb_ld(&bar[XB_TMO])) break; if (sp > XB_SPIN_CAP) { atomicAdd(&bar[XB_TMO], 1u); break; } }
    }
    nloc = mine > 0u ? mine : 1u; nx = cnt > 0u ? cnt : 1u;
}
__device__ __forceinline__ void xcd_barrier(const XcdBarrier& b) {
    asm volatile("s_waitcnt vmcnt(0)" ::: "memory");
    __syncthreads();
    if (threadIdx.x == 0) {
        unsigned* bar = b.bar;
        __builtin_amdgcn_s_waitcnt(0);
        unsigned nloc = b.st[0], nx = b.st[1];
        if (nloc == 0u) { xcd_barrier_complete(bar, b.x, nloc, nx); b.st[0] = nloc; b.st[1] = nx; }
        const unsigned old = xb_add(&bar[XB_XSUB(b.x)], 1u);
        const unsigned gen = old / nloc;
        if (old + 1u == (gen + 1u) * nloc) {
            __builtin_amdgcn_fence(__ATOMIC_RELEASE, "agent");
            asm volatile("s_waitcnt vmcnt(0)" ::: "memory");
            const unsigned og = xb_add(&bar[XB_TOP], 1u);
            const unsigned tg = og / nx;
            if (og + 1u == (tg + 1u) * nx) xb_add(&bar[XB_TOPGEN], 1u);
            else XB_SPIN(xb_ld(&bar[XB_TOPGEN]) == tg, bar);
            __builtin_amdgcn_fence(__ATOMIC_ACQUIRE, "agent");
            xb_add(&bar[XB_XGEN(b.x)], 1u);
            asm volatile("s_waitcnt vmcnt(0)" ::: "memory");
        } else {
            XB_SPIN(xb_ld(&bar[XB_XGEN(b.x)]) == gen, bar);
            __builtin_amdgcn_fence(__ATOMIC_ACQUIRE, "agent");
            asm volatile("s_waitcnt vmcnt(0)" ::: "memory");
        }
    }
    __syncthreads();
}

#ifndef PH_MASK
#define PH_MASK 0xFFF
#endif
#define PH_ON(k) (((PH_MASK) >> (k)) & 1)
struct Args { const float* in[19]; float* out; unsigned char* ws; int ph_lo, ph_hi; };

__device__ __forceinline__ float wave_sum(float v) {
#pragma unroll
    for (int o = 1; o < 64; o <<= 1) v += __shfl_xor(v, o);
    return v;
}
__device__ __forceinline__ int map_row(int mode, int n) {
    switch (mode) {
        case 1: return (n >> 7) * 256 + (n & 127);
        case 2: return (n >> 7) * 256 + 128 + (n & 127);
        case 3: { if (n < 512) return 512 + n; const int j = n - 512; return 1024 + 2 * (j & 31) + (j >> 5); }
        case 4: { const int h = n / 192, d = n % 192; if (d < 128) return h * 128 + d; const int j = d - 128; return 2048 + h * 64 + 2 * (j & 31) + (j >> 5); }
        case 5: { const int h = n >> 8, d = n & 255; return d < 128 ? h * 128 + d : 2048 + h * 128 + (d - 128); }
        default: return n;
    }
}
__device__ __forceinline__ void transpose_item(const float* W, int K, int N, bf16_t* WT, int mode, const float* ks, const float* cs, LAS float* scr, int item, int lane) {
    const int nblk = N / 64, kb = item / nblk, nb = item % nblk, k0 = 64 * kb, n0 = 64 * nb;
    const int lr = lane >> 4, lc = (lane & 15) * 4;
    f32x4 v[16];
#pragma unroll
    for (int i = 0; i < 16; ++i) v[i] = *(const f32x4*)(W + (size_t)(k0 + 4 * i + lr) * N + n0 + lc);
#pragma unroll
    for (int i = 0; i < 16; ++i) { const int kk = 4 * i + lr; f32x4 t = v[i]; if (ks) t = t * ks[k0 + kk]; LAS float* d = scr + kk * 65 + lc; d[0] = t[0]; d[1] = t[1]; d[2] = t[2]; d[3] = t[3]; }
    asm volatile("s_waitcnt lgkmcnt(0)" ::: "memory");
    const int c = lane & 7;
#pragma unroll
    for (int j = 0; j < 8; ++j) { const int n = (lane >> 3) + 8 * j; const LAS float* s = scr + (8 * c) * 65 + n; const float csn = cs ? cs[n0 + n] : 1.f;
        u32x4 o; o.x = cvt_pk_bf16(s[0 * 65] * csn, s[1 * 65] * csn); o.y = cvt_pk_bf16(s[2 * 65] * csn, s[3 * 65] * csn); o.z = cvt_pk_bf16(s[4 * 65] * csn, s[5 * 65] * csn); o.w = cvt_pk_bf16(s[6 * 65] * csn, s[7 * 65] * csn);
        *(u32x4*)(WT + (size_t)map_row(mode, n0 + n) * K + k0 + 8 * c) = o; }
    asm volatile("s_waitcnt lgkmcnt(0)" ::: "memory");
}

template <int W>
__device__ __forceinline__ void pool_chunk(const float* x, bf16_t* B0, int t0, int tin0, int wave, int lane, LAS float* part) {
    const int c0 = wave * 256 + lane * 4; const float* xc = x + c0;
    f32x4 ring[16], s = {0.f, 0.f, 0.f, 0.f};
#pragma unroll
    for (int k = 0; k < 16; ++k) ring[k] = (f32x4){0.f, 0.f, 0.f, 0.f};
    int pb = 0;
#pragma unroll 1
    for (int g2 = (tin0 ? -1 : 0); g2 < 8; ++g2) {
#pragma unroll
        for (int half = 0; half < 2; ++half) { const int tb = t0 + 16 * g2 + 8 * half;
            f32x4 xv[8];
#pragma unroll
            for (int k = 0; k < 8; ++k) xv[k] = *(const f32x4*)(xc + (size_t)(tb + k) * DM);
            float sq[8];
#pragma unroll
            for (int k = 0; k < 8; ++k) sq[k] = wave_sum(sq4(xv[k]));
            if (lane == 0) {
#pragma unroll
                for (int k = 0; k < 8; ++k) part[pb * 64 + k * 8 + wave] = sq[k]; }
            __syncthreads();
            float rs[8];
#pragma unroll
            for (int k = 0; k < 8; ++k) { const f32x4 pa = *(const LAS f32x4*)(part + pb * 64 + k * 8), pc = *(const LAS f32x4*)(part + pb * 64 + k * 8 + 4);
                rs[k] = __builtin_amdgcn_rsqf((((pa[0] + pa[1]) + (pa[2] + pa[3])) + ((pc[0] + pc[1]) + (pc[2] + pc[3]))) * (1.f / DM) + EPS); }
            pb ^= 1;
#pragma unroll
            for (int k = 0; k < 8; ++k) { const int p = 8 * half + k; const f32x4 h = xv[k] * rs[k]; ring[p] = h; s += h;
                if (g2 >= 0) { const int tin = tin0 + 16 * g2 + p, cnt = tin + 1 < W ? tin + 1 : W; const f32x4 d = s * __builtin_amdgcn_rcpf((float)cnt) - h;
                    u32x2 o; o.x = cvt_pk_bf16(d[0], d[1]); o.y = cvt_pk_bf16(d[2], d[3]); *(u32x2*)(B0 + (size_t)(t0 + 16 * g2 + p) * DM + c0) = o; }
                s -= ring[(p - W + 1) & 15]; }
        }
    }
}

__global__ void __launch_bounds__(512, 2) yoco_fwd(Args a) {
    extern __shared__ __attribute__((aligned(16))) unsigned char lds[];
    cg::grid_group grid = cg::this_grid();
    const int tid = threadIdx.x, lane = tid & 63, wave = __builtin_amdgcn_readfirstlane(tid >> 6);
    const int G = gridDim.x, bx = blockIdx.x, vcu = (G % 8 == 0) ? (bx % 8) * (G / 8) + bx / 8 : bx;
    const int gw = vcu * 8 + wave, NGW = G * 8;
    unsigned char* ws = a.ws;
    const float* x = a.in[0]; const int* positions = (const int*)a.in[1];
    float* out = a.out;
    float* rstd0 = (float*)(ws + WS_RSTD0); float* ssq = (float*)(ws + WS_SSQ); float* sskv = (float*)(ws + WS_SSKV); float* ss = (float*)(ws + WS_SS); float* cs = (float*)(ws + WS_CS);
    bf16_t* Wpool = (bf16_t*)(ws + WS_WPOOL); bf16_t* Wa = (bf16_t*)(ws + WS_WA); bf16_t* Wqb = (bf16_t*)(ws + WS_WQB); bf16_t* Wkvb = (bf16_t*)(ws + WS_WKVB); bf16_t* Wo = (bf16_t*)(ws + WS_WO);
    bf16_t* B0 = (bf16_t*)(ws + WS_B0); bf16_t* B1 = (bf16_t*)(ws + WS_B1); bf16_t* QA = (bf16_t*)(ws + WS_QA); bf16_t* KVA = (bf16_t*)(ws + WS_KVA);
    bf16_t* Qb = (bf16_t*)(ws + WS_Q); bf16_t* Kb = (bf16_t*)(ws + WS_K); bf16_t* Vb = (bf16_t*)(ws + WS_V); bf16_t* MID = (bf16_t*)(ws + WS_MID);
    LAS unsigned char* ldsl = (LAS unsigned char*)lds;
    const int lo = a.ph_lo, hi = a.ph_hi;
    volatile LAS unsigned* bst = (volatile LAS unsigned*)(ldsl + LDS_BYTES - 64);
    if (tid == 0) { bst[0] = 0u; bst[1] = 0u; }
    __syncthreads();
    if (bx == 0) for (int u = tid; u < XCD_BAR_WORDS; u += 512) __hip_atomic_store((unsigned*)(ws + WS_BAR) + u, 0u, __ATOMIC_RELAXED, __HIP_MEMORY_SCOPE_AGENT);
    XcdBarrier xbar; xbar.bar = (unsigned*)(ws + WS_BAR); xbar.x = 0; xbar.st = bst;
#define IN(k) (lo <= (k) && (k) < hi)
#define SEAM(k) do { if (IN(k) && IN((k) + 1)) { if ((k) == 1) grid.sync(); else xcd_barrier(xbar); } } while (0)

    if (PH_ON(0) && IN(0)) {
        LAS float* scr = (LAS float*)(ldsl + wave * 16640);
        constexpr int I_POOL = 8 * 8, I_GU = 32 * 88, I_DN = 88 * 32, I_QA = 32 * 8, I_KVA = 32 * 9, I_QB = 8 * 48, I_KVB = 8 * 64, I_WO = 32 * 32;
        constexpr int NITEMS = 4 * I_POOL + 2 * (2 * I_GU + I_DN) + I_QA + I_KVA + I_QB + I_KVB + I_WO;
        for (int it = gw; it < NITEMS; it += NGW) {
            int r = it;
#define JOB(cnt, W_, K_, N_, dst_, mode_, ks_, cs_) if (r < (cnt)) { transpose_item(W_, K_, N_, dst_, mode_, ks_, cs_, scr, r, lane); continue; } r -= (cnt);
            JOB(I_POOL, a.in[3] + 0 * 262144, 512, 512, Wpool + 0 * 262144, 0, a.in[2] + 0, a.in[4] + 0)
            JOB(I_POOL, a.in[3] + 1 * 262144, 512, 512, Wpool + 1 * 262144, 0, a.in[2] + 512, a.in[4] + 512)
            JOB(I_POOL, a.in[3] + 2 * 262144, 512, 512, Wpool + 2 * 262144, 0, a.in[2] + 1024, a.in[4] + 1024)
            JOB(I_POOL, a.in[3] + 3 * 262144, 512, 512, Wpool + 3 * 262144, 0, a.in[2] + 1536, a.in[4] + 1536)
            JOB(I_GU, a.in[15], DM, DFF, (bf16_t*)(ws + WS_WGU0), 1, a.in[14], nullptr)
            JOB(I_GU, a.in[16], DM, DFF, (bf16_t*)(ws + WS_WGU0), 2, a.in[14], nullptr)
            JOB(I_DN, a.in[17], DFF, DM, (bf16_t*)(ws + WS_WDN0), 0, nullptr, nullptr)
            JOB(I_GU, a.in[15] + (size_t)DM * DFF, DM, DFF, (bf16_t*)(ws + WS_WGU1), 1, a.in[14] + DM, nullptr)
            JOB(I_GU, a.in[16] + (size_t)DM * DFF, DM, DFF, (bf16_t*)(ws + WS_WGU1), 2, a.in[14] + DM, nullptr)
            JOB(I_DN, a.in[17] + (size_t)DM * DFF, DFF, DM, (bf16_t*)(ws + WS_WDN1), 0, nullptr, nullptr)
            JOB(I_QA, a.in[10], DM, 512, Wa, 0, a.in[9], nullptr)
            JOB(I_KVA, a.in[6], DM, 576, Wa, 3, a.in[5], nullptr)
            JOB(I_QB, a.in[12], 512, 3072, Wqb, 4, a.in[11], nullptr)
            JOB(I_KVB, a.in[8], 512, 4096, Wkvb, 5, a.in[7], nullptr)
            JOB(I_WO, a.in[13], DM, DM, Wo, 0, nullptr, nullptr)
#undef JOB
        }
        for (int m = gw * 2 + (lane >> 5); m < T; m += NGW * 2) {
            const int i = lane & 31;
            const float invf = (float)exp2(-(double)i * (13.287712379549449 / 32.0));
            const float ang = (float)positions[m] * invf;
            double rev = (double)ang * 0.15915494309189535; rev -= rint(rev);
            const float rf = (float)rev;
            *(f32x2*)(cs + ((size_t)m * 32 + i) * 2) = (f32x2){__builtin_amdgcn_cosf(rf), __builtin_amdgcn_sinf(rf)};
        }
    }
    if (PH_ON(1) && IN(1)) {
        LAS float* part = (LAS float*)(ldsl + 140000);
        for (int chunk = vcu; chunk < T / 128; chunk += G) {
            const int t0 = chunk * 128, tin0 = t0 & (SEQ - 1);
            switch (wave >> 1) {
                case 0: pool_chunk<2>(x, B0, t0, tin0, wave, lane, part); break;
                case 1: pool_chunk<4>(x, B0, t0, tin0, wave, lane, part); break;
                case 2: pool_chunk<8>(x, B0, t0, tin0, wave, lane, part); break;
                default: pool_chunk<16>(x, B0, t0, tin0, wave, lane, part); break;
            }
            __syncthreads();
        }
    }
    SEAM(1);
    xbar = xcd_barrier_post((unsigned*)(ws + WS_BAR), bst);
    if (PH_ON(2) && IN(2)) {
        pg8::Gemm g{B0, Wpool, DM, 512, 512, 512, 262144}; pg8::Order S; S.init(T, 512, 4, G, bx);
        pg8::EpiResid E{x, nullptr, B1, ss, 512};
        pg8::gemm_phase(ldsl, g, S, E);
    }
    SEAM(2);
    if (PH_ON(3) && IN(3)) {
        pg8::Gemm g{B1, (const bf16_t*)(ws + WS_WGU0), DM, DM, DM, 0, 0}; pg8::Order S; S.init(T, 2 * DFF, 1, G, bx);
        pg8::EpiSwiGLU E{MID, ss};
#ifndef REP3
#define REP3 1
#endif
        for (int rep3 = 0; rep3 < REP3; ++rep3) pg8::gemm_phase(ldsl, g, S, E);
    }
    SEAM(3);
    if (PH_ON(4) && IN(4)) {
        pg8::Gemm g{MID, (const bf16_t*)(ws + WS_WDN0), DFF, DFF, DFF, 0, 0}; pg8::Order S; S.init(T, DM, 1, G, bx);
        pg8::EpiResid E{nullptr, B1, B0, ss, 0};
        pg8::gemm_phase(ldsl, g, S, E);
    }
    SEAM(4);
    if (PH_ON(5) && IN(5)) {
        pg8::Gemm g{B0, Wa, DM, DM, DM, 0, 0}; pg8::Order S; S.init(T, 1280, 1, G, bx);
        pg8::EpiA E{ss, QA, KVA, ssq, sskv, Kb, cs};
        pg8::gemm_phase(ldsl, g, S, E);
    }
    SEAM(5);
    if (PH_ON(6) && IN(6)) {
        { pg8::Gemm g{QA, Wqb, 512, 512, 512, 0, 0}; pg8::Order S; S.init(T, 3072, 1, G, bx);
          pg8::EpiQ E{ssq, Qb, cs}; pg8::gemm_phase(ldsl, g, S, E); }
        { pg8::Gemm g{KVA, Wkvb, 512, 512, 512, 0, 0}; pg8::Order S; S.init(T, 4096, 1, G, bx);
          pg8::EpiKV E{sskv, Kb, Vb}; pg8::gemm_phase(ldsl, g, S, E); }
    }
    SEAM(6);
    if (PH_ON(7) && IN(7)) {
#ifndef REP7
#define REP7 1
#endif
        for (int rep7 = 0; rep7 < REP7; ++rep7)
        for (int sid = vcu; sid < 256; sid += G) att::attn_stream(Qb, Kb, Vb, B1, sid, (char*)lds);
    }
    SEAM(7);
    if (PH_ON(8) && IN(8)) {
        pg8::Gemm g{B1, Wo, DM, DM, DM, 0, 0}; pg8::Order S; S.init(T, DM, 1, G, bx);
        pg8::EpiResid E{nullptr, B0, B0, ss, 0};
        pg8::gemm_phase(ldsl, g, S, E);
    }
    SEAM(8);
    if (PH_ON(9) && IN(9)) {
        pg8::Gemm g{B0, (const bf16_t*)(ws + WS_WGU1), DM, DM, DM, 0, 0}; pg8::Order S; S.init(T, 2 * DFF, 1, G, bx);
        pg8::EpiSwiGLU E{MID, ss};
        pg8::gemm_phase(ldsl, g, S, E);
    }
    SEAM(9);
    if (PH_ON(10) && IN(10)) {
        pg8::Gemm g{MID, (const bf16_t*)(ws + WS_WDN1), DFF, DFF, DFF, 0, 0}; pg8::Order S; S.init(T, DM, 1, G, bx);
        pg8::EpiResid E{nullptr, B0, B0, ss, 0};
        pg8::gemm_phase(ldsl, g, S, E);
    }
    SEAM(10);
    if (PH_ON(11) && IN(11)) {
        const float* fg = a.in[18];
        for (int m = gw; m < T; m += NGW) {
            float s = lane < 32 ? ss[(size_t)m * 32 + lane] : 0.f; s = wave_sum(s);
            const float r = __builtin_amdgcn_rsqf(s * (1.f / DM) + EPS);
            const u32x4* xr = (const u32x4*)(B0 + (size_t)m * DM) + lane; f32x4* orow = (f32x4*)(out + (size_t)m * DM) + 2 * lane; const f32x4* gr = (const f32x4*)fg + 2 * lane;
#pragma unroll
            for (int j = 0; j < 4; ++j) { const u32x4 w = xr[64 * j];
                const f32x4 v0 = {__uint_as_float(w.x << 16), __uint_as_float(w.x & 0xffff0000u), __uint_as_float(w.y << 16), __uint_as_float(w.y & 0xffff0000u)};
                const f32x4 v1 = {__uint_as_float(w.z << 16), __uint_as_float(w.z & 0xffff0000u), __uint_as_float(w.w << 16), __uint_as_float(w.w & 0xffff0000u)};
                orow[128 * j] = v0 * r * gr[128 * j]; orow[128 * j + 1] = v1 * r * gr[128 * j + 1]; }
        }
    }
#undef IN
#undef SEAM
}

extern "C" void kernel_launch(void* const* d_in, const int* in_sizes, int n_in, void* d_out, int out_size, void* d_ws, size_t ws_size, hipStream_t stream) {
    static int grid = 0;
    if (grid == 0) {
        if (n_in != 19 || in_sizes[0] != T * DM || out_size != T * DM || ws_size < WS_END) { fprintf(stderr, "kernel_launch: shape/workspace mismatch (n_in %d, in0 %d, out %d, ws %zu < %zu)\n", n_in, n_in > 0 ? in_sizes[0] : -1, out_size, ws_size, (size_t)WS_END); grid = -1; return; }
        int dev = 0, cus = 0, per_cu = 0;
        (void)hipGetDevice(&dev); (void)hipDeviceGetAttribute(&cus, hipDeviceAttributeMultiprocessorCount, dev);
        if (hipFuncSetAttribute((const void*)yoco_fwd, hipFuncAttributeMaxDynamicSharedMemorySize, LDS_BYTES) != hipSuccess) { fprintf(stderr, "kernel_launch: hipFuncSetAttribute failed\n"); grid = -1; return; }
        if (hipOccupancyMaxActiveBlocksPerMultiprocessor(&per_cu, (const void*)yoco_fwd, 512, LDS_BYTES) != hipSuccess || per_cu < 1) { fprintf(stderr, "kernel_launch: occupancy query says %d\n", per_cu); per_cu = 1; }
        (void)hipGetLastError();
        grid = cus * per_cu;
        if (grid <= 0) grid = 256;
    }
    if (grid < 0) return;
    Args a{};
    for (int i = 0; i < 19; ++i) a.in[i] = (const float*)d_in[i];
    a.out = (float*)d_out; a.ws = (unsigned char*)d_ws; a.ph_lo = 0; a.ph_hi = 12;
    void* args[] = {&a};
    hipError_t e = hipLaunchCooperativeKernel((const void*)yoco_fwd, dim3(grid), dim3(512), args, LDS_BYTES, stream);
    if (e != hipSuccess) fprintf(stderr, "cooperative launch failed: %s (grid %d)\n", hipGetErrorString(e), grid);
}
```

```cpp
#include <hip/hip_runtime.h>
#include <hip/hip_cooperative_groups.h>
#include <cstdio>
#include <cstdint>
namespace cg = cooperative_groups;

#define LAS __attribute__((address_space(3)))
typedef unsigned short bf16_t;
typedef short bf16x8 __attribute__((ext_vector_type(8)));
typedef short s16x4 __attribute__((ext_vector_type(4)));
typedef float f32x2 __attribute__((ext_vector_type(2)));
typedef float f32x4 __attribute__((ext_vector_type(4)));
typedef float f32x16 __attribute__((ext_vector_type(16)));
typedef unsigned u32x2 __attribute__((ext_vector_type(2)));
typedef unsigned u32x4 __attribute__((ext_vector_type(4)));

constexpr int DM = 2048, NB = 4, SEQ = 8192, T = NB * SEQ, DFF = 5632, NH = 16;
constexpr float EPS = 1e-6f;
constexpr float C2Q = 0.07216878364870322f * 1.4426950408889634f;

__device__ __forceinline__ unsigned cvt_pk_bf16(float lo, float hi) { unsigned r; asm volatile("v_cvt_pk_bf16_f32 %0, %1, %2" : "=v"(r) : "v"(lo), "v"(hi)); return r; }
__device__ __forceinline__ u32x4 pack8(f32x4 a, f32x4 b) { u32x4 w; w.x = cvt_pk_bf16(a[0], a[1]); w.y = cvt_pk_bf16(a[2], a[3]); w.z = cvt_pk_bf16(b[0], b[1]); w.w = cvt_pk_bf16(b[2], b[3]); return w; }
__device__ __forceinline__ float sq4(f32x4 v) { return (v[0] * v[0] + v[1] * v[1]) + (v[2] * v[2] + v[3] * v[3]); }

namespace pg8 {
constexpr int BM = 256, BK = 64, HALF = 128, HTB = HALF * BK * 2, STAGE_BYTES = 8 * HTB, NXCD = 8, WGM = 8;
__host__ __device__ __forceinline__ int lds_byte(int r, int c) { const int st = (r >> 4) * 2 + (c >> 5), rr = r & 15, cc = c & 31, ob = rr * 64 + cc * 2; return st * 1024 + (ob ^ (((ob >> 9) & 1) << 5)); }
__host__ __device__ __forceinline__ void stage_rc(int b, int& R, int& C) { const int st = b / 1024, sb = b % 1024, swz = sb ^ (((sb >> 9) & 1) << 5); R = (st >> 1) * 16 + swz / 64; C = (st & 1) * 32 + (swz % 64) / 2; }
__host__ __device__ __forceinline__ int perm32(int rho) { const int n = rho >> 4, i = rho & 15; return 8 * (i >> 2) + 4 * n + (i & 3); }

struct Unit { int pm, pn, grp; };
struct Gemm { const bf16_t* A; const bf16_t* Bt; int lda, ldb, K; long grpA, grpB; };

struct Order {
    int nM, nN, nwg, nG, G, c;
    __device__ void init(int M, int N, int nG_, int G_, int c_) { nM = M / BM; nN = N / BM; nwg = nM * nN; nG = nG_; G = G_; c = c_; }
    __device__ bool next(int i, Unit& u) const {
        const long L = (long)i * G + c; if (L >= (long)nwg * nG) return false;
        u.grp = (int)(L / nwg); int wgid = (int)(L % nwg);
        { const int q = nwg / NXCD, r = nwg % NXCD, xcd = wgid % NXCD, off = wgid / NXCD; wgid = (xcd < r ? xcd * (q + 1) : r * (q + 1) + (xcd - r) * q) + off; }
        const int nig = WGM * nN, gid = wgid / nig, fm = gid * WGM, gsz = (nM - fm) < WGM ? (nM - fm) : WGM;
        u.pm = fm + ((wgid % nig) % gsz); u.pn = (wgid % nig) / gsz; return true;
    }
};

template <class Epi>
__device__ __forceinline__ void gemm_phase(LAS unsigned char* lds, const Gemm g, const Order& S, const Epi& E) {
    const int tid = threadIdx.x, wid = __builtin_amdgcn_readfirstlane(tid >> 6), lane = tid & 63, wr = wid >> 2, wc = wid & 3, fr = lane & 15, fq = lane >> 4;
    const int K = g.K, nt = K / BK;
    unsigned voffA[2], voffB[2];
#pragma unroll
    for (int i = 0; i < 2; ++i) { int R, C; stage_rc(tid * 16 + i * 8192, R, C); const int Rb = (R & ~31) + perm32(R & 31);
        voffA[i] = (unsigned)(R * g.lda + C) * 2u; voffB[i] = (unsigned)(Rb * g.ldb + C) * 2u; }
    const size_t kstep = (size_t)(BK * 2);
    const size_t hstepA = (size_t)HALF * g.lda * 2, hstepB = (size_t)HALF * g.ldb * 2;
    const size_t tstepA = 2 * hstepA, tstepB = 2 * hstepB;
    const unsigned ldsw = (unsigned)wid * 1024u;
    const int aoff = lds_byte(wr * 64 + fr, fq * 8), boff = lds_byte(wc * 32 + fr, fq * 8);
#define PG8_SA(b, h) (((b) * 2 + (h)) * HTB)
#define PG8_SB(b, h) ((4 + (b) * 2 + (h)) * HTB)
#define PG8_STAGE(bufoff, gbase, voff) do { _Pragma("unroll") for (int _i = 0; _i < 2; ++_i) \
        __builtin_amdgcn_global_load_lds((const unsigned*)((const char*)(gbase) + (voff)[_i]), (LAS unsigned*)(lds + (bufoff) + ldsw + _i * 8192), 16, 0, 0); } while (0)
#define PG8_LDA(dst, b, h) do { _Pragma("unroll") for (int m = 0; m < 4; ++m) _Pragma("unroll") for (int k = 0; k < 2; ++k) dst[m][k] = *(const LAS bf16x8*)(lds + PG8_SA(b, h) + aoff + m * 2048 + k * 1024); } while (0)
#define PG8_LDB(dst, b, h) do { _Pragma("unroll") for (int n = 0; n < 2; ++n) _Pragma("unroll") for (int k = 0; k < 2; ++k) dst[n][k] = *(const LAS bf16x8*)(lds + PG8_SB(b, h) + boff + n * 2048 + k * 1024); } while (0)
#define PG8_MMA(ai, bj, At, Bt) do { __builtin_amdgcn_s_setprio(1); _Pragma("unroll") for (int m = 0; m < 4; ++m) _Pragma("unroll") for (int n = 0; n < 2; ++n) _Pragma("unroll") for (int k = 0; k < 2; ++k) \
        acc[ai][bj][m][n] = __builtin_amdgcn_mfma_f32_16x16x32_bf16(Bt[n][k], At[m][k], acc[ai][bj][m][n], 0, 0, 0); __builtin_amdgcn_s_setprio(0); } while (0)
#define PG8_WAIT_V(n) asm volatile("s_waitcnt vmcnt(" #n ")" ::: "memory")
#define PG8_WAIT_L(n) asm volatile("s_waitcnt lgkmcnt(" #n ")" ::: "memory")
#define PG8_BAR __builtin_amdgcn_s_barrier()
#define PG8_SCHED __builtin_amdgcn_sched_barrier(0)
    Unit cur, nxt; int ui = 0;
    if (!S.next(0, cur)) return;
    f32x4 acc[2][2][4][2];
#pragma unroll
    for (int a = 0; a < 2; ++a)
#pragma unroll
        for (int b = 0; b < 2; ++b)
#pragma unroll
            for (int m = 0; m < 4; ++m)
#pragma unroll
                for (int n = 0; n < 2; ++n) acc[a][b][m][n] = (f32x4){0.f, 0.f, 0.f, 0.f};
    bf16x8 At[4][2], B0[2][2], B1[2][2];
    const char* cA = (const char*)(g.A + (size_t)cur.grp * g.grpA) + (size_t)cur.pm * tstepA;
    const char* cB = (const char*)(g.Bt + (size_t)cur.grp * g.grpB) + (size_t)cur.pn * tstepB;
    PG8_STAGE(PG8_SB(0, 0), cB, voffB); PG8_STAGE(PG8_SB(0, 1), cB + hstepB, voffB); PG8_STAGE(PG8_SA(0, 0), cA, voffA); PG8_STAGE(PG8_SA(0, 1), cA + hstepA, voffA);
    if (wr == 1) PG8_BAR;
    PG8_WAIT_V(2); PG8_BAR;
    PG8_STAGE(PG8_SB(1, 0), cB + kstep, voffB); PG8_STAGE(PG8_SA(1, 0), cA + kstep, voffA); PG8_STAGE(PG8_SB(1, 1), cB + hstepB + kstep, voffB);
    PG8_WAIT_V(6); PG8_BAR;
    for (;;) {
        const bool has_next = S.next(ui + 1, nxt);
        const char* nA = has_next ? (const char*)(g.A + (size_t)nxt.grp * g.grpA) + (size_t)nxt.pm * tstepA : cA;
        const char* nB = has_next ? (const char*)(g.Bt + (size_t)nxt.grp * g.grpB) + (size_t)nxt.pn * tstepB : cB;
        for (int t = 0; t < nt; t += 2) {
            const bool last = (t == nt - 2);
            const char* a1 = cA + (size_t)(t + 1) * kstep;
            const char* a2 = last ? nA : cA + (size_t)(t + 2) * kstep; const char* b2 = last ? nB : cB + (size_t)(t + 2) * kstep;
            const char* a3 = a2 + kstep; const char* b3 = b2 + kstep;
            PG8_LDB(B0, 0, 0); PG8_LDB(B1, 0, 1); PG8_SCHED; PG8_LDA(At, 0, 0); PG8_STAGE(PG8_SA(1, 1), a1 + hstepA, voffA);
            PG8_WAIT_V(8); PG8_WAIT_L(0); PG8_BAR; PG8_MMA(0, 0, At, B0); PG8_MMA(0, 1, At, B1); PG8_BAR; PG8_SCHED;
            PG8_LDA(At, 0, 1); PG8_STAGE(PG8_SB(0, 0), b2, voffB); PG8_STAGE(PG8_SB(0, 1), b2 + hstepB, voffB); PG8_STAGE(PG8_SA(0, 0), a2, voffA);
            PG8_WAIT_V(8); PG8_WAIT_L(0); PG8_BAR; PG8_MMA(1, 0, At, B0); PG8_MMA(1, 1, At, B1); PG8_BAR; PG8_SCHED;
            PG8_LDB(B0, 1, 0); PG8_LDB(B1, 1, 1); PG8_SCHED; PG8_LDA(At, 1, 0); PG8_STAGE(PG8_SA(0, 1), a2 + hstepA, voffA);
            PG8_WAIT_V(8); PG8_WAIT_L(0); PG8_BAR; PG8_MMA(0, 0, At, B0); PG8_MMA(0, 1, At, B1); PG8_BAR; PG8_SCHED;
            PG8_LDA(At, 1, 1); PG8_STAGE(PG8_SB(1, 0), b3, voffB); PG8_STAGE(PG8_SB(1, 1), b3 + hstepB, voffB); PG8_STAGE(PG8_SA(1, 0), a3, voffA);
            PG8_WAIT_V(8); PG8_WAIT_L(0); PG8_BAR; PG8_MMA(1, 0, At, B0); PG8_MMA(1, 1, At, B1); PG8_BAR; PG8_SCHED;
        }
        if (wr == 0) PG8_BAR;
        E(acc, cur, wr, wc, fr, fq);
        if (!has_next) break;
#pragma unroll
        for (int a = 0; a < 2; ++a)
#pragma unroll
            for (int b = 0; b < 2; ++b)
#pragma unroll
                for (int m = 0; m < 4; ++m)
#pragma unroll
                    for (int n = 0; n < 2; ++n) acc[a][b][m][n] = (f32x4){0.f, 0.f, 0.f, 0.f};
        cur = nxt; cA = nA; cB = nB; ++ui;
        if (wr == 1) PG8_BAR;
    }
    PG8_WAIT_V(0);
    PG8_BAR;
#undef PG8_SA
#undef PG8_SB
#undef PG8_STAGE
#undef PG8_LDA
#undef PG8_LDB
#undef PG8_MMA
#undef PG8_WAIT_V
#undef PG8_WAIT_L
#undef PG8_BAR
#undef PG8_SCHED
}

template <int NP> __device__ __forceinline__ float row_rstd(const float* ss, int row, int fq, float invn) {
    const float* p = ss + (size_t)row * NP + fq * (NP / 4); float s;
    if constexpr (NP == 32) { const f32x4 a = *(const f32x4*)p, b = *(const f32x4*)(p + 4); s = ((a[0] + a[1]) + (a[2] + a[3])) + ((b[0] + b[1]) + (b[2] + b[3])); }
    else { const f32x2 a = *(const f32x2*)p; s = a[0] + a[1]; }
    s += __shfl_xor(s, 16); s += __shfl_xor(s, 32);
    return __builtin_amdgcn_rsqf(s * invn + EPS);
}
__device__ __forceinline__ float rowsum4(float q) { q += __shfl_xor(q, 16); q += __shfl_xor(q, 32); return q; }

struct EpiResid {
    const float* basf; const bf16_t* basb; bf16_t* xb; float* ss; int colgrp;
    __device__ __forceinline__ void operator()(const f32x4 (&acc)[2][2][4][2], const Unit& u, int wr, int wc, int fr, int fq) const {
        const int row0 = u.pm * BM + wr * 64 + fr, colb = u.grp * colgrp + u.pn * BM, col0 = colb + wc * 32 + 8 * fq, pidx = (colb >> 6) + wc;
        f32x4 pre[3][4];
#define RB_LOAD(it, P) do { const size_t off_ = (size_t)(row0 + ((it) >> 2) * HALF + ((it) & 3) * 16) * DM + col0; \
        if (basf) { P[0] = *(const f32x4*)(basf + off_); P[1] = *(const f32x4*)(basf + off_ + 4); P[2] = *(const f32x4*)(basf + off_ + HALF); P[3] = *(const f32x4*)(basf + off_ + HALF + 4); } \
        else { const u32x4 w0_ = *(const u32x4*)(basb + off_), w1_ = *(const u32x4*)(basb + off_ + HALF); \
               P[0] = (f32x4){__uint_as_float(w0_.x << 16), __uint_as_float(w0_.x & 0xffff0000u), __uint_as_float(w0_.y << 16), __uint_as_float(w0_.y & 0xffff0000u)}; \
               P[1] = (f32x4){__uint_as_float(w0_.z << 16), __uint_as_float(w0_.z & 0xffff0000u), __uint_as_float(w0_.w << 16), __uint_as_float(w0_.w & 0xffff0000u)}; \
               P[2] = (f32x4){__uint_as_float(w1_.x << 16), __uint_as_float(w1_.x & 0xffff0000u), __uint_as_float(w1_.y << 16), __uint_as_float(w1_.y & 0xffff0000u)}; \
               P[3] = (f32x4){__uint_as_float(w1_.z << 16), __uint_as_float(w1_.z & 0xffff0000u), __uint_as_float(w1_.w << 16), __uint_as_float(w1_.w & 0xffff0000u)}; } } while (0)
        RB_LOAD(0, pre[0]); RB_LOAD(1, pre[1]);
#pragma unroll
        for (int it = 0; it < 8; ++it) { const int ai = it >> 2, m = it & 3, row = row0 + ai * HALF + m * 16; const size_t off = (size_t)row * DM + col0; float q = 0.f;
            if (it + 2 < 8) RB_LOAD(it + 2, pre[(it + 2) % 3]);
#pragma unroll
            for (int bj = 0; bj < 2; ++bj) {
                const f32x4 v0 = acc[ai][bj][m][0] + pre[it % 3][2 * bj], v1 = acc[ai][bj][m][1] + pre[it % 3][2 * bj + 1];
                *(u32x4*)(xb + off + bj * HALF) = pack8(v0, v1);
                q += sq4(v0) + sq4(v1); }
            q = rowsum4(q); if (fq == 0) ss[(size_t)row * 32 + pidx] = q; }
#undef RB_LOAD
    }
};
struct EpiSwiGLU {
    bf16_t* mid; const float* ss;
    __device__ __forceinline__ void operator()(const f32x4 (&acc)[2][2][4][2], const Unit& u, int wr, int wc, int fr, int fq) const {
        const int row0 = u.pm * BM + wr * 64 + fr, col0 = u.pn * HALF + wc * 32 + 8 * fq;
#pragma unroll
        for (int ai = 0; ai < 2; ++ai)
#pragma unroll
            for (int m = 0; m < 4; ++m) { const int row = row0 + ai * HALF + m * 16; const float s = row_rstd<32>(ss, row, fq, 1.f / DM);
                const float sneg = -1.4426950408889634f * s, s2 = s * s; unsigned w[4];
#pragma unroll
                for (int n = 0; n < 2; ++n)
#pragma unroll
                    for (int e = 0; e < 2; ++e) { const f32x2 gg = {acc[ai][0][m][n][2 * e], acc[ai][0][m][n][2 * e + 1]}, uu = {acc[ai][1][m][n][2 * e], acc[ai][1][m][n][2 * e + 1]};
                        const f32x2 t = gg * sneg; f32x2 d; d.x = __builtin_amdgcn_exp2f(t.x); d.y = __builtin_amdgcn_exp2f(t.y); d = d + 1.0f;
                        f32x2 r; r.x = __builtin_amdgcn_rcpf(d.x); r.y = __builtin_amdgcn_rcpf(d.y);
                        const f32x2 h = (gg * uu) * (r * s2); w[2 * n + e] = cvt_pk_bf16(h.x, h.y); }
                *(u32x4*)(mid + (size_t)row * DFF + col0) = (u32x4){w[0], w[1], w[2], w[3]}; }
    }
};
__device__ __forceinline__ void rope8(f32x4& v0, f32x4& v1, const float* cs  ) {
    const f32x4 c0 = *(const f32x4*)cs, c1 = *(const f32x4*)(cs + 4);
    const f32x4 a = v0, b = v1;
    v0 = (f32x4){a[0] * c0[0] - a[1] * c0[1], a[1] * c0[0] + a[0] * c0[1], a[2] * c0[2] - a[3] * c0[3], a[3] * c0[2] + a[2] * c0[3]};
    v1 = (f32x4){b[0] * c1[0] - b[1] * c1[1], b[1] * c1[0] + b[0] * c1[1], b[2] * c1[2] - b[3] * c1[3], b[3] * c1[2] + b[2] * c1[3]};
}
struct EpiA {
    const float* ss; bf16_t* qa; bf16_t* kva; float* ssq; float* sskv; bf16_t* Kb; const float* cs;
    __device__ __forceinline__ void operator()(const f32x4 (&acc)[2][2][4][2], const Unit& u, int wr, int wc, int fr, int fq) const {
        const int row0 = u.pm * BM + wr * 64 + fr;
        if (u.pn < 4) {
            bf16_t* dst = u.pn < 2 ? qa : kva; float* sso = u.pn < 2 ? ssq : sskv; const int colb = (u.pn & 1) * BM, col0 = colb + wc * 32 + 8 * fq, pidx = (u.pn & 1) * 4 + wc;
#pragma unroll
            for (int ai = 0; ai < 2; ++ai)
#pragma unroll
                for (int m = 0; m < 4; ++m) { const int row = row0 + ai * HALF + m * 16; const float s = row_rstd<32>(ss, row, fq, 1.f / DM); float q = 0.f;
#pragma unroll
                    for (int bj = 0; bj < 2; ++bj) { const f32x4 v0 = acc[ai][bj][m][0] * s, v1 = acc[ai][bj][m][1] * s;
                        *(u32x4*)(dst + (size_t)row * 512 + col0 + bj * HALF) = pack8(v0, v1); q += sq4(v0) + sq4(v1); }
                    q = rowsum4(q); if (fq == 0) sso[(size_t)row * 8 + pidx] = q; }
        } else {
            const int p0 = wc * 32 + 8 * fq;
#pragma unroll
            for (int ai = 0; ai < 2; ++ai)
#pragma unroll
                for (int m = 0; m < 4; ++m) { const int row = row0 + ai * HALF + m * 16; const float s = row_rstd<32>(ss, row, fq, 1.f / DM);
                    if (wc < 2) { f32x4 v0 = acc[ai][0][m][0] * s, v1 = acc[ai][0][m][1] * s; rope8(v0, v1, cs + ((size_t)row * 32 + (p0 >> 1)) * 2);
                        const u32x4 w = pack8(v0, v1); bf16_t* kp = Kb + (size_t)row * 3072 + 128 + p0;
#pragma unroll
                        for (int h = 0; h < NH; ++h) *(u32x4*)(kp + h * 192) = w; } }
        }
    }
};
struct EpiQ {
    const float* ssq; bf16_t* Q; const float* cs;
    __device__ __forceinline__ void operator()(const f32x4 (&acc)[2][2][4][2], const Unit& u, int wr, int wc, int fr, int fq) const {
        const int row0 = u.pm * BM + wr * 64 + fr;
#pragma unroll
        for (int ai = 0; ai < 2; ++ai)
#pragma unroll
            for (int m = 0; m < 4; ++m) { const int row = row0 + ai * HALF + m * 16; const float s = row_rstd<8>(ssq, row, fq, 1.f / 512.f) * C2Q;
#pragma unroll
                for (int bj = 0; bj < 2; ++bj) { f32x4 v0 = acc[ai][bj][m][0] * s, v1 = acc[ai][bj][m][1] * s;
                    if (u.pn < 8) { *(u32x4*)(Q + (size_t)row * 3072 + (2 * u.pn + bj) * 192 + wc * 32 + 8 * fq) = pack8(v0, v1); }
                    else { const int head = 4 * (u.pn - 8) + 2 * bj + (wc >> 1), p0 = 32 * (wc & 1) + 8 * fq; rope8(v0, v1, cs + ((size_t)row * 32 + (p0 >> 1)) * 2);
                        *(u32x4*)(Q + (size_t)row * 3072 + head * 192 + 128 + p0) = pack8(v0, v1); } } }
    }
};
struct EpiKV {
    const float* sskv; bf16_t* Kb; bf16_t* Vb;
    __device__ __forceinline__ void operator()(const f32x4 (&acc)[2][2][4][2], const Unit& u, int wr, int wc, int fr, int fq) const {
        const int row0 = u.pm * BM + wr * 64 + fr;
#pragma unroll
        for (int ai = 0; ai < 2; ++ai)
#pragma unroll
            for (int m = 0; m < 4; ++m) { const int row = row0 + ai * HALF + m * 16; const float s = row_rstd<8>(sskv, row, fq, 1.f / 512.f);
#pragma unroll
                for (int bj = 0; bj < 2; ++bj) { const f32x4 v0 = acc[ai][bj][m][0] * s, v1 = acc[ai][bj][m][1] * s;
                    bf16_t* d = u.pn < 8 ? Kb + (size_t)row * 3072 + (2 * u.pn + bj) * 192 + wc * 32 + 8 * fq : Vb + (size_t)row * 2048 + (2 * (u.pn - 8) + bj) * 128 + wc * 32 + 8 * fq;
                    *(u32x4*)d = pack8(v0, v1); } }
    }
};
}

namespace att {
constexpr int NW = 8, QBLK = 32, KVBLK = 64, QB = 256;
constexpr int LDQ = 3072, LDK = 3072, LDV = 2048, LDO = 2048;
constexpr int KROWB = 400;
constexpr int SHM_K = KVBLK * KROWB, SHM_V = KVBLK * 128 * 2;
constexpr int NQR = 12;
constexpr int LDS_K0 = 3 * SHM_V, LDS_WS = LDS_K0 + 2 * SHM_K, LDS_QS = LDS_WS + NW * 64 * 4, LDS_TOTAL = LDS_QS + NW * (12 - NQR) * 1024;
constexpr float THR = 8.f;
#define SBAR() __builtin_amdgcn_sched_barrier(0)
__device__ __forceinline__ int v_st(int k, int c) { const int kk = (k & ~0xC) | ((k & 4) << 1) | ((k & 8) >> 1); return ((kk >> 3) * 4 + (c >> 5)) * 512 + ((kk & 7) * 32 + (c & 31)) * 2; }
__device__ __forceinline__ int v_rd_base(int lane) { return ((lane & 3) << 3) | (((lane >> 2) & 3) << 6) | (((lane >> 4) & 1) << 5) | (((lane >> 5) & 1) << 8); }
constexpr int v_rd_off(int d0, int ks, int half) { return d0 * 512 + ks * 4096 + half * 2048; }
__device__ __forceinline__ int crow(int r, int hi) { return (r & 3) + 8 * (r >> 2) + 4 * hi; }
__device__ __forceinline__ bf16x8 ldg8(const bf16_t* base, unsigned off) { return *reinterpret_cast<const bf16x8*>(base + off); }
__device__ __forceinline__ void mask_tile(f32x16& p0, f32x16& p1, int dq) {
    const float NEG = -__builtin_inff();
#pragma unroll
    for (int r = 0; r < 16; ++r) { const int c = (r & 3) + 8 * (r >> 2); if (dq - c < 0) p0[r] = NEG; if (dq - c - 32 < 0) p1[r] = NEG; }
}
__device__ __forceinline__ void qkt(f32x16& p0, f32x16& p1, const char* a, const char* qs, const bf16x8* qr, float negm) {
#pragma unroll
    for (int r = 0; r < 16; ++r) { p0[r] = negm; p1[r] = negm; }
    bf16x8 kA[3], kB[3], qv[3];
#define KL(d) do { kA[(d) % 3] = *reinterpret_cast<const bf16x8*>(a + (d) * 32); kB[(d) % 3] = *reinterpret_cast<const bf16x8*>(a + (d) * 32 + 32 * KROWB); \
        if ((d) >= NQR) qv[(d) % 3] = *reinterpret_cast<const bf16x8*>(qs + ((d) - NQR) * 1024); } while (0)
    KL(0); KL(1);
#pragma unroll
    for (int d0 = 0; d0 < 12; ++d0) {
        if (d0 + 2 < 12) KL(d0 + 2);
        SBAR();
        const bf16x8 q = d0 < NQR ? qr[d0 < NQR ? d0 : 0] : qv[d0 % 3];
        p0 = __builtin_amdgcn_mfma_f32_32x32x16_bf16(kA[d0 % 3], q, p0, 0, 0, 0);
        p1 = __builtin_amdgcn_mfma_f32_32x32x16_bf16(kB[d0 % 3], q, p1, 0, 0, 0);
        SBAR(); }
#undef KL
}
__device__ __forceinline__ void softmax_tile(f32x16& p0, f32x16& p1, float& m_reg, float& l_reg, float& alpha, bf16x8& pa0, bf16x8& pa1, bf16x8& pa2, bf16x8& pa3) {
    float pmax = fmaxf(p0[0], p1[0]);
#pragma unroll
    for (int r = 1; r < 16; ++r) pmax = fmaxf(fmaxf(pmax, p0[r]), p1[r]);
    { auto rr = __builtin_amdgcn_permlane32_swap(__float_as_uint(pmax), __float_as_uint(pmax), false, false); pmax = fmaxf(__uint_as_float(rr[0]), __uint_as_float(rr[1])); }
    alpha = 1.f;
    if (__builtin_expect(!__all(pmax <= THR), 0)) { const float dl = fmaxf(pmax, 0.f); m_reg += dl; alpha = __builtin_amdgcn_exp2f(-dl);
#pragma unroll
        for (int r = 0; r < 16; ++r) { p0[r] -= dl; p1[r] -= dl; } }
#pragma unroll
    for (int r = 0; r < 16; ++r) { p0[r] = __builtin_amdgcn_exp2f(p0[r]); p1[r] = __builtin_amdgcn_exp2f(p1[r]); }
    float ps = 0.f;
#pragma unroll
    for (int r = 0; r < 16; ++r) ps += p0[r] + p1[r];
    { auto rr = __builtin_amdgcn_permlane32_swap(__float_as_uint(ps), __float_as_uint(ps), false, false); ps = __uint_as_float(rr[0]) + __uint_as_float(rr[1]); }
    l_reg = l_reg * alpha + ps;
#define PK4(P, B_, OUT) do { unsigned a0 = cvt_pk_bf16(P[B_+0], P[B_+1]), a1 = cvt_pk_bf16(P[B_+2], P[B_+3]); \
        unsigned b0 = cvt_pk_bf16(P[B_+4], P[B_+5]), b1 = cvt_pk_bf16(P[B_+6], P[B_+7]); \
        auto r0 = __builtin_amdgcn_permlane32_swap(a0, b0, false, false); auto r1 = __builtin_amdgcn_permlane32_swap(a1, b1, false, false); \
        u32x4 w = {r0[0], r1[0], r0[1], r1[1]}; OUT = *reinterpret_cast<bf16x8*>(&w); } while (0)
    PK4(p0, 0, pa0); PK4(p0, 8, pa1); PK4(p1, 0, pa2); PK4(p1, 8, pa3);
#undef PK4
}
__device__ __forceinline__ void pv_tile(f32x16* o, int vb, bf16x8 pa0, bf16x8 pa1, bf16x8 pa2, bf16x8 pa3) {
#define TRRD(dst, off) asm volatile("ds_read_b64_tr_b16 %0, %1 offset:%2" : "=&v"(dst) : "v"(vb), "i"(off) : "memory")
#define TR8(S, d0) do { constexpr int b_ = v_rd_off(d0, 0, 0); TRRD(S##l0, b_); TRRD(S##h0, b_ + 2048); TRRD(S##l1, b_ + 4096); TRRD(S##h1, b_ + 6144); \
        TRRD(S##l2, b_ + 8192); TRRD(S##h2, b_ + 10240); TRRD(S##l3, b_ + 12288); TRRD(S##h3, b_ + 14336); } while (0)
#define MM4(S, d0) do { \
        o[d0] = __builtin_amdgcn_mfma_f32_32x32x16_bf16(pa0, (bf16x8){S##l0[0], S##l0[1], S##l0[2], S##l0[3], S##h0[0], S##h0[1], S##h0[2], S##h0[3]}, o[d0], 0, 0, 0); \
        o[d0] = __builtin_amdgcn_mfma_f32_32x32x16_bf16(pa1, (bf16x8){S##l1[0], S##l1[1], S##l1[2], S##l1[3], S##h1[0], S##h1[1], S##h1[2], S##h1[3]}, o[d0], 0, 0, 0); \
        o[d0] = __builtin_amdgcn_mfma_f32_32x32x16_bf16(pa2, (bf16x8){S##l2[0], S##l2[1], S##l2[2], S##l2[3], S##h2[0], S##h2[1], S##h2[2], S##h2[3]}, o[d0], 0, 0, 0); \
        o[d0] = __builtin_amdgcn_mfma_f32_32x32x16_bf16(pa3, (bf16x8){S##l3[0], S##l3[1], S##l3[2], S##l3[3], S##h3[0], S##h3[1], S##h3[2], S##h3[3]}, o[d0], 0, 0, 0); } while (0)
    s16x4 Al0, Al1, Al2, Al3, Ah0, Ah1, Ah2, Ah3, Bl0, Bl1, Bl2, Bl3, Bh0, Bh1, Bh2, Bh3;
    TR8(A, 0); TR8(B, 1);
    asm volatile("s_waitcnt lgkmcnt(8)" ::: "memory"); SBAR(); MM4(A, 0); SBAR();
    TR8(A, 2);
    asm volatile("s_waitcnt lgkmcnt(8)" ::: "memory"); SBAR(); MM4(B, 1); SBAR();
    TR8(B, 3);
    asm volatile("s_waitcnt lgkmcnt(8)" ::: "memory"); SBAR(); MM4(A, 2); SBAR();
    asm volatile("s_waitcnt lgkmcnt(0)" ::: "memory"); SBAR(); MM4(B, 3);
#undef MM4
#undef TR8
#undef TRRD
}
#define VMW() asm volatile("s_waitcnt vmcnt(0)" ::: "memory")
#define SLOAD(Kp, Vp) do { const bf16_t* vp_ = (Vp); st_v0 = ldg8(vp_, voff); st_v1 = ldg8(vp_ + 32 * LDV, voff); \
        const bf16_t* kp_ = (Kp); st_k0 = ldg8(kp_, koff); st_k1 = ldg8(kp_ + 64, koff); st_k2 = ldg8(kp_ + 128, koff); } while (0)
#define SWRITE(kb_, vb_) do { char* d_ = K_lds + (kb_) * SHM_K + kws; *(bf16x8*)d_ = st_k0; *(bf16x8*)(d_ + 128) = st_k1; *(bf16x8*)(d_ + 256) = st_k2; \
        *(bf16x8*)(V_lds + (vb_) * SHM_V + vst0) = st_v0; *(bf16x8*)(V_lds + (vb_) * SHM_V + vst1) = st_v1; } while (0)
#define BLK_BH(ii) (xcd * 8 + (ii))
#define BLK_QB(ii) (((ii) & 1) ? 31 - j : j)
#define TILEPTR(ii, nn, Kp, Vp) do { const int bh_ = BLK_BH(ii), qb_ = BLK_QB(ii), tl_ = ((ii) & 1) ? 4 * qb_ + 3 - (nn) : (nn); \
        const size_t row_ = (size_t)(bh_ >> 4) * SEQ + (size_t)tl_ * KVBLK; Kp = Kall + row_ * LDK + (bh_ & 15) * 192; Vp = Vall + row_ * LDV + (bh_ & 15) * 128; } while (0)
__device__ __forceinline__ void attn_stream(const bf16_t* Qall, const bf16_t* Kall, const bf16_t* Vall, bf16_t* Oall, int sid, char* lds) {
    const int xcd = sid >> 5, j = sid & 31;
    const int tid = threadIdx.x, wid = __builtin_amdgcn_readfirstlane(tid >> 6), lane = tid & 63, r32 = lane & 31, hi = lane >> 5;
    const int sr = tid >> 4, sc = (tid & 15) * 8, kr = tid >> 3;
    const unsigned voff = (unsigned)(sr * LDV + sc), koff = (unsigned)(kr * LDK + (tid & 7) * 8), qoff = (unsigned)((wid * QBLK + r32) * LDQ + hi * 8);
    const int kws = kr * KROWB + (tid & 7) * 16, vst0 = v_st(sr, sc), vst1 = v_st(32 + sr, sc);
    char* V_lds = lds; char* K_lds = lds + LDS_K0; char* qs = lds + LDS_QS + wid * ((12 - NQR) * 1024) + lane * 16;
    float* ws = (float*)(lds + LDS_WS) + wid * 64; float* li_l = ws, * al_l = ws + 32;
    const char* ka0 = K_lds + r32 * KROWB + hi * 16;
    const int vrb = (int)(uintptr_t)V_lds + v_rd_base(lane);
    const bool grpB = wid >= 4;
    if (wid >= 4) __builtin_amdgcn_s_setprio(1);
    bf16x8 st_v0, st_v1, st_k0, st_k1, st_k2;
    bf16x8 qr[NQR];
    f32x16 o[4], p0, p1; float m_reg, l_reg, al; bf16x8 pa0, pa1, pa2, pa3;
    const bf16_t* kp; const bf16_t* vp;
    { const int bh0 = BLK_BH(0); const bf16_t* Q0 = Qall + ((size_t)(bh0 >> 4) * SEQ + (size_t)BLK_QB(0) * QB) * LDQ + (bh0 & 15) * 192;
#pragma unroll
      for (int d0 = 0; d0 < NQR; ++d0) qr[d0] = ldg8(Q0 + d0 * 16, qoff);
#pragma unroll
      for (int d0 = NQR; d0 < 12; ++d0) *(bf16x8*)(qs + (d0 - NQR) * 1024) = ldg8(Q0 + d0 * 16, qoff);
#pragma unroll
      for (int d0 = 0; d0 < NQR; ++d0) asm volatile("" : "+v"(qr[d0]));
      TILEPTR(0, 0, kp, vp); SLOAD(kp, vp); VMW(); SWRITE(0, 0); }
    __syncthreads();
    if (grpB) { TILEPTR(0, 1, kp, vp); SLOAD(kp, vp); }
    int kb = 0, vb = 0;
    for (int i = 0; i < 8; ++i) {
        const int bh = BLK_BH(i), qb = BLK_QB(i), NT = 4 * qb + 4, qlo = qb * QB + wid * QBLK, qm = qlo + r32 - 4 * hi;
        const bool more = i < 7, desc = i & 1;
        m_reg = 0.f; l_reg = 0.f;
#pragma unroll
        for (int d = 0; d < 4; ++d) o[d] = f32x16{};
#define STEP(ACT) do { \
            const int t = desc ? NT - 1 - n : n; \
            const bool v1 = (n + 1 < NT) || more; bool v2 = true; if (n + 2 >= NT) v2 = more; \
            const int kb1 = kb ^ 1, vb1 = vb == 2 ? 0 : vb + 1; \
            if (!grpB && v1) { if (n + 1 < NT) TILEPTR(i, n + 1, kp, vp); else TILEPTR(i + 1, 0, kp, vp); SLOAD(kp, vp); } \
            if (ACT) { SBAR(); qkt(p0, p1, ka0 + kb * SHM_K, qs, qr, -m_reg); SBAR(); } \
            if (grpB) { if (v1) { VMW(); SWRITE(kb1, vb1); } __syncthreads(); \
                        if (v2) { if (n + 2 < NT) TILEPTR(i, n + 2, kp, vp); else TILEPTR(i + 1, n + 2 - NT, kp, vp); SLOAD(kp, vp); } } \
            if (ACT) { SBAR(); \
                { const int kb_ = t * KVBLK; if (kb_ + KVBLK - 1 > qlo) mask_tile(p0, p1, qm - kb_); } \
                softmax_tile(p0, p1, m_reg, l_reg, al, pa0, pa1, pa2, pa3); \
                if (__any(al < 1.f)) { if (hi == 0) al_l[r32] = al; asm volatile("s_waitcnt lgkmcnt(0)" ::: "memory"); \
                    _Pragma("unroll") for (int d_ = 0; d_ < 4; ++d_) _Pragma("unroll") for (int r = 0; r < 16; ++r) o[d_][r] *= al_l[crow(r, hi)]; } \
                SBAR(); pv_tile(o, vrb + vb * SHM_V, pa0, pa1, pa2, pa3); SBAR(); } \
            if (!grpB) { if (v1) { VMW(); SWRITE(kb1, vb1); } __syncthreads(); } \
            kb = kb1; vb = vb1; } while (0)
        const int NTa = 4 * qb + (wid >> 1) + 1;
        const int n0 = desc ? NT - NTa : 0, n1 = n0 + NTa;
        int n = 0;
        for (; n < n0; ++n) STEP(0);
        for (; n < n1; ++n) STEP(1);
        for (; n < NT; ++n) STEP(0);
#undef STEP
        {
            if (hi == 0) li_l[r32] = l_reg; asm volatile("s_waitcnt lgkmcnt(0)" ::: "memory");
            bf16_t* Ow = Oall + ((size_t)(bh >> 4) * SEQ + (size_t)qb * QB) * LDO + (bh & 15) * 128; unsigned ooff = (unsigned)((wid * QBLK + 4 * hi) * LDO + r32); asm volatile("" : "+v"(ooff));
#pragma unroll
            for (int r = 0; r < 16; ++r) { const int orow = (r & 3) + 8 * (r >> 2); const float rl = __builtin_amdgcn_rcpf(li_l[crow(r, hi)]);
#pragma unroll
                for (int d0 = 0; d0 < 4; ++d0) { const float v = o[d0][r] * rl; const float vn = __shfl_xor(v, 1);
                    if ((r32 & 1) == 0) *(unsigned*)(Ow + orow * LDO + d0 * 32 + ooff) = cvt_pk_bf16(v, vn); } }
            if (more) {
                const int bhn = BLK_BH(i + 1); const bf16_t* Qn = Qall + ((size_t)(bhn >> 4) * SEQ + (size_t)BLK_QB(i + 1) * QB) * LDQ + (bhn & 15) * 192;
#pragma unroll
                for (int d0 = 0; d0 < NQR; ++d0) qr[d0] = ldg8(Qn + d0 * 16, qoff);
#pragma unroll
                for (int d0 = NQR; d0 < 12; ++d0) *(bf16x8*)(qs + (d0 - NQR) * 1024) = ldg8(Qn + d0 * 16, qoff);
#pragma unroll
                for (int d0 = 0; d0 < NQR; ++d0) asm volatile("" : "+v"(qr[d0])); } }
    }
    __builtin_amdgcn_s_setprio(0);
    asm volatile("s_waitcnt vmcnt(0)" ::: "memory"); __syncthreads();
}
#undef BLK_BH
#undef BLK_QB
#undef TILEPTR
#undef VMW
#undef SLOAD
#undef SWRITE
#undef SBAR
}

constexpr size_t MiB = 1u << 20;
constexpr size_t WS_BAR = 7 * MiB, WS_RSTD0 = 0, WS_SSQ = 1 * MiB, WS_SSKV = 2 * MiB, WS_SS = 3 * MiB, WS_CS = 8 * MiB;
constexpr size_t WS_WPOOL = 16 * MiB, WS_WA = 18 * MiB, WS_WQB = 23 * MiB, WS_WKVB = 26 * MiB, WS_WO = 30 * MiB;
constexpr size_t WS_WGU0 = 38 * MiB, WS_WDN0 = 82 * MiB, WS_WGU1 = 104 * MiB, WS_WDN1 = 148 * MiB;
constexpr size_t WS_B0 = 170 * MiB, WS_B1 = 298 * MiB, WS_QA = 426 * MiB, WS_KVA = 458 * MiB;
constexpr size_t WS_Q = 490 * MiB, WS_K = 682 * MiB, WS_V = 874 * MiB, WS_MID = 490 * MiB, WS_END = 1002 * MiB;
constexpr int LDS_BYTES = 155648;
static_assert(att::LDS_TOTAL <= LDS_BYTES && pg8::STAGE_BYTES <= LDS_BYTES, "LDS map");

#define XB_TMO      128
#define XB_XCNT(j)  (256  + 64 * (j))
#define XB_XSUB(j)  (1280 + 64 * (j))
#define XB_XGEN(j)  (2304 + 64 * (j))
#define XB_TOP      3328
#define XB_TOPGEN   3392
#define XCD_BAR_WORDS 3456
#define XB_SPIN_CAP (1u << 18)
__device__ __forceinline__ unsigned xb_ld(unsigned* p)              { return __hip_atomic_load(p, __ATOMIC_RELAXED, __HIP_MEMORY_SCOPE_AGENT); }
__device__ __forceinline__ unsigned xb_add(unsigned* p, unsigned v) { return __hip_atomic_fetch_add(p, v, __ATOMIC_RELAXED, __HIP_MEMORY_SCOPE_AGENT); }
__device__ __forceinline__ unsigned xb_xcc_id() { return (unsigned)__builtin_amdgcn_s_getreg((3 << 11) | 20) & 0xFu; }
#define XB_SPIN(cond, bar) do { unsigned _sp = 0; while (cond) { __builtin_amdgcn_s_sleep(1); \
    if ((++_sp & 255u) == 0u) { if (xb_ld(&(bar)[XB_TMO])) break; if (_sp > XB_SPIN_CAP) { atomicAdd(&(bar)[XB_TMO], 1u); break; } } } } while (0)
struct XcdBarrier { unsigned* bar; unsigned x; volatile LAS unsigned* st; };
__device__ __forceinline__ XcdBarrier xcd_barrier_post(unsigned* bar, volatile LAS unsigned* st) {
    XcdBarrier b; b.bar = bar; b.x = xb_xcc_id(); b.st = st;
    if (threadIdx.x == 0) (void)xb_add(&bar[XB_XCNT(b.x)], 1u);
    return b;
}
__device__ __forceinline__ void xcd_barrier_complete(unsigned* bar, unsigned x, unsigned& nloc, unsigned& nx) {
    const unsigned G = gridDim.x * gridDim.y * gridDim.z;
    unsigned sum, cnt, mine, sp = 0u;
    for (;;) {
        sum = 0u; cnt = 0u; mine = 0u;
#pragma unroll
        for (unsigned j = 0; j < 16; ++j) { const unsigned c = xb_ld(&bar[XB_XCNT(j)]); sum += c; cnt += (c > 0u) ? 1u : 0u; mine = (j == x) ? c : mine; }
        if (sum == G) break;
        __builtin_amdgcn_s_sleep(1);
        if ((++sp & 255u) == 0u) { if (xb_ld(&bar[XB_TMO])) break; if (sp > XB_SPIN_CAP) { atomicAdd(&bar[XB_TMO], 1u); break; } }
    }
    nloc = mine > 0u ? mine : 1u; nx = cnt > 0u ? cnt : 1u;
}
__device__ __forceinline__ void xcd_barrier(const XcdBarrier& b) {
    asm volatile("s_waitcnt vmcnt(0)" ::: "memory");
    __syncthreads();
    if (threadIdx.x == 0) {
        unsigned* bar = b.bar;
        __builtin_amdgcn_s_waitcnt(0);
        unsigned nloc = b.st[0], nx = b.st[1];
        if (nloc == 0u) { xcd_barrier_complete(bar, b.x, nloc, nx); b.st[0] = nloc; b.st[1] = nx; }
        const unsigned old = xb_add(&bar[XB_XSUB(b.x)], 1u);
        const unsigned gen = old / nloc;
        if (old + 1u == (gen + 1u) * nloc) {
            __builtin_amdgcn_fence(__ATOMIC_RELEASE, "agent");
            asm volatile("s_waitcnt vmcnt(0)" ::: "memory");
            const unsigned og = xb_add(&bar[XB_TOP], 1u);
            const unsigned tg = og / nx;
            if (og + 1u == (tg + 1u) * nx) xb_add(&bar[XB_TOPGEN], 1u);
            else XB_SPIN(xb_ld(&bar[XB_TOPGEN]) == tg, bar);
            __builtin_amdgcn_fence(__ATOMIC_ACQUIRE, "agent");
            xb_add(&bar[XB_XGEN(b.x)], 1u);
            asm volatile("s_waitcnt vmcnt(0)" ::: "memory");
        } else {
            XB_SPIN(xb_ld(&bar[XB_XGEN(b.x)]) == gen, bar);
            __builtin_amdgcn_fence(__ATOMIC_ACQUIRE, "agent");
            asm volatile("s_waitcnt vmcnt(0)" ::: "memory");
        }
    }
    __syncthreads();
}

#ifndef PH_MASK
#define PH_MASK 0xFFF
#endif
#define PH_ON(k) (((PH_MASK) >> (k)) & 1)
struct Args { const float* in[19]; float* out; unsigned char* ws; int ph_lo, ph_hi; };

__device__ __forceinline__ float wave_sum(float v) {
#pragma unroll
    for (int o = 1; o < 64; o <<= 1) v += __shfl_xor(v, o);
    return v;
}
__device__ __forceinline__ int map_row(int mode, int n) {
    switch (mode) {
        case 1: return (n >> 7) * 256 + (n & 127);
        case 2: return (n >> 7) * 256 + 128 + (n & 127);
        case 3: { if (n < 512) return 512 + n; const int j = n - 512; return 1024 + 2 * (j & 31) + (j >> 5); }
        case 4: { const int h = n / 192, d = n % 192; if (d < 128) return h * 128 + d; const int j = d - 128; return 2048 + h * 64 + 2 * (j & 31) + (j >> 5); }
        case 5: { const int h = n >> 8, d = n & 255; return d < 128 ? h * 128 + d : 2048 + h * 128 + (d - 128); }
        default: return n;
    }
}
__device__ __forceinline__ void transpose_item(const float* W, int K, int N, bf16_t* WT, int mode, const float* ks, const float* cs, LAS float* scr, int item, int lane) {
    const int nblk = N / 64, kb = item / nblk, nb = item % nblk, k0 = 64 * kb, n0 = 64 * nb;
    const int lr = lane >> 4, lc = (lane & 15) * 4;
    f32x4 v[16];
#pragma unroll
    for (int i = 0; i < 16; ++i) v[i] = *(const f32x4*)(W + (size_t)(k0 + 4 * i + lr) * N + n0 + lc);
#pragma unroll
    for (int i = 0; i < 16; ++i) { const int kk = 4 * i + lr; f32x4 t = v[i]; if (ks) t = t * ks[k0 + kk]; LAS float* d = scr + kk * 65 + lc; d[0] = t[0]; d[1] = t[1]; d[2] = t[2]; d[3] = t[3]; }
    asm volatile("s_waitcnt lgkmcnt(0)" ::: "memory");
    const int c = lane & 7;
#pragma unroll
    for (int j = 0; j < 8; ++j) { const int n = (lane >> 3) + 8 * j; const LAS float* s = scr + (8 * c) * 65 + n; const float csn = cs ? cs[n0 + n] : 1.f;
        u32x4 o; o.x = cvt_pk_bf16(s[0 * 65] * csn, s[1 * 65] * csn); o.y = cvt_pk_bf16(s[2 * 65] * csn, s[3 * 65] * csn); o.z = cvt_pk_bf16(s[4 * 65] * csn, s[5 * 65] * csn); o.w = cvt_pk_bf16(s[6 * 65] * csn, s[7 * 65] * csn);
        *(u32x4*)(WT + (size_t)map_row(mode, n0 + n) * K + k0 + 8 * c) = o; }
    asm volatile("s_waitcnt lgkmcnt(0)" ::: "memory");
}

template <int W>
__device__ __forceinline__ void pool_chunk(const float* x, bf16_t* B0, int t0, int tin0, int wave, int lane, LAS float* part) {
    const int c0 = wave * 256 + lane * 4; const float* xc = x + c0;
    f32x4 ring[16], s = {0.f, 0.f, 0.f, 0.f};
#pragma unroll
    for (int k = 0; k < 16; ++k) ring[k] = (f32x4){0.f, 0.f, 0.f, 0.f};
    int pb = 0;
#pragma unroll 1
    for (int g2 = (tin0 ? -1 : 0); g2 < 8; ++g2) {
#pragma unroll
        for (int half = 0; half < 2; ++half) { const int tb = t0 + 16 * g2 + 8 * half;
            f32x4 xv[8];
#pragma unroll
            for (int k = 0; k < 8; ++k) xv[k] = *(const f32x4*)(xc + (size_t)(tb + k) * DM);
            float sq[8];
#pragma unroll
            for (int k = 0; k < 8; ++k) sq[k] = wave_sum(sq4(xv[k]));
            if (lane == 0) {
#pragma unroll
                for (int k = 0; k < 8; ++k) part[pb * 64 + k * 8 + wave] = sq[k]; }
            __syncthreads();
            float rs[8];
#pragma unroll
            for (int k = 0; k < 8; ++k) { const f32x4 pa = *(const LAS f32x4*)(part + pb * 64 + k * 8), pc = *(const LAS f32x4*)(part + pb * 64 + k * 8 + 4);
                rs[k] = __builtin_amdgcn_rsqf((((pa[0] + pa[1]) + (pa[2] + pa[3])) + ((pc[0] + pc[1]) + (pc[2] + pc[3]))) * (1.f / DM) + EPS); }
            pb ^= 1;
#pragma unroll
            for (int k = 0; k < 8; ++k) { const int p = 8 * half + k; const f32x4 h = xv[k] * rs[k]; ring[p] = h; s += h;
                if (g2 >= 0) { const int tin = tin0 + 16 * g2 + p, cnt = tin + 1 < W ? tin + 1 : W; const f32x4 d = s * __builtin_amdgcn_rcpf((float)cnt) - h;
                    u32x2 o; o.x = cvt_pk_bf16(d[0], d[1]); o.y = cvt_pk_bf16(d[2], d[3]); *(u32x2*)(B0 + (size_t)(t0 + 16 * g2 + p) * DM + c0) = o; }
                s -= ring[(p - W + 1) & 15]; }
        }
    }
}

__global__ void __launch_bounds__(512, 2) yoco_fwd(Args a) {
    extern __shared__ __attribute__((aligned(16))) unsigned char lds[];
    cg::grid_group grid = cg::this_grid();
    const int tid = threadIdx.x, lane = tid & 63, wave = __builtin_amdgcn_readfirstlane(tid >> 6);
    const int G = gridDim.x, bx = blockIdx.x, vcu = (G % 8 == 0) ? (bx % 8) * (G / 8) + bx / 8 : bx;
    const int gw = vcu * 8 + wave, NGW = G * 8;
    unsigned char* ws = a.ws;
    const float* x = a.in[0]; const int* positions = (const int*)a.in[1];
    float* out = a.out;
    float* rstd0 = (float*)(ws + WS_RSTD0); float* ssq = (float*)(ws + WS_SSQ); float* sskv = (float*)(ws + WS_SSKV); float* ss = (float*)(ws + WS_SS); float* cs = (float*)(ws + WS_CS);
    bf16_t* Wpool = (bf16_t*)(ws + WS_WPOOL); bf16_t* Wa = (bf16_t*)(ws + WS_WA); bf16_t* Wqb = (bf16_t*)(ws + WS_WQB); bf16_t* Wkvb = (bf16_t*)(ws + WS_WKVB); bf16_t* Wo = (bf16_t*)(ws + WS_WO);
    bf16_t* B0 = (bf16_t*)(ws + WS_B0); bf16_t* B1 = (bf16_t*)(ws + WS_B1); bf16_t* QA = (bf16_t*)(ws + WS_QA); bf16_t* KVA = (bf16_t*)(ws + WS_KVA);
    bf16_t* Qb = (bf16_t*)(ws + WS_Q); bf16_t* Kb = (bf16_t*)(ws + WS_K); bf16_t* Vb = (bf16_t*)(ws + WS_V); bf16_t* MID = (bf16_t*)(ws + WS_MID);
    LAS unsigned char* ldsl = (LAS unsigned char*)lds;
    const int lo = a.ph_lo, hi = a.ph_hi;
    volatile LAS unsigned* bst = (volatile LAS unsigned*)(ldsl + LDS_BYTES - 64);
    if (tid == 0) { bst[0] = 0u; bst[1] = 0u; }
    __syncthreads();
    if (bx == 0) for (int u = tid; u < XCD_BAR_WORDS; u += 512) __hip_atomic_store((unsigned*)(ws + WS_BAR) + u, 0u, __ATOMIC_RELAXED, __HIP_MEMORY_SCOPE_AGENT);
    XcdBarrier xbar; xbar.bar = (unsigned*)(ws + WS_BAR); xbar.x = 0; xbar.st = bst;
#define IN(k) (lo <= (k) && (k) < hi)
#define SEAM(k) do { if (IN(k) && IN((k) + 1)) { if ((k) == 1) grid.sync(); else xcd_barrier(xbar); } } while (0)

    if (PH_ON(1) && IN(1)) {
        LAS float* part = (LAS float*)(ldsl + 140000);
        for (int chunk = vcu; chunk < T / 128; chunk += G) {
            const int t0 = chunk * 128, tin0 = t0 & (SEQ - 1);
            switch (wave >> 1) {
                case 0: pool_chunk<2>(x, B0, t0, tin0, wave, lane, part); break;
                case 1: pool_chunk<4>(x, B0, t0, tin0, wave, lane, part); break;
                case 2: pool_chunk<8>(x, B0, t0, tin0, wave, lane, part); break;
                default: pool_chunk<16>(x, B0, t0, tin0, wave, lane, part); break;
            }
            __syncthreads();
        }
    }
    if (PH_ON(0) && IN(0)) {
        LAS float* scr = (LAS float*)(ldsl + wave * 16640);
        constexpr int I_POOL = 8 * 8, I_GU = 32 * 88, I_DN = 88 * 32, I_QA = 32 * 8, I_KVA = 32 * 9, I_QB = 8 * 48, I_KVB = 8 * 64, I_WO = 32 * 32;
        constexpr int NITEMS = 4 * I_POOL + 2 * (2 * I_GU + I_DN) + I_QA + I_KVA + I_QB + I_KVB + I_WO;
        for (int it = gw; it < NITEMS; it += NGW) {
            int r = it;
#define JOB(cnt, W_, K_, N_, dst_, mode_, ks_, cs_) if (r < (cnt)) { transpose_item(W_, K_, N_, dst_, mode_, ks_, cs_, scr, r, lane); continue; } r -= (cnt);
            JOB(I_POOL, a.in[3] + 0 * 262144, 512, 512, Wpool + 0 * 262144, 0, a.in[2] + 0, a.in[4] + 0)
            JOB(I_POOL, a.in[3] + 1 * 262144, 512, 512, Wpool + 1 * 262144, 0, a.in[2] + 512, a.in[4] + 512)
            JOB(I_POOL, a.in[3] + 2 * 262144, 512, 512, Wpool + 2 * 262144, 0, a.in[2] + 1024, a.in[4] + 1024)
            JOB(I_POOL, a.in[3] + 3 * 262144, 512, 512, Wpool + 3 * 262144, 0, a.in[2] + 1536, a.in[4] + 1536)
            JOB(I_GU, a.in[15], DM, DFF, (bf16_t*)(ws + WS_WGU0), 1, a.in[14], nullptr)
            JOB(I_GU, a.in[16], DM, DFF, (bf16_t*)(ws + WS_WGU0), 2, a.in[14], nullptr)
            JOB(I_DN, a.in[17], DFF, DM, (bf16_t*)(ws + WS_WDN0), 0, nullptr, nullptr)
            JOB(I_GU, a.in[15] + (size_t)DM * DFF, DM, DFF, (bf16_t*)(ws + WS_WGU1), 1, a.in[14] + DM, nullptr)
            JOB(I_GU, a.in[16] + (size_t)DM * DFF, DM, DFF, (bf16_t*)(ws + WS_WGU1), 2, a.in[14] + DM, nullptr)
            JOB(I_DN, a.in[17] + (size_t)DM * DFF, DFF, DM, (bf16_t*)(ws + WS_WDN1), 0, nullptr, nullptr)
            JOB(I_QA, a.in[10], DM, 512, Wa, 0, a.in[9], nullptr)
            JOB(I_KVA, a.in[6], DM, 576, Wa, 3, a.in[5], nullptr)
            JOB(I_QB, a.in[12], 512, 3072, Wqb, 4, a.in[11], nullptr)
            JOB(I_KVB, a.in[8], 512, 4096, Wkvb, 5, a.in[7], nullptr)
            JOB(I_WO, a.in[13], DM, DM, Wo, 0, nullptr, nullptr)
#undef JOB
        }
        for (int m = gw * 2 + (lane >> 5); m < T; m += NGW * 2) {
            const int i = lane & 31;
            const float invf = (float)exp2(-(double)i * (13.287712379549449 / 32.0));
            const float ang = (float)positions[m] * invf;
            double rev = (double)ang * 0.15915494309189535; rev -= rint(rev);
            const float rf = (float)rev;
            *(f32x2*)(cs + ((size_t)m * 32 + i) * 2) = (f32x2){__builtin_amdgcn_cosf(rf), __builtin_amdgcn_sinf(rf)};
        }
    }
    SEAM(1);
    xbar = xcd_barrier_post((unsigned*)(ws + WS_BAR), bst);
    if (PH_ON(2) && IN(2)) {
        pg8::Gemm g{B0, Wpool, DM, 512, 512, 512, 262144}; pg8::Order S; S.init(T, 512, 4, G, bx);
        pg8::EpiResid E{x, nullptr, B1, ss, 512};
        pg8::gemm_phase(ldsl, g, S, E);
    }
    SEAM(2);
    if (PH_ON(3) && IN(3)) {
        pg8::Gemm g{B1, (const bf16_t*)(ws + WS_WGU0), DM, DM, DM, 0, 0}; pg8::Order S; S.init(T, 2 * DFF, 1, G, bx);
        pg8::EpiSwiGLU E{MID, ss};
#ifndef REP3
#define REP3 1
#endif
        for (int rep3 = 0; rep3 < REP3; ++rep3) pg8::gemm_phase(ldsl, g, S, E);
    }
    SEAM(3);
    if (PH_ON(4) && IN(4)) {
        pg8::Gemm g{MID, (const bf16_t*)(ws + WS_WDN0), DFF, DFF, DFF, 0, 0}; pg8::Order S; S.init(T, DM, 1, G, bx);
        pg8::EpiResid E{nullptr, B1, B0, ss, 0};
        pg8::gemm_phase(ldsl, g, S, E);
    }
    SEAM(4);
    if (PH_ON(5) && IN(5)) {
        pg8::Gemm g{B0, Wa, DM, DM, DM, 0, 0}; pg8::Order S; S.init(T, 1280, 1, G, bx);
        pg8::EpiA E{ss, QA, KVA, ssq, sskv, Kb, cs};
        pg8::gemm_phase(ldsl, g, S, E);
    }
    SEAM(5);
    if (PH_ON(6) && IN(6)) {
        { pg8::Gemm g{QA, Wqb, 512, 512, 512, 0, 0}; pg8::Order S; S.init(T, 3072, 1, G, bx);
          pg8::EpiQ E{ssq, Qb, cs}; pg8::gemm_phase(ldsl, g, S, E); }
        { pg8::Gemm g{KVA, Wkvb, 512, 512, 512, 0, 0}; pg8::Order S; S.init(T, 4096, 1, G, bx);
          pg8::EpiKV E{sskv, Kb, Vb}; pg8::gemm_phase(ldsl, g, S, E); }
    }
    SEAM(6);
    if (PH_ON(7) && IN(7)) {
#ifndef REP7
#define REP7 1
#endif
        for (int rep7 = 0; rep7 < REP7; ++rep7)
        for (int sid = vcu; sid < 256; sid += G) att::attn_stream(Qb, Kb, Vb, B1, sid, (char*)lds);
    }
    SEAM(7);
    if (PH_ON(8) && IN(8)) {
        pg8::Gemm g{B1, Wo, DM, DM, DM, 0, 0}; pg8::Order S; S.init(T, DM, 1, G, bx);
        pg8::EpiResid E{nullptr, B0, B0, ss, 0};
        pg8::gemm_phase(ldsl, g, S, E);
    }
    SEAM(8);
    if (PH_ON(9) && IN(9)) {
        pg8::Gemm g{B0, (const bf16_t*)(ws + WS_WGU1), DM, DM, DM, 0, 0}; pg8::Order S; S.init(T, 2 * DFF, 1, G, bx);
        pg8::EpiSwiGLU E{MID, ss};
        pg8::gemm_phase(ldsl, g, S, E);
    }
    SEAM(9);
    if (PH_ON(10) && IN(10)) {
        pg8::Gemm g{MID, (const bf16_t*)(ws + WS_WDN1), DFF, DFF, DFF, 0, 0}; pg8::Order S; S.init(T, DM, 1, G, bx);
        pg8::EpiResid E{nullptr, B0, B0, ss, 0};
        pg8::gemm_phase(ldsl, g, S, E);
    }
    SEAM(10);
    if (PH_ON(11) && IN(11)) {
        const float* fg = a.in[18];
        for (int m = gw; m < T; m += NGW) {
            float s = lane < 32 ? ss[(size_t)m * 32 + lane] : 0.f; s = wave_sum(s);
            const float r = __builtin_amdgcn_rsqf(s * (1.f / DM) + EPS);
            const u32x4* xr = (const u32x4*)(B0 + (size_t)m * DM) + lane; f32x4* orow = (f32x4*)(out + (size_t)m * DM) + 2 * lane; const f32x4* gr = (const f32x4*)fg + 2 * lane;
#pragma unroll
            for (int j = 0; j < 4; ++j) { const u32x4 w = xr[64 * j];
                const f32x4 v0 = {__uint_as_float(w.x << 16), __uint_as_float(w.x & 0xffff0000u), __uint_as_float(w.y << 16), __uint_as_float(w.y & 0xffff0000u)};
                const f32x4 v1 = {__uint_as_float(w.z << 16), __uint_as_float(w.z & 0xffff0000u), __uint_as_float(w.w << 16), __uint_as_float(w.w & 0xffff0000u)};
                orow[128 * j] = v0 * r * gr[128 * j]; orow[128 * j + 1] = v1 * r * gr[128 * j + 1]; }
        }
    }
#undef IN
#undef SEAM
}

extern "C" void kernel_launch(void* const* d_in, const int* in_sizes, int n_in, void* d_out, int out_size, void* d_ws, size_t ws_size, hipStream_t stream) {
    static int grid = 0;
    if (grid == 0) {
        if (n_in != 19 || in_sizes[0] != T * DM || out_size != T * DM || ws_size < WS_END) { fprintf(stderr, "kernel_launch: shape/workspace mismatch (n_in %d, in0 %d, out %d, ws %zu < %zu)\n", n_in, n_in > 0 ? in_sizes[0] : -1, out_size, ws_size, (size_t)WS_END); grid = -1; return; }
        int dev = 0, cus = 0, per_cu = 0;
        (void)hipGetDevice(&dev); (void)hipDeviceGetAttribute(&cus, hipDeviceAttributeMultiprocessorCount, dev);
        if (hipFuncSetAttribute((const void*)yoco_fwd, hipFuncAttributeMaxDynamicSharedMemorySize, LDS_BYTES) != hipSuccess) { fprintf(stderr, "kernel_launch: hipFuncSetAttribute failed\n"); grid = -1; return; }
        if (hipOccupancyMaxActiveBlocksPerMultiprocessor(&per_cu, (const void*)yoco_fwd, 512, LDS_BYTES) != hipSuccess || per_cu < 1) { fprintf(stderr, "kernel_launch: occupancy query says %d\n", per_cu); per_cu = 1; }
        (void)hipGetLastError();
        grid = cus * per_cu;
        if (grid <= 0) grid = 256;
    }
    if (grid < 0) return;
    Args a{};
    for (int i = 0; i < 19; ++i) a.in[i] = (const float*)d_in[i];
    a.out = (float*)d_out; a.ws = (unsigned char*)d_ws; a.ph_lo = 0; a.ph_hi = 12;
    void* args[] = {&a};
    hipError_t e = hipLaunchCooperativeKernel((const void*)yoco_fwd, dim3(grid), dim3(512), args, LDS_BYTES, stream);
    if (e != hipSuccess) fprintf(stderr, "cooperative launch failed: %s (grid %d)\n", hipGetErrorString(e), grid);
}
```
